# Optimizing an MI355X kernel written in HIP

```python
import jax, jax.numpy as jnp
from jax import lax
import numpy as np

D_MODEL = 1024
BATCH = 8
SEQ = 4096
DEPTH = 4

HEAD_DIM = 64
A_Q_HEADS = 8
A_KV_HEADS = 2
B_GROUPS = ((128, 1), (512, 4), (2048, 16))
B_HEADS = 4
N_B = len(B_GROUPS)
D_FF = 4 * D_MODEL
GRID_W = 64
ROPE_THETA = 10000.0
Q_BLOCK = 128
EPS = 1e-6

A_Q_W = A_Q_HEADS * HEAD_DIM
A_KV_W = A_KV_HEADS * HEAD_DIM
B_W = B_HEADS * HEAD_DIM
IN_SIZES = [A_Q_W, A_KV_W, A_KV_W] + [B_W] * (3 * N_B) + [D_MODEL, D_MODEL]
IN_W = sum(IN_SIZES)
IN_SPLITS = [int(v) for v in np.cumsum(IN_SIZES)[:-1]]

kernel_name = "hybrid_gqa_axial_dilated_gated_encoder"


def rms(x, g):
    x32 = x.astype(jnp.float32)
    y = x32 * lax.rsqrt(jnp.mean(x32 * x32, axis=-1, keepdims=True) + EPS)
    return (y * g.astype(jnp.float32)).astype(x.dtype)


def rope_cos_sin(pos, dim):
    inv = ROPE_THETA ** (-jnp.arange(0, dim, 2, dtype=jnp.float32) / dim)
    ang = pos.astype(jnp.float32)[:, None] * inv[None, :]
    return jnp.cos(ang), jnp.sin(ang)


def apply_rope(x, cos, sin):
    x32 = x.astype(jnp.float32)
    x1, x2 = jnp.split(x32, 2, axis=-1)
    c = cos[None, :, None, :]
    s = sin[None, :, None, :]
    return jnp.concatenate([x1 * c - x2 * s, x2 * c + x1 * s], axis=-1).astype(x.dtype)


def axial_rope(x, row_cs, col_cs):
    half = x.shape[-1] // 2
    return jnp.concatenate([apply_rope(x[..., :half], *row_cs),
                            apply_rope(x[..., half:], *col_cs)], axis=-1)


def gqa_attention(q, k, v):
    B, S, Hq, hd = q.shape
    Hkv = k.shape[2]
    rep = Hq // Hkv
    q = q.reshape(B, S, Hkv, rep, hd)
    scale = hd ** -0.5

    def block(i):
        qi = lax.dynamic_slice_in_dim(q, i * Q_BLOCK, Q_BLOCK, axis=1)
        s = jnp.einsum('bqgrd,bkgd->bgrqk', qi, k, preferred_element_type=jnp.float32) * scale
        p = jax.nn.softmax(s, axis=-1).astype(v.dtype)
        return jnp.einsum('bgrqk,bkgd->bqgrd', p, v)

    o = lax.map(block, jnp.arange(S // Q_BLOCK))
    return jnp.moveaxis(o, 0, 1).reshape(B, S, Hq * hd)


def dilated_attention(qs, ks, vs):
    B, S, H, hd = qs[0].shape
    scale = hd ** -0.5
    offs = []
    for (w, d) in B_GROUPS:
        kk = (w // 2) // d
        offs.append(jnp.asarray(np.arange(-kk, kk + 1) * d, dtype=jnp.int32))

    def block(i):
        t = i * Q_BLOCK + jnp.arange(Q_BLOCK, dtype=jnp.int32)
        outs, lses = [], []
        for q, k, v, off in zip(qs, ks, vs, offs):
            idx = t[:, None] + off[None, :]
            valid = (idx >= 0) & (idx < S)
            idx = jnp.clip(idx, 0, S - 1)
            qi = lax.dynamic_slice_in_dim(q, i * Q_BLOCK, Q_BLOCK, axis=1)
            kg = k[:, idx]
            vg = v[:, idx]
            s = jnp.einsum('bqhd,bqkhd->bhqk', qi, kg, preferred_element_type=jnp.float32) * scale
            s = jnp.where(valid[None, None], s, -jnp.inf)
            lse = jax.nn.logsumexp(s, axis=-1)
            p = jnp.exp(s - lse[..., None]).astype(vg.dtype)
            outs.append(jnp.einsum('bhqk,bqkhd->bqhd', p, vg))
            lses.append(lse)
        wts = jax.nn.softmax(jnp.stack(lses), axis=0)
        wts = jnp.transpose(wts, (0, 1, 3, 2))[..., None]
        return jnp.sum(wts.astype(outs[0].dtype) * jnp.stack(outs), axis=0)

    o = lax.map(block, jnp.arange(S // Q_BLOCK))
    return jnp.moveaxis(o, 0, 1).reshape(B, S, H * hd)


def setup_inputs(seed: int = 0) -> dict:
    key = jax.random.key(seed)
    ks = jax.random.split(key, 16)
    f = jnp.float32
    nrm = lambda k, shape, fan: jax.random.normal(k, shape, f) * (fan ** -0.5)
    return {
        "x": jax.random.normal(ks[0], (BATCH, SEQ, D_MODEL), f),
        "c": jax.random.normal(ks[1], (BATCH, D_MODEL), f),
        "w_ada": nrm(ks[2], (DEPTH, D_MODEL, 6 * D_MODEL), D_MODEL),
        "b_ada": 0.02 * jax.random.normal(ks[3], (DEPTH, 6 * D_MODEL), f),
        "g_mix": 1.0 + 0.05 * jax.random.normal(ks[4], (DEPTH, D_MODEL), f),
        "g_mlp": 1.0 + 0.05 * jax.random.normal(ks[5], (DEPTH, D_MODEL), f),
        "w_in": nrm(ks[6], (DEPTH, D_MODEL, IN_W), D_MODEL),
        "q_norm_a": 1.0 + 0.05 * jax.random.normal(ks[7], (DEPTH, HEAD_DIM), f),
        "k_norm_a": 1.0 + 0.05 * jax.random.normal(ks[8], (DEPTH, HEAD_DIM), f),
        "q_norm_b": 1.0 + 0.05 * jax.random.normal(ks[9], (DEPTH, N_B, HEAD_DIM), f),
        "k_norm_b": 1.0 + 0.05 * jax.random.normal(ks[10], (DEPTH, N_B, HEAD_DIM), f),
        "w_branch_a": nrm(ks[11], (DEPTH, A_Q_W, D_MODEL), A_Q_W),
        "w_branch_b": nrm(ks[12], (DEPTH, B_W, D_MODEL), B_W),
        "w_out": nrm(ks[13], (DEPTH, D_MODEL, D_MODEL), D_MODEL),
        "w_ff1": nrm(ks[14], (DEPTH, D_MODEL, D_FF), D_MODEL),
        "w_ff2": nrm(ks[15], (DEPTH, D_FF, D_MODEL), D_FF),
    }


def reference(x, c, w_ada, b_ada, g_mix, g_mlp, w_in, q_norm_a, k_norm_a, q_norm_b, k_norm_b,
              w_branch_a, w_branch_b, w_out, w_ff1, w_ff2):
    B, S, D = x.shape
    rows = S // GRID_W
    row_idx = jnp.broadcast_to(jnp.arange(rows)[:, None], (rows, GRID_W)).reshape(-1)
    col_idx = jnp.broadcast_to(jnp.arange(GRID_W)[None, :], (rows, GRID_W)).reshape(-1)
    row_cs = rope_cos_sin(row_idx, HEAD_DIM // 2)
    col_cs = rope_cos_sin(col_idx, HEAD_DIM // 2)
    seq_cs = rope_cos_sin(jnp.arange(S), HEAD_DIM)
    c_act = jax.nn.silu(c)

    for l in range(DEPTH):
        ada = c_act @ w_ada[l] + b_ada[l]
        sh1, sc1, gt1, sh2, sc2, gt2 = [a[:, None, :] for a in jnp.split(ada, 6, axis=-1)]

        h = rms(x, g_mix[l]) * (1.0 + sc1) + sh1
        parts = jnp.split(h @ w_in[l], IN_SPLITS, axis=-1)
        qa = parts[0].reshape(B, S, A_Q_HEADS, HEAD_DIM)
        ka = parts[1].reshape(B, S, A_KV_HEADS, HEAD_DIM)
        va = parts[2].reshape(B, S, A_KV_HEADS, HEAD_DIM)
        qa = axial_rope(rms(qa, q_norm_a[l]), row_cs, col_cs)
        ka = axial_rope(rms(ka, k_norm_a[l]), row_cs, col_cs)
        y_a = gqa_attention(qa, ka, va) @ w_branch_a[l]

        qs, kss, vs = [], [], []
        for g in range(N_B):
            qb = parts[3 + 3 * g].reshape(B, S, B_HEADS, HEAD_DIM)
            kb = parts[4 + 3 * g].reshape(B, S, B_HEADS, HEAD_DIM)
            vb = parts[5 + 3 * g].reshape(B, S, B_HEADS, HEAD_DIM)
            qs.append(apply_rope(rms(qb, q_norm_b[l, g]), *seq_cs))
            kss.append(apply_rope(rms(kb, k_norm_b[l, g]), *seq_cs))
            vs.append(vb)
        y_b = dilated_attention(qs, kss, vs) @ w_branch_b[l]

        gate_a = jax.nn.sigmoid(parts[3 + 3 * N_B])
        gate_b = jax.nn.sigmoid(parts[4 + 3 * N_B])
        mixed = gate_a * y_a + gate_b * y_b
        x = x + gt1 * (mixed @ w_out[l])

        h2 = rms(x, g_mlp[l]) * (1.0 + sc2) + sh2
        x = x + gt2 * (jnp.square(jax.nn.relu(h2 @ w_ff1[l])) @ w_ff2[l])

    return x
```

```cpp
#include <hip/hip_runtime.h>
#include <hip/hip_bf16.h>
#include <hip/hip_cooperative_groups.h>
#include <cstdio>
#include <cstdint>
#include <cmath>
namespace cg = cooperative_groups;

#ifndef MK_PER_PHASE
#define MK_PER_PHASE 0
#endif

#ifndef NAIVE_ATT
#define NAIVE_ATT 0
#endif
#ifndef NAIVE_DIL
#define NAIVE_DIL 0
#endif

#ifndef NAIVE_GEMM
#define NAIVE_GEMM 0
#endif

#ifndef NAIVE_GIN
#define NAIVE_GIN NAIVE_GEMM
#endif
#ifndef NAIVE_BR
#define NAIVE_BR NAIVE_GEMM
#endif
#ifndef NAIVE_OUT
#define NAIVE_OUT NAIVE_GEMM
#endif
#ifndef NAIVE_F1
#define NAIVE_F1 NAIVE_GEMM
#endif
#ifndef NAIVE_F2
#define NAIVE_F2 NAIVE_GEMM
#endif

#ifndef TAB_DOUBLE
#define TAB_DOUBLE 1
#endif

#ifndef DBG_SKIP
#define DBG_SKIP 0u
#endif

#ifndef DBG_SYNCX
#define DBG_SYNCX 0
#endif
#ifndef DBG_DIL2
#define DBG_DIL2 0
#endif
#ifndef DBG_GEMM2
#define DBG_GEMM2 0
#endif

constexpr int BATCH = 8, SEQ = 4096, DM = 1024, DEPTH = 4, FF = 4096, NIN = 5120;
constexpr int MTOK = BATCH * SEQ;
constexpr int PP = 5120;
constexpr int C_QA = 0, C_KA = 512, C_VA = 640, C_B0 = 768, C_GA = 3072, C_GB = 4096, C_OB = 768;
constexpr float QK_C2 = 0.125f * 1.4426950408889634f;
constexpr float EPS = 1e-6f;

namespace pg8 {
#define PG8_LAS __attribute__((address_space(3)))
typedef unsigned short bf16_t;
typedef short bf16x8 __attribute__((ext_vector_type(8)));
typedef float f32x4 __attribute__((ext_vector_type(4)));
typedef unsigned u32x4 __attribute__((ext_vector_type(4)));
constexpr int BM = 256, BK = 64, HALF = 128, HTB = HALF * BK * 2  , STAGE_BYTES = 8 * HTB, NXCD = 8, WGM = 8;

__host__ __device__ __forceinline__ int lds_byte(int r, int c) { const int st = (r >> 4) * 2 + (c >> 5), rr = r & 15, cc = c & 31, ob = rr * 64 + cc * 2; return st * 1024 + (ob ^ (((ob >> 9) & 1) << 5)); }
__host__ __device__ __forceinline__ void stage_rc(int b, int& R, int& C) { const int st = b / 1024, sb = b % 1024, swz = sb ^ (((sb >> 9) & 1) << 5); R = (st >> 1) * 16 + swz / 64; C = (st & 1) * 32 + (swz % 64) / 2; }
__host__ __device__ __forceinline__ int perm32(int rho) { const int n = rho >> 4, i = rho & 15; return 8 * (i >> 2) + 4 * n + (i & 3); }

struct Unit { int pm, pn; };
struct Gemm { const bf16_t* A; const bf16_t* Bt; int M, N, K, lda; };

struct StaticOrder {
    int nM, nN, nwg, G, c;
    __host__ __device__ void init(int M, int N, int G_, int c_) { nM = M / BM; nN = N / BM; nwg = nM * nN; G = G_; c = c_; }
    __host__ __device__ bool next(int i, Unit& u) const {
        const long L = (long)i * G + c; if (L >= nwg) return false;
        int wgid = (int)L; { const int q = nwg / NXCD, r = nwg % NXCD, xcd = wgid % NXCD, off = wgid / NXCD; wgid = (xcd < r ? xcd * (q + 1) : r * (q + 1) + (xcd - r) * q) + off; }
        const int nig = WGM * nN, gid = wgid / nig, fm = gid * WGM, gsz = (nM - fm) < WGM ? (nM - fm) : WGM;
        u.pm = fm + ((wgid % nig) % gsz); u.pn = (wgid % nig) / gsz; return true;
    }
    __device__ __forceinline__ void a_ready(const Unit&) const {}
    __device__ __forceinline__ void done(const Unit&) const {}
};

typedef float f32x2c __attribute__((ext_vector_type(2))); typedef __bf16 bf16x2c __attribute__((ext_vector_type(2)));
__device__ __forceinline__ unsigned cvt_pk_bf16(float lo, float hi) { const f32x2c v = {lo, hi}; const bf16x2c b = __builtin_convertvector(v, bf16x2c); return __builtin_bit_cast(unsigned, b); }
typedef float f32x2 __attribute__((ext_vector_type(2)));
typedef unsigned u32x2 __attribute__((ext_vector_type(2)));
__device__ __forceinline__ float bf_lo(unsigned w) { return __uint_as_float(w << 16); }
__device__ __forceinline__ float bf_hi(unsigned w) { return __uint_as_float(w & 0xffff0000u); }
__device__ __forceinline__ float sigm(float v) { return __builtin_amdgcn_rcpf(1.0f + __builtin_amdgcn_exp2f(-1.4426950408889634f * v)); }
__device__ __forceinline__ u32x4 pack8(const f32x4 a, const f32x4 b) { u32x4 w; w.x = cvt_pk_bf16(a[0], a[1]); w.y = cvt_pk_bf16(a[2], a[3]); w.z = cvt_pk_bf16(b[0], b[1]); w.w = cvt_pk_bf16(b[2], b[3]); return w; }

__device__ __forceinline__ float row_rstd(const float* rss, int row) {
    const f32x4* p = (const f32x4*)(rss + (size_t)row * 16); const f32x4 a = p[0], b = p[1], c = p[2], d = p[3];
    const float s = ((a[0] + a[1]) + (a[2] + a[3])) + ((b[0] + b[1]) + (b[2] + b[3])) + ((c[0] + c[1]) + (c[2] + c[3])) + ((d[0] + d[1]) + (d[2] + d[3]));
    return __builtin_amdgcn_rsqf(s * (1.0f / DM) + EPS);
}
__device__ __forceinline__ void rows_rstd(const float* rss, int row0, int fq, float (&rs)[2][4]) {
    f32x4 q[2][4];
#pragma unroll
    for (int ai = 0; ai < 2; ++ai)
#pragma unroll
        for (int m = 0; m < 4; ++m) q[ai][m] = *(const f32x4*)(rss + (size_t)(row0 + ai * HALF + m * 16) * 16 + 4 * fq);
#pragma unroll
    for (int ai = 0; ai < 2; ++ai)
#pragma unroll
        for (int m = 0; m < 4; ++m) { float s = (q[ai][m][0] + q[ai][m][1]) + (q[ai][m][2] + q[ai][m][3]); s += __shfl_xor(s, 16); s += __shfl_xor(s, 32);
            rs[ai][m] = __builtin_amdgcn_rsqf(s * (1.0f / DM) + EPS); }
}
struct EpiIn {
    static constexpr bool PERM = true, AFTER_DRAIN = false;
    bf16_t* P; const float* qna; const float* kna; const float* qnb; const float* knb; const float* tabA; const float* tabB; const float* rss; const float* bias;
    __device__ __forceinline__ void operator()(const f32x4 (&acc)[2][2][4][2], const Unit& u, int wr, int wc, int fr, int fq) const {
        const int pn = u.pn; const int row0 = u.pm * BM + wr * 64 + fr; const int bb = (u.pm * BM) / SEQ;
        if ((DBG_SKIP >> pn) & 1u) return;
        float rs[2][4]; rows_rstd(rss, row0, fq, rs);
        if (pn >= 12) {
            const int col0 = pn * 256 + wc * 32 + 8 * fq;
            f32x4 bv[2][2];
#pragma unroll
            for (int bj = 0; bj < 2; ++bj)
#pragma unroll
                for (int n = 0; n < 2; ++n) bv[bj][n] = *(const f32x4*)(bias + (size_t)bb * NIN + col0 + bj * HALF + 4 * n);
#pragma unroll
            for (int ai = 0; ai < 2; ++ai)
#pragma unroll
                for (int m = 0; m < 4; ++m) { const int row = row0 + ai * HALF + m * 16; bf16_t* rowp = P + (size_t)row * PP + col0; const float rstd = rs[ai][m];
#pragma unroll
                    for (int bj = 0; bj < 2; ++bj) { f32x4 v0 = acc[ai][bj][m][0] * rstd + bv[bj][0], v1 = acc[ai][bj][m][1] * rstd + bv[bj][1];
#pragma unroll
                        for (int j = 0; j < 4; ++j) { v0[j] = sigm(v0[j]); v1[j] = sigm(v1[j]); }
                        *(u32x4*)(rowp + bj * HALF) = pack8(v0, v1); } }
            return;
        }
        int mode, colbase; const float* gn = qna; float scale = 1.f;
        if (pn <= 1) { mode = 0; colbase = (4 * pn + wc) * 64; gn = qna; scale = QK_C2; }
        else if (pn == 2) { colbase = 512 + 64 * wc; if (wc < 2) { mode = 0; gn = kna; } else mode = 2; }
        else { const int g = (pn - 3) / 3, kind = (pn - 3) - 3 * g; colbase = 256 * pn + 64 * wc;
               if (kind == 2) mode = 2; else { mode = 1; gn = (kind == 0 ? qnb : knb) + 64 * g; scale = (kind == 0) ? QK_C2 : 1.f; } }
        const int d0 = (mode == 0) ? (32 * (fq >> 1) + 8 * (fq & 1)) : 8 * fq; const int bjs = (mode == 0) ? 16 : 32;
        f32x4 bz[2][2];
#pragma unroll
        for (int bj = 0; bj < 2; ++bj)
#pragma unroll
            for (int n = 0; n < 2; ++n) bz[bj][n] = *(const f32x4*)(bias + (size_t)bb * NIN + colbase + d0 + bj * bjs + 4 * n);
        if (mode == 2) {
#pragma unroll
            for (int ai = 0; ai < 2; ++ai)
#pragma unroll
                for (int m = 0; m < 4; ++m) { const int row = row0 + ai * HALF + m * 16; bf16_t* rowp = P + (size_t)row * PP + colbase + d0; const float rstd = rs[ai][m];
#pragma unroll
                    for (int bj = 0; bj < 2; ++bj) *(u32x4*)(rowp + bj * bjs) = pack8(acc[ai][bj][m][0] * rstd + bz[bj][0], acc[ai][bj][m][1] * rstd + bz[bj][1]); }
            return;
        }
        f32x4 gw[2][2];
#pragma unroll
        for (int bj = 0; bj < 2; ++bj)
#pragma unroll
            for (int n = 0; n < 2; ++n) gw[bj][n] = *(const f32x4*)(gn + d0 + bj * bjs + 4 * n);
#pragma unroll
        for (int ai = 0; ai < 2; ++ai)
#pragma unroll
            for (int m = 0; m < 4; ++m) {
                const int row = row0 + ai * HALF + m * 16, t = row & (SEQ - 1);
                const float rs0 = rs[ai][m];
                f32x4 zz[2][2];
#pragma unroll
                for (int bj = 0; bj < 2; ++bj)
#pragma unroll
                    for (int n = 0; n < 2; ++n) zz[bj][n] = acc[ai][bj][m][n] * rs0 + bz[bj][n];
                float ss = 0.f;
#pragma unroll
                for (int bj = 0; bj < 2; ++bj)
#pragma unroll
                    for (int n = 0; n < 2; ++n) { const f32x4 x = zz[bj][n]; ss += (x[0] * x[0] + x[1] * x[1]) + (x[2] * x[2] + x[3] * x[3]); }
                ss += __shfl_xor(ss, 16); ss += __shfl_xor(ss, 32);
                const float rstd = __builtin_amdgcn_rsqf(ss * (1.0f / 64.0f) + EPS) ;
                const float* tb = (mode == 0) ? tabA + ((((fq >> 1) ? (t & 63) : (t >> 6)) * 16 + 8 * (fq & 1)) * 2) : tabB + ((t * 32 + 8 * fq) * 2);
                f32x4 cs[4];
#pragma unroll
                for (int i = 0; i < 4; ++i) cs[i] = *(const f32x4*)(tb + 4 * i);
                f32x4 o1[2], o2[2];
#pragma unroll
                for (int n = 0; n < 2; ++n) { const f32x4 y0 = zz[0][n] * rstd * gw[0][n], y1 = zz[1][n] * rstd * gw[1][n];
#pragma unroll
                    for (int j = 0; j < 4; ++j) { const float c = cs[2 * n + (j >> 1)][(j & 1) * 2], s = cs[2 * n + (j >> 1)][(j & 1) * 2 + 1];
                        o1[n][j] = (y0[j] * c - y1[j] * s) * scale; o2[n][j] = (y1[j] * c + y0[j] * s) * scale; } }
                bf16_t* rowp = P + (size_t)row * PP + colbase + d0;
                *(u32x4*)(rowp) = pack8(o1[0], o1[1]); *(u32x4*)(rowp + bjs) = pack8(o2[0], o2[1]);
                if (m & 1) asm volatile("" ::: "memory");
            }
    }
};
template <int PASS> struct EpiBr {
    static constexpr bool PERM = true, AFTER_DRAIN = false;
    bf16_t* MX; const bf16_t* P; int gcol;
    __device__ __forceinline__ void operator()(const f32x4 (&acc)[2][2][4][2], const Unit& u, int wr, int wc, int fr, int fq) const {
        const int row0 = u.pm * BM + wr * 64 + fr, col0 = u.pn * 256 + wc * 32 + 8 * fq;
#pragma unroll
        for (int ai = 0; ai < 2; ++ai)
#pragma unroll
            for (int m = 0; m < 4; ++m) { const size_t row = (size_t)(row0 + ai * HALF + m * 16);
#pragma unroll
                for (int bj = 0; bj < 2; ++bj) { const int c = col0 + bj * HALF;
                    const u32x4 gv = *(const u32x4*)(P + row * PP + gcol + c);
                    f32x4 v0 = acc[ai][bj][m][0], v1 = acc[ai][bj][m][1];
                    v0[0] *= bf_lo(gv.x); v0[1] *= bf_hi(gv.x); v0[2] *= bf_lo(gv.y); v0[3] *= bf_hi(gv.y);
                    v1[0] *= bf_lo(gv.z); v1[1] *= bf_hi(gv.z); v1[2] *= bf_lo(gv.w); v1[3] *= bf_hi(gv.w);
                    if (PASS == 1) { const u32x4 pv = *(const u32x4*)(MX + row * DM + c);
                        v0[0] += bf_lo(pv.x); v0[1] += bf_hi(pv.x); v0[2] += bf_lo(pv.y); v0[3] += bf_hi(pv.y);
                        v1[0] += bf_lo(pv.z); v1[1] += bf_hi(pv.z); v1[2] += bf_lo(pv.w); v1[3] += bf_hi(pv.w); }
                    *(u32x4*)(MX + row * DM + c) = pack8(v0, v1); }
                if (m & 1) asm volatile("" ::: "memory"); }
    }
};
struct EpiRes {
    static constexpr bool PERM = false, AFTER_DRAIN = false;
    const float* base; float* out; const float* gt;
    bf16_t* XS; const float* gs; float* rss;
    __device__ __forceinline__ void operator()(const f32x4 (&acc)[2][2][4][2], const Unit& u, int wr, int wc, int fr, int fq) const {
        const int row0 = u.pm * BM + wr * 64 + fr, col0 = u.pn * 256 + wc * 32 + 4 * fq; const int b = (u.pm * BM) / SEQ;
        f32x4 gv[2][2], gsv[2][2];
#pragma unroll
        for (int bj = 0; bj < 2; ++bj)
#pragma unroll
            for (int n = 0; n < 2; ++n) { gv[bj][n] = *(const f32x4*)(gt + (size_t)b * 6 * DM + col0 + bj * HALF + n * 16);
                gsv[bj][n] = XS ? *(const f32x4*)(gs + (size_t)b * DM + col0 + bj * HALF + n * 16) : (f32x4){0.f, 0.f, 0.f, 0.f}; }
#pragma unroll
        for (int ai = 0; ai < 2; ++ai)
#pragma unroll
            for (int m = 0; m < 4; ++m) { const int row = row0 + ai * HALF + m * 16; const size_t off = (size_t)row * DM + col0; float ss = 0.f;
#pragma unroll
                for (int bj = 0; bj < 2; ++bj)
#pragma unroll
                    for (int n = 0; n < 2; ++n) { const f32x4 bs = *(const f32x4*)(base + off + bj * HALF + n * 16);
                        const f32x4 o = bs + gv[bj][n] * acc[ai][bj][m][n];
                        *(f32x4*)(out + off + bj * HALF + n * 16) = o;
                        if (XS) { ss += (o[0] * o[0] + o[1] * o[1]) + (o[2] * o[2] + o[3] * o[3]); const f32x4 xs = o * gsv[bj][n];
                            u32x2 w; w.x = cvt_pk_bf16(xs[0], xs[1]); w.y = cvt_pk_bf16(xs[2], xs[3]); *(u32x2*)(XS + off + bj * HALF + n * 16) = w; } }
                if (XS) { ss += __shfl_xor(ss, 16); ss += __shfl_xor(ss, 32); if (fq == 0) rss[(size_t)row * 16 + u.pn * 4 + wc] = ss; }
                if (m & 1) asm volatile("" ::: "memory"); }
    }
};
struct EpiRelu2 {
    static constexpr bool PERM = true, AFTER_DRAIN = false;
    bf16_t* H; const float* rss; const float* bias;
    __device__ __forceinline__ void operator()(const f32x4 (&acc)[2][2][4][2], const Unit& u, int wr, int wc, int fr, int fq) const {
        const int row0 = u.pm * BM + wr * 64 + fr, col0 = u.pn * 256 + wc * 32 + 8 * fq; const int b = (u.pm * BM) / SEQ;
        float rs[2][4]; rows_rstd(rss, row0, fq, rs);
        f32x4 bv[2][2];
#pragma unroll
        for (int bj = 0; bj < 2; ++bj)
#pragma unroll
            for (int n = 0; n < 2; ++n) bv[bj][n] = *(const f32x4*)(bias + (size_t)b * FF + col0 + bj * HALF + 4 * n);
#pragma unroll
        for (int ai = 0; ai < 2; ++ai)
#pragma unroll
            for (int m = 0; m < 4; ++m) { const int row = row0 + ai * HALF + m * 16; bf16_t* rowp = H + (size_t)row * FF + col0; const float rstd = rs[ai][m];
#pragma unroll
                for (int bj = 0; bj < 2; ++bj) { f32x4 v0 = acc[ai][bj][m][0] * rstd + bv[bj][0], v1 = acc[ai][bj][m][1] * rstd + bv[bj][1];
#pragma unroll
                    for (int j = 0; j < 4; ++j) { const float a = fmaxf(v0[j], 0.f), b = fmaxf(v1[j], 0.f); v0[j] = a * a; v1[j] = b * b; }
                    *(u32x4*)(rowp + bj * HALF) = pack8(v0, v1); } }
    }
};

template <class Epi, class Sched, bool ALIGN_EPI, bool SP2, int KC, int LDA>
__device__ __forceinline__ void gemm_phase(const int tid, PG8_LAS unsigned char* lds, const Gemm g, const Sched& S, const Epi& E) {
    const int wid = __builtin_amdgcn_readfirstlane(tid >> 6), lane = tid & 63, wr = wid >> 2, wc = wid & 3, fr = lane & 15, fq = lane >> 4;
    constexpr int K = KC, nt = K / BK;
    unsigned voffA[2], voffB[2];
#pragma unroll
    for (int i = 0; i < 2; ++i) { int R, C; stage_rc(tid * 16 + i * 8192, R, C); const int Rb = Epi::PERM ? ((R & ~31) + perm32(R & 31)) : R;
        voffA[i] = (unsigned)(R * LDA + C) * 2u; voffB[i] = (unsigned)(Rb * K + C) * 2u; }
    constexpr size_t kstep = (size_t)(BK * 2);
    constexpr size_t hstep = (size_t)HALF * K * 2, hstepA = (size_t)HALF * LDA * 2;
    constexpr size_t tstep = 2 * hstep, tstepA = 2 * hstepA;
    const unsigned ldsw = (unsigned)wid * 1024u;
    const int aoff = lds_byte(wr * 64 + fr, fq * 8), boff = lds_byte(wc * 32 + fr, fq * 8);
#define PG8_SA(b, h) (((b) * 2 + (h)) * HTB)
#define PG8_SB(b, h) ((4 + (b) * 2 + (h)) * HTB)
#define PG8_STAGE(bufoff, gbase, voff) do { _Pragma("unroll") for (int _i = 0; _i < 2; ++_i) \
        __builtin_amdgcn_global_load_lds((const unsigned*)((const char*)(gbase) + (voff)[_i]), (PG8_LAS unsigned*)(lds + (bufoff) + ldsw + _i * 8192), 16, 0, 0); } while (0)
#define PG8_LDA(dst, b, h) do { _Pragma("unroll") for (int m = 0; m < 4; ++m) _Pragma("unroll") for (int k = 0; k < 2; ++k) dst[m][k] = *(const PG8_LAS bf16x8*)(lds + PG8_SA(b, h) + aoff + m * 2048 + k * 1024); } while (0)
#define PG8_LDB(dst, b, h) do { _Pragma("unroll") for (int n = 0; n < 2; ++n) _Pragma("unroll") for (int k = 0; k < 2; ++k) dst[n][k] = *(const PG8_LAS bf16x8*)(lds + PG8_SB(b, h) + boff + n * 2048 + k * 1024); } while (0)
#define PG8_MMA(ai, bj, At, Bt) do { __builtin_amdgcn_s_setprio(1); _Pragma("unroll") for (int m = 0; m < 4; ++m) _Pragma("unroll") for (int n = 0; n < 2; ++n) _Pragma("unroll") for (int k = 0; k < 2; ++k) \
        acc[ai][bj][m][n] = __builtin_amdgcn_mfma_f32_16x16x32_bf16(Bt[n][k], At[m][k], acc[ai][bj][m][n], 0, 0, 0); __builtin_amdgcn_s_setprio(0); } while (0)
#define PG8_WAIT_V(n) asm volatile("s_waitcnt vmcnt(" #n ")" ::: "memory")
#define PG8_WAIT_L(n) asm volatile("s_waitcnt lgkmcnt(" #n ")" ::: "memory")
#define PG8_BAR __builtin_amdgcn_s_barrier()
#define PG8_SCHED __builtin_amdgcn_sched_barrier(0)
    Unit cur, nxt; int ui = 0;
    if (!S.next(0, cur)) return;
    f32x4 acc[2][2][4][2];
#pragma unroll
    for (int a = 0; a < 2; ++a)
#pragma unroll
        for (int b = 0; b < 2; ++b)
#pragma unroll
            for (int m = 0; m < 4; ++m)
#pragma unroll
                for (int n = 0; n < 2; ++n) acc[a][b][m][n] = (f32x4){0.f, 0.f, 0.f, 0.f};
    bf16x8 At[4][2], B0[2][2], B1[2][2];
    const char* cA = (const char*)g.A + (size_t)cur.pm * tstepA; const char* cB = (const char*)g.Bt + (size_t)cur.pn * tstep;
    S.a_ready(cur);
    if constexpr (SP2) {
        PG8_STAGE(PG8_SB(0, 0), cB, voffB); PG8_STAGE(PG8_SB(0, 1), cB + hstep, voffB); PG8_STAGE(PG8_SA(0, 0), cA, voffA); PG8_STAGE(PG8_SA(0, 1), cA + hstepA, voffA);
        if (wr == 1) PG8_BAR;
        PG8_WAIT_V(2); PG8_BAR;
        PG8_STAGE(PG8_SB(1, 0), cB + kstep, voffB); PG8_STAGE(PG8_SA(1, 0), cA + kstep, voffA); PG8_STAGE(PG8_SB(1, 1), cB + hstep + kstep, voffB);
        PG8_WAIT_V(6); PG8_BAR;
    } else {
        PG8_STAGE(PG8_SB(0, 0), cB, voffB); PG8_STAGE(PG8_SA(0, 0), cA, voffA); PG8_STAGE(PG8_SB(0, 1), cB + hstep, voffB); PG8_STAGE(PG8_SA(0, 1), cA + hstepA, voffA);
        if (wr == 1) PG8_BAR;
        PG8_WAIT_V(4); PG8_BAR;
        PG8_STAGE(PG8_SB(1, 0), cB + kstep, voffB); PG8_STAGE(PG8_SA(1, 0), cA + kstep, voffA); PG8_STAGE(PG8_SB(1, 1), cB + hstep + kstep, voffB);
        PG8_WAIT_V(6); PG8_BAR;
    }
    for (;;) {
        const bool has_next = S.next(ui + 1, nxt);
        const char* nA = has_next ? (const char*)g.A + (size_t)nxt.pm * tstepA : cA; const char* nB = has_next ? (const char*)g.Bt + (size_t)nxt.pn * tstep : cB;
#pragma unroll 1
        for (int t = 0; t < nt; t += 2) {
            const bool last = (t == nt - 2);
            const char* a1 = cA + (size_t)(t + 1) * kstep;
            const char* a2 = last ? nA : cA + (size_t)(t + 2) * kstep; const char* b2 = last ? nB : cB + (size_t)(t + 2) * kstep;
            const char* a3 = a2 + kstep; const char* b3 = b2 + kstep;
            if (last && has_next) S.a_ready(nxt);
            if constexpr (SP2) {
            PG8_LDB(B0, 0, 0); PG8_LDB(B1, 0, 1); PG8_SCHED; PG8_LDA(At, 0, 0); PG8_STAGE(PG8_SA(1, 1), a1 + hstepA, voffA);
            PG8_WAIT_V(8); PG8_WAIT_L(0); PG8_BAR; PG8_MMA(0, 0, At, B0); PG8_MMA(0, 1, At, B1); PG8_BAR; PG8_SCHED;
            PG8_LDA(At, 0, 1); PG8_STAGE(PG8_SB(0, 0), b2, voffB); PG8_STAGE(PG8_SB(0, 1), b2 + hstep, voffB); PG8_STAGE(PG8_SA(0, 0), a2, voffA);
            PG8_WAIT_V(8); PG8_WAIT_L(0); PG8_BAR; PG8_MMA(1, 0, At, B0); PG8_MMA(1, 1, At, B1); PG8_BAR; PG8_SCHED;
            PG8_LDB(B0, 1, 0); PG8_LDB(B1, 1, 1); PG8_SCHED; PG8_LDA(At, 1, 0); PG8_STAGE(PG8_SA(0, 1), a2 + hstepA, voffA);
            PG8_WAIT_V(8); PG8_WAIT_L(0); PG8_BAR; PG8_MMA(0, 0, At, B0); PG8_MMA(0, 1, At, B1); PG8_BAR; PG8_SCHED;
            PG8_LDA(At, 1, 1); PG8_STAGE(PG8_SB(1, 0), b3, voffB); PG8_STAGE(PG8_SB(1, 1), b3 + hstep, voffB); PG8_STAGE(PG8_SA(1, 0), a3, voffA);
            PG8_WAIT_V(8); PG8_WAIT_L(0); PG8_BAR; PG8_MMA(1, 0, At, B0); PG8_MMA(1, 1, At, B1); PG8_BAR; PG8_SCHED;
            } else {
            PG8_LDB(B0, 0, 0); PG8_SCHED; PG8_LDA(At, 0, 0); PG8_STAGE(PG8_SA(1, 1), a1 + hstepA, voffA);
            PG8_WAIT_L(8); PG8_BAR; PG8_WAIT_L(0); PG8_MMA(0, 0, At, B0); PG8_BAR; PG8_SCHED;
            PG8_LDB(B1, 0, 1); PG8_STAGE(PG8_SB(0, 0), b2, voffB);
            PG8_BAR; PG8_WAIT_L(0); PG8_MMA(0, 1, At, B1); PG8_BAR;
            PG8_LDA(At, 0, 1); PG8_STAGE(PG8_SA(0, 0), a2, voffA);
            PG8_BAR; PG8_WAIT_L(0); PG8_MMA(1, 0, At, B0); PG8_BAR; PG8_SCHED;
            PG8_STAGE(PG8_SB(0, 1), b2 + hstep, voffB);
            PG8_WAIT_V(6); PG8_BAR; PG8_MMA(1, 1, At, B1); PG8_BAR;
            PG8_LDB(B0, 1, 0); PG8_SCHED; PG8_LDA(At, 1, 0); PG8_STAGE(PG8_SA(0, 1), a2 + hstepA, voffA);
            PG8_WAIT_L(8); PG8_BAR; PG8_WAIT_L(0); PG8_MMA(0, 0, At, B0); PG8_BAR; PG8_SCHED;
            PG8_LDB(B1, 1, 1); PG8_STAGE(PG8_SB(1, 0), b3, voffB);
            PG8_BAR; PG8_WAIT_L(0); PG8_MMA(0, 1, At, B1); PG8_BAR;
            PG8_LDA(At, 1, 1); PG8_STAGE(PG8_SA(1, 0), a3, voffA);
            PG8_BAR; PG8_WAIT_L(0); PG8_MMA(1, 0, At, B0); PG8_BAR; PG8_SCHED;
            PG8_STAGE(PG8_SB(1, 1), b3 + hstep, voffB);
            PG8_WAIT_V(6); PG8_BAR; PG8_MMA(1, 1, At, B1); PG8_BAR;
            }
        }
        if constexpr (ALIGN_EPI) { if (wr == 0) PG8_BAR; }
        if constexpr (!Epi::AFTER_DRAIN) { E(acc, cur, wr, wc, fr, fq); S.done(cur); }
        if (!has_next) break;
#pragma unroll
        for (int a = 0; a < 2; ++a)
#pragma unroll
            for (int b = 0; b < 2; ++b)
#pragma unroll
                for (int m = 0; m < 4; ++m)
#pragma unroll
                    for (int n = 0; n < 2; ++n) acc[a][b][m][n] = (f32x4){0.f, 0.f, 0.f, 0.f};
        cur = nxt; cA = nA; cB = nB; ++ui;
        if constexpr (ALIGN_EPI) { if (wr == 1) PG8_BAR; }
    }
    PG8_WAIT_V(0);
    if constexpr (!ALIGN_EPI) { if (wr == 0) PG8_BAR; }
    PG8_BAR;
    if constexpr (Epi::AFTER_DRAIN) { E.fused(acc, cur, wr, wc, fr, fq, lds, wid, lane); S.done(cur); }
#undef PG8_SA
#undef PG8_SB
#undef PG8_STAGE
#undef PG8_LDA
#undef PG8_LDB
#undef PG8_MMA
#undef PG8_WAIT_V
#undef PG8_WAIT_L
#undef PG8_BAR
#undef PG8_SCHED
}
}
namespace attn_body {
using bf16=__hip_bfloat16;
using bf16x8=__attribute__((ext_vector_type(8)))short;
using s16x4=__attribute__((ext_vector_type(4)))short;
using f32x16=__attribute__((ext_vector_type(16)))float;
using u32x4=__attribute__((ext_vector_type(4)))unsigned;
constexpr int BATCH=8,NHEAD=8,SEQ=4096,D=64,DM=5120;
constexpr int NW=8,QBLK=32,QB=QBLK*NW,KVBLK=64,NQB=SEQ/QB;
constexpr int ATTN_PITCH=DM, ATTN_UNIT_ROWS=QB;
__device__ __forceinline__ int crow(int r,int hi){return (r&3)+8*(r>>2)+4*hi;}
#define SBAR() __builtin_amdgcn_sched_barrier(0)
__device__ __forceinline__ void cmask(f32x16&p0,f32x16&p1,int jb,int qrel,int hi){
  const float NEG=-INFINITY; int kb=64*jb+4*hi;
  #pragma unroll
  for(int r=0;r<16;++r){int kv=kb+(r&3)+8*(r>>2); if(kv>qrel)p0[r]=NEG; if(kv+32>qrel)p1[r]=NEG;}
}

constexpr int NSLOT=3, SLOTB=8192;
constexpr int LDS_K=0, LDS_V=NSLOT*SLOTB, LDS_WS=2*NSLOT*SLOTB, LDS_OST=LDS_WS+NW*64*4, LDS_BYTES=LDS_OST+NW*4096;
constexpr float C2=0.125f*1.4426950408889634f;
__device__ __forceinline__ void glds16(const void*gsrc,unsigned lds_dst){unsigned keep;
  asm volatile("s_mov_b32 %0, m0\n\ts_mov_b32 m0, %2\n\ts_nop 0\n\tglobal_load_lds_dwordx4 %1, off\n\ts_mov_b32 m0, %0":"=&s"(keep):"v"(gsrc),"s"(lds_dst):"memory");}
__device__ __forceinline__ float max3f(float a,float b,float c){float r;asm("v_max3_f32 %0, %1, %2, %3":"=v"(r):"v"(a),"v"(b),"v"(c));return r;}
__device__ __forceinline__ float max2f(float a,float b){float r;asm("v_max_f32_e32 %0, %1, %2":"=v"(r):"v"(a),"v"(b));return r;}
__device__ __forceinline__ float fadd_s(float a,float b){float r;asm("v_add_f32_e32 %0, %1, %2":"=v"(r):"v"(a),"v"(b));return r;}
__device__ __forceinline__ float fsub_s(float a,float b){float r;asm("v_sub_f32_e32 %0, %1, %2":"=v"(r):"v"(a),"v"(b));return r;}
typedef float f32x2_t __attribute__((ext_vector_type(2))); typedef __bf16 bf16x2_t __attribute__((ext_vector_type(2)));
__device__ __forceinline__ unsigned cvtpk_s(float lo,float hi){f32x2_t v={lo,hi};bf16x2_t b=__builtin_convertvector(v,bf16x2_t);return __builtin_bit_cast(unsigned,b);}
#define WAIT_BAR(N) asm volatile("s_waitcnt vmcnt(" #N ") lgkmcnt(0)\n\ts_barrier":::"memory")

__device__ __forceinline__ void qkt(f32x16&p0,f32x16&p1,const char*Kslot,const bf16x8*qr,const f32x16&negm,int r32,int hi){
  const char*kb=Kslot+hi*1024+r32*16;
  #pragma unroll
  for(int d0=0;d0<4;++d0){
    const bf16x8 b0=*reinterpret_cast<const bf16x8*>(kb+d0*2048);
    const bf16x8 b1=*reinterpret_cast<const bf16x8*>(kb+d0*2048+512);
    if(d0==0){p0=__builtin_amdgcn_mfma_f32_32x32x16_bf16(b0,qr[0],negm,0,0,0);p1=__builtin_amdgcn_mfma_f32_32x32x16_bf16(b1,qr[0],negm,0,0,0);}
    else{p0=__builtin_amdgcn_mfma_f32_32x32x16_bf16(b0,qr[d0],p0,0,0,0);p1=__builtin_amdgcn_mfma_f32_32x32x16_bf16(b1,qr[d0],p1,0,0,0);}}
}
typedef __attribute__((address_space(3))) const char* lds_cptr;
typedef short v4i16_t __attribute__((ext_vector_type(4)));
__device__ __forceinline__ void kload8(bf16x8*kf,lds_cptr kp){
  kf[0]=*(const __attribute__((address_space(3))) bf16x8*)(kp);      kf[1]=*(const __attribute__((address_space(3))) bf16x8*)(kp+512);
  kf[2]=*(const __attribute__((address_space(3))) bf16x8*)(kp+2048); kf[3]=*(const __attribute__((address_space(3))) bf16x8*)(kp+2560);
  kf[4]=*(const __attribute__((address_space(3))) bf16x8*)(kp+4096); kf[5]=*(const __attribute__((address_space(3))) bf16x8*)(kp+4608);
  kf[6]=*(const __attribute__((address_space(3))) bf16x8*)(kp+6144); kf[7]=*(const __attribute__((address_space(3))) bf16x8*)(kp+6656);
}
__device__ __forceinline__ void kload2(bf16x8*kf,lds_cptr kp,int j){ kf[2*j]=*(const __attribute__((address_space(3))) bf16x8*)(kp+j*2048); kf[2*j+1]=*(const __attribute__((address_space(3))) bf16x8*)(kp+j*2048+512); }
__device__ __forceinline__ s16x4 vtr(lds_cptr p){ return __builtin_bit_cast(s16x4,__builtin_amdgcn_ds_read_tr16_b64_v4i16((__attribute__((address_space(3))) v4i16_t*)p)); }
__device__ __forceinline__ float rowmax(const f32x16&p0,const f32x16&p1){
  float a=max3f(p0[0],p0[1],p1[0]),b=max3f(p0[2],p0[3],p1[1]);a=max3f(a,p1[2],p1[3]);
  #pragma unroll
  for(int r=4;r<16;r+=4){a=max3f(a,p0[r],p0[r+1]);b=max3f(b,p0[r+2],p0[r+3]);a=max3f(a,p1[r],p1[r+1]);b=max3f(b,p1[r+2],p1[r+3]);}
  const float m=max2f(a,b);
  auto rr=__builtin_amdgcn_permlane32_swap(__float_as_uint(m),__float_as_uint(m),false,false);
  return max2f(__uint_as_float(rr[0]),__uint_as_float(rr[1]));
}
__device__ __forceinline__ void pv(f32x16*o,int vb,bf16x8 pa0,bf16x8 pa1,bf16x8 pa2,bf16x8 pa3){
  #pragma unroll
  for(int d0=0;d0<2;++d0){s16x4 lo[4],hi[4];
    #pragma unroll
    for(int ks=0;ks<4;++ks){
      asm volatile("ds_read_b64_tr_b16 %0,%1 offset:%c2":"=&v"(lo[ks]):"v"(vb),"i"(d0*4096+ks*1024):"memory");
      asm volatile("ds_read_b64_tr_b16 %0,%1 offset:%c2":"=&v"(hi[ks]):"v"(vb),"i"(d0*4096+ks*1024+512):"memory");}
    asm volatile("s_waitcnt lgkmcnt(0)":::"memory");SBAR();
    #define PK(k) (bf16x8){lo[k][0],lo[k][1],lo[k][2],lo[k][3],hi[k][0],hi[k][1],hi[k][2],hi[k][3]}
    o[d0]=__builtin_amdgcn_mfma_f32_32x32x16_bf16(pa0,PK(0),o[d0],0,0,0);
    o[d0]=__builtin_amdgcn_mfma_f32_32x32x16_bf16(pa1,PK(1),o[d0],0,0,0);
    o[d0]=__builtin_amdgcn_mfma_f32_32x32x16_bf16(pa2,PK(2),o[d0],0,0,0);
    o[d0]=__builtin_amdgcn_mfma_f32_32x32x16_bf16(pa3,PK(3),o[d0],0,0,0);
    #undef PK
  }
}

#ifndef ATTN_STORE16
#define ATTN_STORE16(p,v) (*(u32x4*)(p)=(v))
#endif
template<int THRL> __device__ __forceinline__ void attn_unit(int b,int h,int qb,const bf16*Q,const bf16*__restrict__ K,const bf16*__restrict__ V,bf16*O,char*shm,const int tid){
  const int lane=tid&63,r32=lane&31,hi=lane>>5; const int wid=__builtin_amdgcn_readfirstlane(tid>>6);
  const long rowbase=(long)b*SEQ; const int q0=qb*QB;
  const bf16*Qw=Q+(rowbase+q0+wid*QBLK)*DM+h*D;
  const bf16*Kh=K+rowbase*DM+(h>>2)*D,*Vh=V+rowbase*DM+(h>>2)*D;
  const unsigned lds0=(unsigned)(uintptr_t)shm;
  float*wsf=(float*)(shm+LDS_WS)+wid*64;
  const bf16*ksrc=Kh+(long)lane*DM+wid*8;
  const bf16*vsrc=Vh+(long)(16*(wid&3)+(lane>>2))*DM+(wid>>2)*32+(lane&3)*8;
  const unsigned kdst=lds0+LDS_K+wid*1024, vdst=lds0+LDS_V+wid*1024;
  #define DMA_K(t,slot) glds16(ksrc+(long)(t)*KVBLK*DM,(unsigned)__builtin_amdgcn_readfirstlane(kdst+(slot)))
  #define DMA_V(t,slot) glds16(vsrc+(long)(t)*KVBLK*DM,(unsigned)__builtin_amdgcn_readfirstlane(vdst+(slot)))
  const int vb0=(int)(lds0+LDS_V)+((lane>>4)&1)*32+(lane&3)*8+(4*hi+((lane&15)>>2))*64;
  const char*Kbase=shm+LDS_K; bf16x8 kf[8];
  const lds_cptr shm3=(lds_cptr)shm; const lds_cptr kp0=shm3+LDS_K+hi*1024+r32*16; const lds_cptr vp0=shm3+LDS_V+((lane>>4)&1)*32+(lane&3)*8+(4*hi+((lane&15)>>2))*64;
  const int NT=SEQ/KVBLK;
  DMA_K(0,0);DMA_V(0,0);DMA_K(1,SLOTB);
  bf16x8 qr[4];
  #pragma unroll
  for(int d0=0;d0<4;++d0)qr[d0]=*reinterpret_cast<const bf16x8*>(&Qw[(long)r32*DM+d0*16+hi*8]);
  float mhat=0.f,l_reg=0.f;f32x16 o[2];o[0]=f32x16{};o[1]=f32x16{};f32x16 negm=f32x16{};asm volatile("":"+v"(negm));
  const int qrel=wid*QBLK+r32;
  #define CMASK(P0,P1,t) do{}while(0)
  bool resc=false;
  #define START(P0,P1) do{ const float rm=rowmax(P0,P1); resc=false; \
    { const float dl=rm; mhat=fadd_s(mhat,dl); \
      _Pragma("unroll") for(int r=0;r<16;++r){P0[r]=fsub_s(P0[r],dl);P1[r]=fsub_s(P1[r],dl);} \
      _Pragma("unroll") for(int r=0;r<16;++r)negm[r]=-mhat; asm volatile("":"+v"(negm)); } \
    _Pragma("unroll") for(int r=0;r<16;++r)P0[r]=__builtin_amdgcn_exp2f(P0[r]); }while(0)
  #define RESC() do{ if(resc){ asm volatile("s_waitcnt lgkmcnt(0)":::"memory"); \
      _Pragma("unroll") for(int d_=0;d_<2;++d_) _Pragma("unroll") for(int r=0;r<16;++r)o[d_][r]*=wsf[crow(r,hi)]; } }while(0)
  f32x16 pA0,pA1,pB0,pB1;
  int sl_prev=0,sl_cur=0,sl_next=SLOTB;
  #define ROT() do{sl_prev=sl_cur;sl_cur=sl_next;sl_next=(sl_next==(NSLOT-1)*SLOTB)?0:sl_next+SLOTB;}while(0)
  DMA_K(2,2*SLOTB);
  WAIT_BAR(3);
  qkt(pA0,pA1,Kbase,qr,negm,r32,hi);asm volatile("s_nop 15\n\ts_nop 7":"+v"(pA0),"+v"(pA1));CMASK(pA0,pA1,0);
  START(pA0,pA1);
  _Pragma("unroll") for(int r=0;r<16;++r)pA1[r]=__builtin_amdgcn_exp2f(pA1[r]);
  WAIT_BAR(0);
  DMA_K(3,0);DMA_V(1,SLOTB);
  ROT();
  kload8(kf,kp0+sl_cur);
  WAIT_BAR(2);
  s16x4 vlo[8],vhi[8]; u32x4 pw0,pw1,pw2,pw3;
  #define PKW(P,B) cvtpk_s(P[B],P[B+1])
  #define PAF(k) __builtin_bit_cast(bf16x8,pw##k)
  #define VFR(i) (bf16x8){vlo[i][0],vlo[i][1],vlo[i][2],vlo[i][3],vhi[i][0],vhi[i][1],vhi[i][2],vhi[i][3]}
  #define PIN(x) asm volatile("":"+v"(x))
  #define MX3(a,b,c) __builtin_fmaxf(__builtin_fmaxf((a),(b)),(c))
  #define GAPA(MF,A0,A1,A2,A3,W0,W1,PW) do{ MF; sacc+=A0; sacc+=A1; sacc+=A2; sacc+=A3; PIN(sacc); W0; W1; PIN(PW); SBAR(); }while(0)
  #define EX(v) __builtin_amdgcn_exp2f(v)
  #define GAPB(MF,X,B) do{ MF; X[B]=EX(X[B]); X[B+1]=EX(X[B+1]); X[B+2]=EX(X[B+2]); X[B+3]=EX(X[B+3]); PIN(X); SBAR(); }while(0)
  #define VRD(i) do{ vlo[i]=vtr(vp_+(((i)>>2)*4096+((i)&3)*1024)); vhi[i]=vtr(vp_+(((i)>>2)*4096+((i)&3)*1024+512)); }while(0)
  #define KRD(G,j) do{ if(G){ kload2(kf,kp0+sl_next,j); SBAR(); } }while(0)
  #define STEP(C0,C1,P0,P1,t,GK,GV,GL) do{ SBAR(); \
    const lds_cptr vp_=vp0+sl_prev; \
    VRD(0); SBAR(); float sacc=(P0[0]+P0[1]); \
    GAPA(C0=__builtin_amdgcn_mfma_f32_32x32x16_bf16(kf[0],qr[0],negm,0,0,0), P0[2],P0[3],P0[4],P0[5],     pw0[0]=PKW(P0,0), pw0[1]=PKW(P0,2), pw0); \
    VRD(4); SBAR(); GAPA(C1=__builtin_amdgcn_mfma_f32_32x32x16_bf16(kf[1],qr[0],negm,0,0,0), P0[6],P0[7],P0[8],P0[9],     pw0[2]=PKW(P0,4), pw0[3]=PKW(P0,6), pw0); \
    VRD(1); SBAR(); GAPA(C0=__builtin_amdgcn_mfma_f32_32x32x16_bf16(kf[2],qr[1],C0,0,0,0),   P0[10],P0[11],P0[12],P0[13], pw1[0]=PKW(P0,8), pw1[1]=PKW(P0,10), pw1); \
    VRD(5); SBAR(); GAPA(C1=__builtin_amdgcn_mfma_f32_32x32x16_bf16(kf[3],qr[1],C1,0,0,0),   P0[14],P0[15],P1[0],P1[1],   pw1[2]=PKW(P0,12),pw1[3]=PKW(P0,14), pw1); \
    VRD(2); SBAR(); GAPA(C0=__builtin_amdgcn_mfma_f32_32x32x16_bf16(kf[4],qr[2],C0,0,0,0),   P1[2],P1[3],P1[4],P1[5],     pw2[0]=PKW(P1,0), pw2[1]=PKW(P1,2), pw2); \
    VRD(6); SBAR(); GAPA(C1=__builtin_amdgcn_mfma_f32_32x32x16_bf16(kf[5],qr[2],C1,0,0,0),   P1[6],P1[7],P1[8],P1[9],     pw2[2]=PKW(P1,4), pw2[3]=PKW(P1,6), pw2); \
    VRD(3); SBAR(); GAPA(C0=__builtin_amdgcn_mfma_f32_32x32x16_bf16(kf[6],qr[3],C0,0,0,0),   P1[10],P1[11],P1[12],P1[13], pw3[0]=PKW(P1,8), pw3[1]=PKW(P1,10), pw3); \
    VRD(7); SBAR(); GAPA(C1=__builtin_amdgcn_mfma_f32_32x32x16_bf16(kf[7],qr[3],C1,0,0,0),   P1[14],P1[15],0.f,0.f,       pw3[2]=PKW(P1,12),pw3[3]=PKW(P1,14), pw3); \
    l_reg+=sacc; \
    if(GK){DMA_K((t)+3,sl_cur);} if(GV){DMA_V((t)+1,sl_next);} \
    CMASK(C0,C1,t); \
    { float a=MX3(C0[0],C0[1],C1[0]),b=MX3(C0[2],C0[3],C1[1]); a=MX3(a,C1[2],C1[3]); \
      _Pragma("unroll") for(int r=4;r<16;r+=4){a=MX3(a,C0[r],C0[r+1]);b=MX3(b,C0[r+2],C0[r+3]);a=MX3(a,C1[r],C1[r+1]);b=MX3(b,C1[r+2],C1[r+3]);} \
      float rm=__builtin_fmaxf(a,b); { auto rr=__builtin_amdgcn_permlane32_swap(__float_as_uint(rm),__float_as_uint(rm),false,false); rm=__builtin_fmaxf(__uint_as_float(rr[0]),__uint_as_float(rr[1])); } \
      resc=false; \
      if(__builtin_expect(__any(rm>(float)THRL),0)){ const float dl=__builtin_fmaxf(rm,0.f); mhat+=dl; \
        _Pragma("unroll") for(int r=0;r<16;++r){C0[r]-=dl;C1[r]-=dl;} \
        _Pragma("unroll") for(int r=0;r<16;++r)negm[r]=-mhat; asm volatile("":"+v"(negm)); \
        const float f=__builtin_amdgcn_exp2f(-dl); l_reg*=f; if(hi==0)wsf[r32]=f; resc=true; } } \
    SBAR(); \
    GAPB(o[0]=__builtin_amdgcn_mfma_f32_32x32x16_bf16(PAF(0),VFR(0),o[0],0,0,0), C0,0); \
    GAPB(o[1]=__builtin_amdgcn_mfma_f32_32x32x16_bf16(PAF(0),VFR(4),o[1],0,0,0), C0,4); \
    KRD(GL,0); GAPB(o[0]=__builtin_amdgcn_mfma_f32_32x32x16_bf16(PAF(1),VFR(1),o[0],0,0,0), C0,8); \
    KRD(GL,1); GAPB(o[1]=__builtin_amdgcn_mfma_f32_32x32x16_bf16(PAF(1),VFR(5),o[1],0,0,0), C0,12); \
    KRD(GL,2); GAPB(o[0]=__builtin_amdgcn_mfma_f32_32x32x16_bf16(PAF(2),VFR(2),o[0],0,0,0), C1,0); \
    KRD(GL,3); GAPB(o[1]=__builtin_amdgcn_mfma_f32_32x32x16_bf16(PAF(2),VFR(6),o[1],0,0,0), C1,4); \
    GAPB(o[0]=__builtin_amdgcn_mfma_f32_32x32x16_bf16(PAF(3),VFR(3),o[0],0,0,0), C1,8); \
    GAPB(o[1]=__builtin_amdgcn_mfma_f32_32x32x16_bf16(PAF(3),VFR(7),o[1],0,0,0), C1,12); \
    }while(0)
  int t=1;
  #undef CMASK
  #define CMASK(P0,P1,t) do{}while(0)
  for(;t+5<NT;t+=2){
    STEP(pB0,pB1,pA0,pA1,t,true,true,true);     WAIT_BAR(2); RESC(); ROT();
    STEP(pA0,pA1,pB0,pB1,t+1,true,true,true);   WAIT_BAR(2); RESC(); ROT();
  }
  #undef CMASK
  #define CMASK(P0,P1,t) do{}while(0)
  #define ENDW(tt) do{ if((tt)+3<NT){WAIT_BAR(2);} else if((tt)+2<NT){WAIT_BAR(1);} else {WAIT_BAR(0);} }while(0)
  for(;t+1<NT;t+=2){
    STEP(pB0,pB1,pA0,pA1,t,(t+3<NT),(t+1<NT),(t+1<NT));       ENDW(t);   RESC(); ROT();
    STEP(pA0,pA1,pB0,pB1,t+1,(t+4<NT),(t+2<NT),(t+2<NT));     ENDW(t+1); RESC(); ROT();
  }
  STEP(pB0,pB1,pA0,pA1,NT-1,false,false,false); RESC();
  { float sacc=pB0[0]+pB0[1]; _Pragma("unroll") for(int r=2;r<16;++r)sacc+=pB0[r]; _Pragma("unroll") for(int r=0;r<16;++r)sacc+=pB1[r]; l_reg+=sacc;
    pw0=(u32x4){PKW(pB0,0),PKW(pB0,2),PKW(pB0,4),PKW(pB0,6)};pw1=(u32x4){PKW(pB0,8),PKW(pB0,10),PKW(pB0,12),PKW(pB0,14)};pw2=(u32x4){PKW(pB1,0),PKW(pB1,2),PKW(pB1,4),PKW(pB1,6)};pw3=(u32x4){PKW(pB1,8),PKW(pB1,10),PKW(pB1,12),PKW(pB1,14)};
    SBAR(); pv(o,vb0+sl_cur,PAF(0),PAF(1),PAF(2),PAF(3)); }
  #undef PKW
  #undef PAF
  #undef VFR
  #undef PIN
  #undef MX3
  #undef GAPA
  #undef GAPB
  #undef EX
  #undef VRD
  #undef KRD
  #undef STEP
  #undef ENDW
  {auto rr=__builtin_amdgcn_permlane32_swap(__float_as_uint(l_reg),__float_as_uint(l_reg),false,false);l_reg=__uint_as_float(rr[0])+__uint_as_float(rr[1]);}
  if(hi==0)wsf[32+r32]=l_reg;asm volatile("s_waitcnt lgkmcnt(0)":::"memory");
  float rli[16];
  #pragma unroll
  for(int r=0;r<16;++r)rli[r]=__builtin_amdgcn_rcpf(wsf[32+crow(r,hi)]);
  bf16*Ow=O+(rowbase+q0+wid*QBLK)*DM+h*D;
  { bf16*stg=(bf16*)(shm+LDS_OST)+wid*2048;
    #pragma unroll
    for(int r=0;r<16;++r){const int orow=crow(r,hi);
      #pragma unroll
      for(int d0=0;d0<2;++d0)stg[orow*64+d0*32+r32]=__float2bfloat16(o[d0][r]*rli[r]);}
    asm volatile("s_waitcnt lgkmcnt(0)":::"memory");
    #pragma unroll
    for(int i=0;i<4;++i){const int row=i*8+(lane>>3),ch=lane&7; const u32x4 v=*(const u32x4*)(stg+row*64+ch*8); ATTN_STORE16(Ow+(long)row*DM+ch*8,v);} }
  asm volatile("s_waitcnt lgkmcnt(0)\n\ts_barrier":::"memory");
  #undef DMA_K
  #undef DMA_V
  #undef CMASK
  #undef START
  #undef RESC
  #undef ROT
}
constexpr int ATTN_LDS_BYTES=LDS_BYTES;
#undef SBAR
#undef WAIT_BAR
}
namespace dil {
#define DLAS __attribute__((address_space(3)))
typedef unsigned short bf16_t;
typedef short bf16x8 __attribute__((ext_vector_type(8)));
typedef short s16x4 __attribute__((ext_vector_type(4)));
typedef float f32x16 __attribute__((ext_vector_type(16)));
typedef unsigned u32x4 __attribute__((ext_vector_type(4)));
constexpr int ROWB = 144;
constexpr int WAVE_LDS = 32 * ROWB + 256;
__device__ __forceinline__ int crow(int r, int hi) { return (r & 3) + 8 * (r >> 2) + 4 * hi; }
typedef float f32x2d __attribute__((ext_vector_type(2))); typedef __bf16 bf16x2d __attribute__((ext_vector_type(2)));
__device__ __forceinline__ unsigned cvtpk(float lo, float hi) { const f32x2d v = {lo, hi}; const bf16x2d b = __builtin_convertvector(v, bf16x2d); return __builtin_bit_cast(unsigned, b); }
__device__ __forceinline__ int clampi(int v) { return v < 0 ? 0 : (v > SEQ - 1 ? SEQ - 1 : v); }

__device__ __forceinline__ void load_tile(const bf16_t* Pb, int base, int dg, int m0, int kcol, int vcol, int lane, bf16x8 (&kf)[4], u32x4 (&vr)[4]) {
    const int r32 = lane & 31, hi = lane >> 5;
    const int tk = clampi(base + dg * (m0 + r32));
    const bf16_t* kp = Pb + (size_t)tk * PP + kcol + 8 * hi;
#pragma unroll
    for (int d0 = 0; d0 < 4; ++d0) kf[d0] = *(const bf16x8*)(kp + 16 * d0);
#pragma unroll
    for (int c = 0; c < 4; ++c) { const int tv = clampi(base + dg * (m0 + 8 * c + (lane >> 3)));
        vr[c] = *(const u32x4*)(Pb + (size_t)tv * PP + vcol + 8 * (lane & 7)); }
}

__device__ __forceinline__ void dil_task(bf16_t* P, int w, DLAS unsigned char* wl, int lane, bf16_t* OUTP, int opitch, int ocol) {
    const int r32 = lane & 31, hi = lane >> 5;
    const int b = w >> 9, h = (w >> 7) & 3, blk = (w >> 4) & 7, rr = w & 15;
    const int base = 512 * blk + rr;
    bf16_t* Pb = P + (size_t)b * SEQ * PP;
    DLAS float* sc = (DLAS float*)(wl + 32 * ROWB);
    float m_run = -1e30f, l_run = 0.f; f32x16 o0 = {}, o1 = {};
    const int vaddr = ((lane & 15) >> 2) * ROWB + (((lane >> 4) & 1) * 16 + (lane & 3) * 4) * 2;
    for (int g = 0; g < 3; ++g) {
        const int dg = 1 << (2 * g), rho = 16 >> (2 * g), ntile = (31 * rho + 129 + 31) >> 5;
        const int qcol = C_B0 + 768 * g + 64 * h, kcol = qcol + 256, vcol = qcol + 512;
        bf16x8 qf[4];
        { const bf16_t* qp = Pb + (size_t)(base + 16 * r32) * PP + qcol + 8 * hi;
#pragma unroll
          for (int d0 = 0; d0 < 4; ++d0) qf[d0] = *(const bf16x8*)(qp + 16 * d0); }
        bf16x8 kf[4], kn[4]; u32x4 vr[4], vn[4];
        load_tile(Pb, base, dg, -64, kcol, vcol, lane, kf, vr);
        for (int T = 0; T < ntile; ++T) {
            const int m0 = -64 + 32 * T;
            if (T + 1 < ntile) load_tile(Pb, base, dg, m0 + 32, kcol, vcol, lane, kn, vn);
            f32x16 p = {};
#pragma unroll
            for (int d0 = 0; d0 < 4; ++d0) p = __builtin_amdgcn_mfma_f32_32x32x16_bf16(kf[d0], qf[d0], p, 0, 0, 0);
#pragma unroll
            for (int c = 0; c < 4; ++c) *(DLAS u32x4*)(wl + (8 * c + (lane >> 3)) * ROWB + (lane & 7) * 16) = vr[c];
            bool valid[16]; float mx = -1e30f;
#pragma unroll
            for (int r = 0; r < 16; ++r) { const int m = m0 + crow(r, hi); const int tok = base + dg * m;
                valid[r] = ((unsigned)(m - rho * r32 + 64) <= 128u) && ((unsigned)tok < (unsigned)SEQ);
                p[r] = valid[r] ? p[r] : -1e30f; mx = fmaxf(mx, p[r]); }
            mx = fmaxf(mx, __shfl_xor(mx, 32));
            const float m_new = fmaxf(m_run, mx), alpha = __builtin_amdgcn_exp2f(m_run - m_new); m_run = m_new;
            float psum = 0.f;
#pragma unroll
            for (int r = 0; r < 16; ++r) { const float e = valid[r] ? __builtin_amdgcn_exp2f(p[r] - m_new) : 0.f; p[r] = e; psum += e; }
            l_run = l_run * alpha + psum;
            if (!__all(alpha == 1.0f)) {
                if (hi == 0) sc[r32] = alpha;
#pragma unroll
                for (int r = 0; r < 16; ++r) { const float a = sc[crow(r, hi)]; o0[r] *= a; o1[r] *= a; }
            }
            u32x4 pk0, pk1;
            pk0.x = cvtpk(p[0], p[1]); pk0.y = cvtpk(p[2], p[3]); pk0.z = cvtpk(p[4], p[5]); pk0.w = cvtpk(p[6], p[7]);
            pk1.x = cvtpk(p[8], p[9]); pk1.y = cvtpk(p[10], p[11]); pk1.z = cvtpk(p[12], p[13]); pk1.w = cvtpk(p[14], p[15]);
            const bf16x8 pa0 = __builtin_bit_cast(bf16x8, pk0), pa1 = __builtin_bit_cast(bf16x8, pk1);
#pragma unroll
            for (int s = 0; s < 2; ++s) {
#pragma unroll
                for (int d0 = 0; d0 < 2; ++d0) {
                    DLAS unsigned char* va = wl + vaddr + (16 * s + 4 * hi) * ROWB + d0 * 64;
                    const s16x4 lo = __builtin_bit_cast(s16x4, __builtin_amdgcn_ds_read_tr16_b64_v4i16((DLAS s16x4*)va));
                    const s16x4 hh = __builtin_bit_cast(s16x4, __builtin_amdgcn_ds_read_tr16_b64_v4i16((DLAS s16x4*)(va + 8 * ROWB)));
                    const bf16x8 vf = (bf16x8){lo[0], lo[1], lo[2], lo[3], hh[0], hh[1], hh[2], hh[3]};
                    if (d0 == 0) o0 = __builtin_amdgcn_mfma_f32_32x32x16_bf16(s == 0 ? pa0 : pa1, vf, o0, 0, 0, 0);
                    else         o1 = __builtin_amdgcn_mfma_f32_32x32x16_bf16(s == 0 ? pa0 : pa1, vf, o1, 0, 0, 0);
                }
            }
#pragma unroll
            for (int i = 0; i < 4; ++i) { kf[i] = kn[i]; vr[i] = vn[i]; }
        }
    }
    l_run += __shfl_xor(l_run, 32);
    if (hi == 0) sc[32 + r32] = __builtin_amdgcn_rcpf(l_run);
    bf16_t* op = OUTP + ((size_t)b * SEQ + base) * opitch + ocol + 64 * h + r32;
#pragma unroll
    for (int r = 0; r < 16; ++r) { const int q = crow(r, hi); const float inv = sc[32 + q];
        const __hip_bfloat16 a = __float2bfloat16(o0[r] * inv), c = __float2bfloat16(o1[r] * inv);
        op[(size_t)(16 * q) * opitch] = __builtin_bit_cast(unsigned short, a); op[(size_t)(16 * q) * opitch + 32] = __builtin_bit_cast(unsigned short, c); }
}
}


namespace naive {
__device__ __forceinline__ float bf2f(unsigned short v) { return __uint_as_float((unsigned)v << 16); }
__device__ __forceinline__ float wmax(float v) {
#pragma unroll
    for (int o = 1; o < 64; o <<= 1) v = fmaxf(v, __shfl_xor(v, o));
    return v;
}
__device__ __forceinline__ float wsum(float v) {
#pragma unroll
    for (int o = 1; o < 64; o <<= 1) v += __shfl_xor(v, o);
    return v;
}
__device__ __forceinline__ void dense_task(unsigned short* P, int task, __attribute__((address_space(3))) float* qs, int lane) {
    const int m = task >> 3, hq = task & 7, b = m >> 12;
    unsigned short* prow = P + (size_t)m * PP + C_QA + 64 * hq;
    qs[lane] = bf2f(prow[lane]);
    const unsigned short* kb = P + (size_t)b * SEQ * PP + C_KA + 64 * (hq >> 2);
    const unsigned short* vb = P + (size_t)b * SEQ * PP + C_VA + 64 * (hq >> 2);
    float m_run = -1e30f, l = 0.f, o = 0.f;
    for (int kc = 0; kc < SEQ / 64; ++kc) {
        const unsigned short* kr = kb + (size_t)(kc * 64 + lane) * PP;
        float s = 0.f;
#pragma unroll 8
        for (int d = 0; d < 64; ++d) s += qs[d] * bf2f(kr[d]);
        const float m_new = fmaxf(m_run, wmax(s)), alpha = __builtin_amdgcn_exp2f(m_run - m_new), p = __builtin_amdgcn_exp2f(s - m_new);
        m_run = m_new; l = l * alpha + wsum(p); o *= alpha;
        for (int j = 0; j < 64; ++j) o += __shfl(p, j) * bf2f(vb[(size_t)(kc * 64 + j) * PP + lane]);
    }
    const __hip_bfloat16 r = __float2bfloat16(o / l);
    prow[lane] = __builtin_bit_cast(unsigned short, r);
}
__device__ __forceinline__ void dil_task(unsigned short* P, int task, __attribute__((address_space(3))) float* qs, int lane) {
    const int m = task >> 2, h = task & 3, b = m >> 12, t = m & (SEQ - 1);
    const unsigned short* Pb = P + (size_t)b * SEQ * PP;
    float m_run = -1e30f, l = 0.f, o = 0.f;
    for (int g = 0; g < 3; ++g) {
        const int dg = 1 << (2 * g); const int qcol = C_B0 + 768 * g + 64 * h, kcol = qcol + 256, vcol = qcol + 512;
        qs[lane] = bf2f(Pb[(size_t)t * PP + qcol + lane]);
        for (int c = 0; c < 3; ++c) {
            const int j = -64 + 64 * c + lane, tok = t + dg * j; const bool valid = (j <= 64) && (tok >= 0) && (tok < SEQ);
            const unsigned short* kr = Pb + (size_t)(valid ? tok : t) * PP + kcol;
            float s = 0.f;
#pragma unroll 8
            for (int d = 0; d < 64; ++d) s += qs[d] * bf2f(kr[d]);
            s = valid ? s : -1e30f;
            const float m_new = fmaxf(m_run, wmax(s)), alpha = __builtin_amdgcn_exp2f(m_run - m_new), p = valid ? __builtin_amdgcn_exp2f(s - m_new) : 0.f;
            m_run = m_new; l = l * alpha + wsum(p); o *= alpha;
            for (int jj = 0; jj < 64; ++jj) { int tk = t + dg * (-64 + 64 * c + jj); tk = tk < 0 ? 0 : (tk > SEQ - 1 ? SEQ - 1 : tk);
                o += __shfl(p, jj) * bf2f(Pb[(size_t)tk * PP + vcol + lane]); }
        }
    }
    const __hip_bfloat16 r = __float2bfloat16(o / l);
    P[(size_t)m * PP + C_OB + 64 * h + lane] = __builtin_bit_cast(unsigned short, r);
}
}


namespace naive {
__device__ __forceinline__ float blo(unsigned w) { return __uint_as_float(w << 16); }
__device__ __forceinline__ float bhi(unsigned w) { return __uint_as_float(w & 0xffff0000u); }
__device__ __forceinline__ unsigned short f2b(float v) { const __hip_bfloat16 r = __float2bfloat16(v); return __builtin_bit_cast(unsigned short, r); }
__device__ __forceinline__ float dotcol(const unsigned short* arow, const float* W, int K, int N, int c) {
    float s = 0.f;
    for (int k = 0; k < K; k += 2) { const unsigned w2 = *(const unsigned*)(arow + k); s += blo(w2) * W[(size_t)k * N + c]; s += bhi(w2) * W[(size_t)(k + 1) * N + c]; }
    return s;
}
__device__ __forceinline__ void gin_task(int w, int lane, const unsigned short* XN, unsigned short* P, const float* win, const float* qna, const float* kna, const float* qnb, const float* knb) {
    const int m = w / 80, cg = w % 80, c = 64 * cg + lane, t = m & (SEQ - 1);
    if (!NAIVE_GIN && !((DBG_SKIP >> (cg >> 2)) & 1u)) return;
    const float z = dotcol(XN + (size_t)m * DM, win, DM, NIN, c);
    float o;
    if (cg >= 48) o = 1.0f / (1.0f + expf(-z));
    else {
        int mode; const float* gn = qna; float scale = 1.f;
        if (cg < 8) { mode = 0; gn = qna; scale = QK_C2; }
        else if (cg < 10) { mode = 0; gn = kna; }
        else if (cg < 12) mode = 2;
        else { const int g = (cg - 12) / 12, rem = (cg - 12) % 12; if (rem < 4) { mode = 1; gn = qnb + 64 * g; scale = QK_C2; } else if (rem < 8) { mode = 1; gn = knb + 64 * g; } else mode = 2; }
        if (mode == 2) o = z;
        else {
            const float ss = wsum(z * z), y = z * (1.0f / sqrtf(ss * (1.0f / 64.0f) + EPS)) * gn[lane];
            float ang; bool first; float partner;
            if (mode == 0) { const int dd = lane & 31, i = dd & 15, pos = (lane >> 5) ? (t & 63) : (t >> 6); ang = (float)pos * powf(10000.0f, -(float)i / 16.0f); first = dd < 16; partner = __shfl_xor(y, 16); }
            else { const int i = lane & 31; ang = (float)t * powf(10000.0f, -(float)i / 32.0f); first = lane < 32; partner = __shfl_xor(y, 32); }
            const double a = (double)ang; const float cs = (float)cos(a), sn = (float)sin(a);
            o = (first ? (y * cs - partner * sn) : (y * cs + partner * sn)) * scale;
        }
    }
    P[(size_t)m * PP + c] = f2b(o);
}
}

#define LAS __attribute__((address_space(3)))
typedef unsigned short bf16;
typedef unsigned v4u __attribute__((ext_vector_type(4)));
typedef float f32x4 __attribute__((ext_vector_type(4)));
constexpr int NWAVES = 8;
constexpr size_t MiB = 1u << 20;
constexpr size_t WS_ADA = 1 * MiB, WS_TABB = 2 * MiB, WS_TABA = 3 * MiB;
constexpr size_t WS_WIN = 4 * MiB, WS_WA = 44 * MiB, WS_WB = 48 * MiB, WS_WO = 50 * MiB, WS_W1 = 58 * MiB, WS_W2 = 90 * MiB;
constexpr size_t WS_XN = 122 * MiB, WS_P = 186 * MiB, WS_XSB = 442 * MiB, WS_RSS = 506 * MiB, WS_END = 508 * MiB;
constexpr size_t WS_BIASA = 64 * 1024, WS_GS = 704 * 1024, WS_BIASF = 3 * MiB + 64 * 1024;
constexpr int RING_BYTES = 131072, LDS_BYTES = 147456;
constexpr int NPHASE = 2 + 6 * DEPTH;

__device__ __forceinline__ unsigned f2bf(float f) { unsigned u = __builtin_bit_cast(unsigned, f); return (u + 0x7fffu + ((u >> 16) & 1u)) >> 16; }
__device__ __forceinline__ unsigned pk2(float lo, float hi) { return f2bf(lo) | (f2bf(hi) << 16); }
#define LDS_WAIT() asm volatile("s_waitcnt lgkmcnt(0)" ::: "memory")
__device__ __forceinline__ float wave_sum(float v) {
#pragma unroll
    for (int o = 1; o < 64; o <<= 1) v += __shfl_xor(v, o);
    return v;
}
__device__ __forceinline__ int win_dst_row(int n) {
    const int pn = n >> 8, u = n & 255, wc = u >> 6, d = u & 63, e = d & 7;
    if (pn >= 12) return n;
    int bj, fq;
    if (pn <= 1 || (pn == 2 && wc < 2)) { bj = (d >> 4) & 1; fq = 2 * (d >> 5) + ((d >> 3) & 1); }
    else { bj = d >> 5; fq = (d >> 3) & 3; }
    return (pn << 8) + 128 * bj + 32 * wc + 8 * fq + e;
}
__device__ __forceinline__ void p0_transpose_item(const float* W, int K, int N, bf16* WT, bool perm, LAS float* scr, int item, int lane) {
    const int nblk = N / 32, kb = item / nblk, nb = item % nblk, k0 = 64 * kb, n0 = 32 * nb;
#pragma unroll 8
    for (int i = 0; i < 32; ++i) { const int kk = 2 * i + (lane >> 5); scr[kk * 33 + (lane & 31)] = W[(size_t)(k0 + kk) * N + n0 + (lane & 31)]; }
    LDS_WAIT(); asm volatile("" ::: "memory");
    const int c = lane & 7;
#pragma unroll
    for (int j = 0; j < 4; ++j) { const int n = (lane >> 3) + 8 * j; const LAS float* s = scr + (8 * c) * 33 + n;
        v4u o; o.x = pk2(s[0 * 33], s[1 * 33]); o.y = pk2(s[2 * 33], s[3 * 33]); o.z = pk2(s[4 * 33], s[5 * 33]); o.w = pk2(s[6 * 33], s[7 * 33]);
        const int row = perm ? win_dst_row(n0 + n) : (n0 + n);
        *(v4u*)(WT + (size_t)row * K + k0 + 8 * c) = o; }
    LDS_WAIT(); asm volatile("" ::: "memory");
}

__device__ __forceinline__ void gemv8_block(const float* W, int N, int n0, const LAS float* vec, LAS float* red, float* dst, int dstride, const float* addv, int wave, int lane) {
    const int cg = lane & 15, rg = lane >> 4;
    f32x4 a[8];
#pragma unroll
    for (int b = 0; b < 8; ++b) a[b] = (f32x4){0.f, 0.f, 0.f, 0.f};
    const float* wp = W + (size_t)(wave * 128 + rg) * N + n0 + 4 * cg;
#pragma unroll 8
    for (int i = 0; i < 32; ++i) { const f32x4 wv = *(const f32x4*)(wp + (size_t)(4 * i) * N); const int kk = wave * 128 + 4 * i + rg;
#pragma unroll
        for (int b = 0; b < 8; ++b) a[b] += wv * vec[b * DM + kk]; }
#pragma unroll
    for (int b = 0; b < 8; ++b)
#pragma unroll
        for (int j = 0; j < 4; ++j) { float v = a[b][j]; v += __shfl_xor(v, 16); v += __shfl_xor(v, 32); a[b][j] = v; }
    if (rg == 0) {
#pragma unroll
        for (int b = 0; b < 8; ++b) *(LAS f32x4*)(red + (wave * 8 + b) * 64 + 4 * cg) = a[b];
    }
    __syncthreads();
    { float s = addv ? addv[n0 + lane] : 0.f;
#pragma unroll
      for (int w2 = 0; w2 < 8; ++w2) s += red[(w2 * 8 + wave) * 64 + lane];
      dst[(size_t)wave * dstride + n0 + lane] = s; }
    __syncthreads();
}

#define XB_TMO      128
#define XB_XCNT(j)  (256  + 64 * (j))
#define XB_XSUB(j)  (1280 + 64 * (j))
#define XB_XGEN(j)  (2304 + 64 * (j))
#define XB_TOP      3328
#define XB_TOPGEN   3392
#define XCD_BAR_WORDS 3456
#define XB_SPIN_CAP (1u << 18)

__device__ __forceinline__ unsigned xb_ld(unsigned* p)              { return __hip_atomic_load(p, __ATOMIC_RELAXED, __HIP_MEMORY_SCOPE_AGENT); }
__device__ __forceinline__ unsigned xb_add(unsigned* p, unsigned v) { return __hip_atomic_fetch_add(p, v, __ATOMIC_RELAXED, __HIP_MEMORY_SCOPE_AGENT); }
__device__ __forceinline__ unsigned xb_xcc_id() { return (unsigned)__builtin_amdgcn_s_getreg((3 << 11) | 20) & 0xFu; }
#define XB_SPIN(cond, bar) do { unsigned _sp = 0; while (cond) { __builtin_amdgcn_s_sleep(1); \
    if ((++_sp & 255u) == 0u) { if (xb_ld(&(bar)[XB_TMO])) break; if (_sp > XB_SPIN_CAP) { atomicAdd(&(bar)[XB_TMO], 1u); break; } } } } while (0)

struct XcdBarrier {
    unsigned* bar; unsigned x;
    volatile LAS unsigned* st;
};

__device__ __forceinline__ XcdBarrier xcd_barrier_post(unsigned* bar, volatile LAS unsigned* st, bool leader) {
    XcdBarrier b; b.bar = bar; b.x = xb_xcc_id(); b.st = st;
    if (leader) (void)xb_add(&bar[XB_XCNT(b.x)], 1u);
    return b;
}
__device__ __forceinline__ void xcd_barrier_complete(unsigned* bar, unsigned x, unsigned& nloc, unsigned& nx) {
    const unsigned G = gridDim.x * gridDim.y * gridDim.z;
    unsigned sum, cnt, mine, sp = 0u;
    for (;;) {
        sum = 0u; cnt = 0u; mine = 0u;
#pragma unroll
        for (unsigned j = 0; j < 16; ++j) { const unsigned c = xb_ld(&bar[XB_XCNT(j)]); sum += c; cnt += (c > 0u) ? 1u : 0u; mine = (j == x) ? c : mine; }
        if (sum == G) break;
        __builtin_amdgcn_s_sleep(1);
        if ((++sp & 255u) == 0u) { if (xb_ld(&bar[XB_TMO])) break; if (sp > XB_SPIN_CAP) { atomicAdd(&bar[XB_TMO], 1u); break; } }
    }
    nloc = mine > 0u ? mine : 1u; nx = cnt > 0u ? cnt : 1u;
}

__device__ __forceinline__ void xcd_barrier(const XcdBarrier& b, bool leader) {
    asm volatile("s_waitcnt vmcnt(0)" ::: "memory");
    __syncthreads();
    if (leader) {
        unsigned* bar = b.bar;
        __builtin_amdgcn_s_waitcnt(0);
        unsigned nloc = b.st[0], nx = b.st[1];
        if (nloc == 0u) { xcd_barrier_complete(bar, b.x, nloc, nx); b.st[0] = nloc; b.st[1] = nx; }
        const unsigned old = xb_add(&bar[XB_XSUB(b.x)], 1u);
        const unsigned gen = old / nloc;
        if (old + 1u == (gen + 1u) * nloc) {
            __builtin_amdgcn_fence(__ATOMIC_RELEASE, "agent");
            asm volatile("s_waitcnt vmcnt(0)" ::: "memory");
            const unsigned og = xb_add(&bar[XB_TOP], 1u);
            const unsigned tg = og / nx;
            if (og + 1u == (tg + 1u) * nx) xb_add(&bar[XB_TOPGEN], 1u);
            else XB_SPIN(xb_ld(&bar[XB_TOPGEN]) == tg, bar);
            __builtin_amdgcn_fence(__ATOMIC_ACQUIRE, "agent");
            xb_add(&bar[XB_XGEN(b.x)], 1u);
            asm volatile("s_waitcnt vmcnt(0)" ::: "memory");
        } else {
            XB_SPIN(xb_ld(&bar[XB_XGEN(b.x)]) == gen, bar);
            __builtin_amdgcn_fence(__ATOMIC_ACQUIRE, "agent");
            asm volatile("s_waitcnt vmcnt(0)" ::: "memory");
        }
    }
    __syncthreads();
}

struct Args { const float* in[16]; float* out; unsigned char* ws; int ph_lo, ph_hi; };

typedef const Args __attribute__((address_space(4))) CArgs;
template <int ph> __device__ __forceinline__ void run_phase(CArgs* ap0, const int wave0, unsigned char* lds) {
    LAS unsigned char* L = (LAS unsigned char*)lds;
        int zz = 0; asm volatile("" : "+v"(zz));
        const int lane = __builtin_amdgcn_mbcnt_hi(~0u, __builtin_amdgcn_mbcnt_lo(~0u, zz)), wave = wave0;
        const int tid = wave * 64 + lane;
        int bx = blockIdx.x; asm volatile("" : "+s"(bx));
        const int G = gridDim.x; const int vcu = (G % 8 == 0) ? (bx % 8) * (G / 8) + bx / 8 : bx;
        const int gw = vcu * NWAVES + wave, NGW = G * NWAVES;
        CArgs* ap = ap0; asm volatile("" : "+s"(ap));
        unsigned char* ws = ap->ws;
        float* ADA = (float*)(ws + WS_ADA); float* TABB = (float*)(ws + WS_TABB); float* TABA = (float*)(ws + WS_TABA);
        bf16* XN = (bf16*)(ws + WS_XN); bf16* P = (bf16*)(ws + WS_P); bf16* HB = (bf16*)(ws + WS_P);
        const float* x_in = ap->in[0]; float* out = ap->out;
        if (ph == 0) {
            {
                LAS float* cact = (LAS float*)L;
                LAS float* red = (LAS float*)(L + 32768);
                for (int i = tid; i < BATCH * DM; i += NWAVES * 64) { const float v = ap->in[1][i]; cact[i] = v * __builtin_amdgcn_rcpf(1.0f + __expf(-v)); }
                __syncthreads();
                for (int it = bx; it < DEPTH * 96; it += G) {
                    const int l = it / 96, n0 = (it % 96) * 64;
                    gemv8_block(ap->in[2] + (size_t)l * DM * 6 * DM, 6 * DM, n0, cact, red, ADA + (size_t)l * BATCH * 6 * DM, 6 * DM, ap->in[3] + (size_t)l * 6 * DM, wave, lane);
                }
            }
            {
                for (int e = bx * NWAVES * 64 + tid; e < SEQ * 32 + 64 * 16; e += G * NWAVES * 64) {
                    int pos, i; float fr; float* dst;
                    if (e < SEQ * 32) { pos = e >> 5; i = e & 31; fr = (float)i * (1.0f / 32.0f); dst = TABB + 2 * (size_t)e; }
                    else { const int e2 = e - SEQ * 32; pos = e2 >> 4; i = e2 & 15; fr = (float)i * (1.0f / 16.0f); dst = TABA + 2 * (size_t)e2; }
                    const float inv = exp2f(-fr * 13.287712379549449f);
                    const float ang = (float)pos * inv;
                    const double turns = (double)ang * 0.15915494309189535;
                    const float fpart = (float)(turns - rint(turns));
#if TAB_DOUBLE
                    dst[0] = (float)cos((double)ang); dst[1] = (float)sin((double)ang);
#else
                    dst[0] = __builtin_amdgcn_cosf(fpart); dst[1] = __builtin_amdgcn_sinf(fpart);
#endif
                }
            }
            {
                LAS float* scr = (LAS float*)(L + wave * 16384);
                constexpr int I_IN = (DM / 64) * (NIN / 32), I_A = (512 / 64) * (DM / 32), I_B = (256 / 64) * (DM / 32), I_O = (DM / 64) * (DM / 32), I_1 = (DM / 64) * (FF / 32), I_2 = (FF / 64) * (DM / 32);
                constexpr int I_L = I_IN + I_A + I_B + I_O + I_1 + I_2;
                __syncthreads();
                for (int it = gw; it < DEPTH * I_L; it += NGW) {
                    const int l = it / I_L; int r = it - l * I_L;
                    if (r < I_IN) { p0_transpose_item(ap->in[6] + (size_t)l * DM * NIN, DM, NIN, (bf16*)(ws + WS_WIN) + (size_t)l * NIN * DM, true, scr, r, lane); continue; } r -= I_IN;
                    if (r < I_A) { p0_transpose_item(ap->in[11] + (size_t)l * 512 * DM, 512, DM, (bf16*)(ws + WS_WA) + (size_t)l * DM * 512, false, scr, r, lane); continue; } r -= I_A;
                    if (r < I_B) { p0_transpose_item(ap->in[12] + (size_t)l * 256 * DM, 256, DM, (bf16*)(ws + WS_WB) + (size_t)l * DM * 256, false, scr, r, lane); continue; } r -= I_B;
                    if (r < I_O) { p0_transpose_item(ap->in[13] + (size_t)l * DM * DM, DM, DM, (bf16*)(ws + WS_WO) + (size_t)l * DM * DM, false, scr, r, lane); continue; } r -= I_O;
                    if (r < I_1) { p0_transpose_item(ap->in[14] + (size_t)l * DM * FF, DM, FF, (bf16*)(ws + WS_W1) + (size_t)l * FF * DM, false, scr, r, lane); continue; } r -= I_1;
                    p0_transpose_item(ap->in[15] + (size_t)l * FF * DM, FF, DM, (bf16*)(ws + WS_W2) + (size_t)l * DM * FF, false, scr, r, lane);
                }
                __syncthreads();
            }
        } else {
            const int l = (ph - 2) / 6, sub6 = (ph - 2) % 6;
            const int sub = (ph == 1) ? 0 : (sub6 == 0 ? 1 : sub6 == 1 ? 2 : sub6 == 2 ? 3 : sub6 == 3 ? 4 : sub6 == 4 ? 6 : 7);
            const float* ada_l = ADA + (size_t)l * BATCH * 6 * DM;
            float* RSS = (float*)(ws + WS_RSS); float* GSV = (float*)(ws + WS_GS); float* BIASA = (float*)(ws + WS_BIASA); float* BIASF = (float*)(ws + WS_BIASF); bf16* XSB = (bf16*)(ws + WS_XSB);
            if (sub == 0) {
                { LAS float* shv = (LAS float*)L;
                  LAS float* red = (LAS float*)(L + 32768);
                  for (int it = bx; it < DEPTH * 144; it += G) {
                      const int ll = it / 144, r = it % 144; const bool isA = r < 80; const int n0 = (isA ? r : r - 80) * 64, N = isA ? NIN : FF;
                      const float* W = (isA ? ap->in[6] + (size_t)ll * DM * NIN : ap->in[14] + (size_t)ll * DM * FF);
                      const float* adl = ADA + (size_t)ll * BATCH * 6 * DM + (isA ? 0 : 3 * DM);
                      for (int i = tid; i < BATCH * DM; i += NWAVES * 64) shv[i] = adl[(size_t)(i >> 10) * 6 * DM + (i & 1023)];
                      __syncthreads();
                      gemv8_block(W, N, n0, shv, red, isA ? BIASA + (size_t)ll * BATCH * NIN : BIASF + (size_t)ll * BATCH * FF, N, nullptr, wave, lane);
                  } }
                for (int e = bx * NWAVES * 64 + tid; e < 2 * DEPTH * BATCH * DM; e += G * NWAVES * 64) {
                    const int which = e >> 15, ll = (e >> 13) & 3, b = (e >> 10) & 7, c = e & 1023;
                    GSV[e] = (which ? ap->in[5] : ap->in[4])[ll * DM + c] * (1.0f + ADA[((size_t)ll * BATCH + b) * 6 * DM + (which ? 4 : 1) * DM + c]);
                }
                { f32x4 gg[4];
#pragma unroll
                  for (int j = 0; j < 4; ++j) gg[j] = *(const f32x4*)(ap->in[4] + 256 * j + 4 * lane);
                  for (int m = gw; m < MTOK; m += NGW) {
                    const int b = m >> 12; const f32x4* xr = (const f32x4*)(x_in + (size_t)m * DM) + lane;
                    f32x4 v[4]; float s = 0.f;
#pragma unroll
                    for (int j = 0; j < 4; ++j) { v[j] = xr[64 * j]; s += (v[j][0] * v[j][0] + v[j][1] * v[j][1]) + (v[j][2] * v[j][2] + v[j][3] * v[j][3]); }
                    s = wave_sum(s);
                    if (lane < 16) RSS[(size_t)m * 16 + lane] = (lane == 0) ? s : 0.f;
                    const float* ab = ADA + (size_t)b * 6 * DM + DM;
                    unsigned long long* o8 = (unsigned long long*)(XN + (size_t)m * DM) + lane;
#pragma unroll
                    for (int j = 0; j < 4; ++j) { const f32x4 sc = *(const f32x4*)(ab + 256 * j + 4 * lane);
                        const f32x4 y = v[j] * gg[j] * (sc + 1.0f);
                        o8[64 * j] = (unsigned long long)pk2(y[0], y[1]) | ((unsigned long long)pk2(y[2], y[3]) << 32); }
                  } }
            } else if (sub == 1) {
                pg8::Gemm g{XN, (const bf16*)(ws + WS_WIN) + (size_t)l * NIN * DM, MTOK, NIN, DM, DM}; pg8::StaticOrder S; S.init(MTOK, NIN, G, bx);
                pg8::EpiIn E{P, ap->in[7] + l * 64, ap->in[8] + l * 64, ap->in[9] + l * 192, ap->in[10] + l * 192, TABA, TABB, RSS, BIASA + (size_t)l * BATCH * NIN};
#if NAIVE_GIN
                for (int w = gw; w < MTOK * 80; w += NGW) naive::gin_task(w, lane, XN, P, ap->in[6] + (size_t)l * DM * NIN, ap->in[7] + l * 64, ap->in[8] + l * 64, ap->in[9] + l * 192, ap->in[10] + l * 192);
#else
#ifndef NO_GIN
                pg8::gemm_phase<pg8::EpiIn, pg8::StaticOrder, true, true, DM, DM>(tid, L, g, S, E);
#if DBG_GEMM2 & 1
                pg8::gemm_phase<pg8::EpiIn, pg8::StaticOrder, true, true, DM, DM>(tid, L, g, S, E);
#endif
#endif
#if DBG_SKIP
                for (int w = gw; w < MTOK * 80; w += NGW) naive::gin_task(w, lane, XN, P, ap->in[6] + (size_t)l * DM * NIN, ap->in[7] + l * 64, ap->in[8] + l * 64, ap->in[9] + l * 192, ap->in[10] + l * 192);
#endif
#endif
            } else if (sub == 2) {
                for (int u = vcu; u < BATCH * 8 * 16; u += G) {
                    const int i = u / G, uu = i * G + vcu;
                    const int b = uu >> 7, h = (uu >> 4) & 7, qb = uu & 15;
#if !defined(NO_ATT) && !NAIVE_ATT
                    attn_body::attn_unit<8>(b, h, qb, (const attn_body::bf16*)P + C_QA, (const attn_body::bf16*)P + C_KA, (const attn_body::bf16*)P + C_VA, (attn_body::bf16*)P + C_QA, (char*)lds, tid);
#endif
                }
                __syncthreads();
#if NAIVE_ATT
                for (int w = gw; w < MTOK * 8; w += NGW) naive::dense_task(P, w, (LAS float*)(L + wave * 256), lane);
                __syncthreads();
#endif
#if NAIVE_DIL
                for (int w = gw; w < MTOK * 4; w += NGW) naive::dil_task(P, w, (LAS float*)(L + wave * 256), lane);
#elif !defined(NO_DIL)
                for (int w = gw; w < BATCH * 4 * 128; w += NGW) dil::dil_task(P, w, L + wave * dil::WAVE_LDS, lane, P, PP, C_OB);
#if DBG_DIL2
                for (int w = gw; w < BATCH * 4 * 128; w += NGW) dil::dil_task(P, w, L + wave * dil::WAVE_LDS, lane, XN, DM, 0);
#endif
#endif
                __syncthreads();
            } else if (sub == 3) {
                { pg8::Gemm g{P + C_QA, (const bf16*)(ws + WS_WA) + (size_t)l * DM * 512, MTOK, DM, 512, PP}; pg8::StaticOrder S; S.init(MTOK, DM, G, bx);

#if NAIVE_BR
                for (int w = gw; w < MTOK * 16; w += NGW) { const int m = w >> 4, c = 64 * (w & 15) + lane;
                    const float za = naive::dotcol(P + (size_t)m * PP + C_QA, ap->in[11] + (size_t)l * 512 * DM, 512, DM, c), zb = naive::dotcol(P + (size_t)m * PP + C_OB, ap->in[12] + (size_t)l * 256 * DM, 256, DM, c);
                    const float ga = naive::bf2f(P[(size_t)m * PP + C_GA + c]), gb = naive::bf2f(P[(size_t)m * PP + C_GB + c]);
                    XN[(size_t)m * DM + c] = naive::f2b(ga * za + gb * zb); }
#else
#ifndef NO_BR0
pg8::EpiBr<0> E{XN, P, C_GA}; pg8::gemm_phase<pg8::EpiBr<0>, pg8::StaticOrder, true, true, 512, PP>(tid, L, g, S, E);
#endif
#endif
 }
                { pg8::Gemm g{P + C_OB, (const bf16*)(ws + WS_WB) + (size_t)l * DM * 256, MTOK, DM, 256, PP}; pg8::StaticOrder S; S.init(MTOK, DM, G, bx);

#if NAIVE_BR

#else
#ifndef NO_BR1
pg8::EpiBr<1> E{XN, P, C_GB}; pg8::gemm_phase<pg8::EpiBr<1>, pg8::StaticOrder, true, true, 256, PP>(tid, L, g, S, E);
#endif
#endif
 }
            } else if (sub == 4) {
                pg8::Gemm g{XN, (const bf16*)(ws + WS_WO) + (size_t)l * DM * DM, MTOK, DM, DM, DM}; pg8::StaticOrder S; S.init(MTOK, DM, G, bx);
                pg8::EpiRes E{l == 0 ? x_in : out, out, ada_l + 2 * DM, XSB, GSV + (size_t)(DEPTH + l) * BATCH * DM, RSS};
#if NAIVE_OUT
                for (int w = gw; w < MTOK * 16; w += NGW) { const int m = w >> 4, c = 64 * (w & 15) + lane;
                    const float z = naive::dotcol(XN + (size_t)m * DM, ap->in[13] + (size_t)l * DM * DM, DM, DM, c);
                    out[(size_t)m * DM + c] = (l == 0 ? x_in : out)[(size_t)m * DM + c] + ada_l[(size_t)(m >> 12) * 6 * DM + 2 * DM + c] * z; }
#else
#ifndef NO_RES
pg8::gemm_phase<pg8::EpiRes, pg8::StaticOrder, true, true, DM, DM>(tid, L, g, S, E);
#endif
#endif

            } else if (sub == 6) {
                pg8::Gemm g{XSB, (const bf16*)(ws + WS_W1) + (size_t)l * FF * DM, MTOK, FF, DM, DM}; pg8::StaticOrder S; S.init(MTOK, FF, G, bx);
                pg8::EpiRelu2 E{HB, RSS, BIASF + (size_t)l * BATCH * FF};
#if NAIVE_F1
                for (int w = gw; w < MTOK * 64; w += NGW) { const int m = w >> 6, c = 64 * (w & 63) + lane;
                    const float z = fmaxf(naive::dotcol(XN + (size_t)m * DM, ap->in[14] + (size_t)l * DM * FF, DM, FF, c), 0.f);
                    HB[(size_t)m * FF + c] = naive::f2b(z * z); }
#else
#ifndef NO_F1
pg8::gemm_phase<pg8::EpiRelu2, pg8::StaticOrder, true, true, DM, DM>(tid, L, g, S, E);
#if DBG_GEMM2 & 4
pg8::gemm_phase<pg8::EpiRelu2, pg8::StaticOrder, true, true, DM, DM>(tid, L, g, S, E);
#endif
#endif
#endif

            } else {
                pg8::Gemm g{HB, (const bf16*)(ws + WS_W2) + (size_t)l * DM * FF, MTOK, DM, FF, FF}; pg8::StaticOrder S; S.init(MTOK, DM, G, bx);
                pg8::EpiRes E{out, out, ada_l + 5 * DM, (l + 1 < DEPTH) ? XN : (bf16*)nullptr, GSV + (size_t)((l + 1 < DEPTH) ? (l + 1) : 0) * BATCH * DM, RSS};
#if NAIVE_F2
                for (int w = gw; w < MTOK * 16; w += NGW) { const int m = w >> 4, c = 64 * (w & 15) + lane;
                    const float z = naive::dotcol(HB + (size_t)m * FF, ap->in[15] + (size_t)l * FF * DM, FF, DM, c);
                    out[(size_t)m * DM + c] = out[(size_t)m * DM + c] + ada_l[(size_t)(m >> 12) * 6 * DM + 5 * DM + c] * z; }
#else
#ifndef NO_RES
pg8::gemm_phase<pg8::EpiRes, pg8::StaticOrder, true, true, FF, FF>(tid, L, g, S, E);
#endif
#endif

            }
        }
}

__global__ void __launch_bounds__(NWAVES * 64, 2) mk_fwd(Args args) {
    extern __shared__ __attribute__((aligned(16))) unsigned char lds[];
    CArgs* ap0 = (CArgs*)__builtin_amdgcn_kernarg_segment_ptr();
    const int ph_lo = ap0->ph_lo, ph_hi = ap0->ph_hi;
    const int wave0 = __builtin_amdgcn_readfirstlane(threadIdx.x >> 6);
    volatile LAS unsigned* bst = (volatile LAS unsigned*)((LAS unsigned char*)lds + RING_BYTES + 64);
    if (threadIdx.x == 0) { bst[0] = 0u; bst[1] = 0u; }
    __syncthreads();
    unsigned* barw = (unsigned*)ap0->ws;
    const unsigned xbx = xcd_barrier_post(barw, bst, threadIdx.x == 0).x;
#define RUN(PH) if (ph_lo <= (PH) && (PH) < ph_hi) { run_phase<(PH)>(ap0, wave0, lds); if ((PH) + 1 < ph_hi) { if ((PH) == 0) cg::this_grid().sync(); else { int z_ = 0; asm volatile("" : "+v"(z_)); const bool ld_ = (wave0 == 0) && (__builtin_amdgcn_mbcnt_hi(~0u, __builtin_amdgcn_mbcnt_lo(~0u, z_)) == 0); XcdBarrier xb_; xb_.bar = barw; xb_.x = xbx; xb_.st = bst; for (int xs_ = 0; xs_ <= DBG_SYNCX; ++xs_) xcd_barrier(xb_, ld_); } } }
#define RUN8(B) RUN(B) RUN(B + 1) RUN(B + 2) RUN(B + 3) RUN(B + 4) RUN(B + 5) RUN(B + 6) RUN(B + 7)
    RUN(0) RUN(1) RUN8(2) RUN8(10) RUN8(18)
#undef RUN8
#undef RUN
}

extern "C" void kernel_launch(void* const* d_in, const int* in_sizes, int n_in, void* d_out, int out_size, void* d_ws, size_t ws_size, hipStream_t stream) {
    static int grid = 0;
    if (grid == 0) {
        if (n_in != 16 || out_size != MTOK * DM || ws_size < WS_END) { fprintf(stderr, "kernel_launch: unexpected shapes (n_in %d out %d ws %zu)\n", n_in, out_size, ws_size); grid = -1; return; }
        int dev = 0, cus = 0, per_cu = 0;
        if (hipGetDevice(&dev) != hipSuccess || hipDeviceGetAttribute(&cus, hipDeviceAttributeMultiprocessorCount, dev) != hipSuccess) { grid = -1; return; }
        if (hipFuncSetAttribute((const void*)mk_fwd, hipFuncAttributeMaxDynamicSharedMemorySize, LDS_BYTES) != hipSuccess) { fprintf(stderr, "kernel_launch: hipFuncSetAttribute failed\n"); grid = -1; return; }
        if (hipOccupancyMaxActiveBlocksPerMultiprocessor(&per_cu, (const void*)mk_fwd, NWAVES * 64, LDS_BYTES) != hipSuccess || per_cu < 1) per_cu = 1;
        (void)hipGetLastError();
        grid = cus * 1;
        fprintf(stderr, "kernel_launch: grid %d (occupancy query %d per CU)\n", grid, per_cu);
    }
    if (grid < 0) return;
    if (hipMemsetAsync(d_ws, 0, 16384, stream) != hipSuccess) { fprintf(stderr, "kernel_launch: memset failed\n"); return; }
    Args a{};
    for (int i = 0; i < 16; ++i) a.in[i] = (const float*)d_in[i];
    a.out = (float*)d_out; a.ws = (unsigned char*)d_ws;
#if MK_PER_PHASE
    for (int ph = 0; ph < NPHASE; ++ph) { a.ph_lo = ph; a.ph_hi = ph + 1; hipLaunchKernelGGL(mk_fwd, dim3(grid), dim3(NWAVES * 64), LDS_BYTES, stream, a); }
#else
    a.ph_lo = 0; a.ph_hi = NPHASE;
    void* kargs[] = {&a};
    hipError_t e = hipLaunchCooperativeKernel((void*)mk_fwd, dim3(grid), dim3(NWAVES * 64), kargs, LDS_BYTES, stream);
    if (e != hipSuccess) fprintf(stderr, "cooperative launch failed: %s (grid %d)\n", hipGetErrorString(e), grid);
#endif
}
```

```cpp
#include <hip/hip_runtime.h>
#include <hip/hip_bf16.h>
#include <hip/hip_cooperative_groups.h>
#include <cstdio>
#include <cstdint>
#include <cmath>
namespace cg = cooperative_groups;

#ifndef MK_PER_PHASE
#define MK_PER_PHASE 0
#endif

#ifndef NAIVE_ATT
#define NAIVE_ATT 0
#endif
#ifndef NAIVE_DIL
#define NAIVE_DIL 0
#endif

#ifndef NAIVE_GEMM
#define NAIVE_GEMM 0
#endif

#ifndef NAIVE_GIN
#define NAIVE_GIN NAIVE_GEMM
#endif
#ifndef NAIVE_BR
#define NAIVE_BR NAIVE_GEMM
#endif
#ifndef NAIVE_OUT
#define NAIVE_OUT NAIVE_GEMM
#endif
#ifndef NAIVE_F1
#define NAIVE_F1 NAIVE_GEMM
#endif
#ifndef NAIVE_F2
#define NAIVE_F2 NAIVE_GEMM
#endif

#ifndef TAB_DOUBLE
#define TAB_DOUBLE 1
#endif

#ifndef DBG_SKIP
#define DBG_SKIP 0u
#endif

#ifndef DBG_SYNCX
#define DBG_SYNCX 0
#endif
#ifndef DBG_DIL2
#define DBG_DIL2 0
#endif
#ifndef DBG_GEMM2
#define DBG_GEMM2 0
#endif

#ifndef DBG_P02
#define DBG_P02 0
#endif

constexpr int BATCH = 8, SEQ = 4096, DM = 1024, DEPTH = 4, FF = 4096, NIN = 5120;
constexpr int MTOK = BATCH * SEQ;
constexpr int PP = 5120;
constexpr int C_QA = 0, C_KA = 512, C_VA = 640, C_B0 = 768, C_GA = 3072, C_GB = 4096, C_OB = 768;
constexpr float QK_C2 = 0.125f * 1.4426950408889634f;
constexpr float EPS = 1e-6f;

namespace pg8 {
#define PG8_LAS __attribute__((address_space(3)))
typedef unsigned short bf16_t;
typedef short bf16x8 __attribute__((ext_vector_type(8)));
typedef float f32x4 __attribute__((ext_vector_type(4)));
typedef unsigned u32x4 __attribute__((ext_vector_type(4)));
constexpr int BM = 256, BK = 64, HALF = 128, HTB = HALF * BK * 2  , STAGE_BYTES = 8 * HTB, NXCD = 8, WGM = 8;

__host__ __device__ __forceinline__ int lds_byte(int r, int c) { const int st = (r >> 4) * 2 + (c >> 5), rr = r & 15, cc = c & 31, ob = rr * 64 + cc * 2; return st * 1024 + (ob ^ (((ob >> 9) & 1) << 5)); }
__host__ __device__ __forceinline__ void stage_rc(int b, int& R, int& C) { const int st = b / 1024, sb = b % 1024, swz = sb ^ (((sb >> 9) & 1) << 5); R = (st >> 1) * 16 + swz / 64; C = (st & 1) * 32 + (swz % 64) / 2; }
__host__ __device__ __forceinline__ int perm32(int rho) { const int n = rho >> 4, i = rho & 15; return 8 * (i >> 2) + 4 * n + (i & 3); }

struct Unit { int pm, pn; };
struct Gemm { const bf16_t* A; const bf16_t* Bt; int M, N, K, lda; };

struct StaticOrder {
    int nM, nN, nwg, G, c;
    __host__ __device__ void init(int M, int N, int G_, int c_) { nM = M / BM; nN = N / BM; nwg = nM * nN; G = G_; c = c_; }
    __host__ __device__ bool next(int i, Unit& u) const {
        const long L = (long)i * G + c; if (L >= nwg) return false;
        int wgid = (int)L; { const int q = nwg / NXCD, r = nwg % NXCD, xcd = wgid % NXCD, off = wgid / NXCD; wgid = (xcd < r ? xcd * (q + 1) : r * (q + 1) + (xcd - r) * q) + off; }
        const int nig = WGM * nN, gid = wgid / nig, fm = gid * WGM, gsz = (nM - fm) < WGM ? (nM - fm) : WGM;
        u.pm = fm + ((wgid % nig) % gsz); u.pn = (wgid % nig) / gsz; return true;
    }
    __device__ __forceinline__ void a_ready(const Unit&) const {}
    __device__ __forceinline__ void done(const Unit&) const {}
};

typedef float f32x2c __attribute__((ext_vector_type(2))); typedef __bf16 bf16x2c __attribute__((ext_vector_type(2)));
__device__ __forceinline__ unsigned cvt_pk_bf16(float lo, float hi) { const f32x2c v = {lo, hi}; const bf16x2c b = __builtin_convertvector(v, bf16x2c); return __builtin_bit_cast(unsigned, b); }
typedef float f32x2 __attribute__((ext_vector_type(2)));
typedef unsigned u32x2 __attribute__((ext_vector_type(2)));
__device__ __forceinline__ float bf_lo(unsigned w) { return __uint_as_float(w << 16); }
__device__ __forceinline__ float bf_hi(unsigned w) { return __uint_as_float(w & 0xffff0000u); }
__device__ __forceinline__ float sigm(float v) { return __builtin_amdgcn_rcpf(1.0f + __builtin_amdgcn_exp2f(-1.4426950408889634f * v)); }
__device__ __forceinline__ u32x4 pack8(const f32x4 a, const f32x4 b) { u32x4 w; w.x = cvt_pk_bf16(a[0], a[1]); w.y = cvt_pk_bf16(a[2], a[3]); w.z = cvt_pk_bf16(b[0], b[1]); w.w = cvt_pk_bf16(b[2], b[3]); return w; }

__device__ __forceinline__ float row_rstd(const float* rss, int row) {
    const f32x4* p = (const f32x4*)(rss + (size_t)row * 16); const f32x4 a = p[0], b = p[1], c = p[2], d = p[3];
    const float s = ((a[0] + a[1]) + (a[2] + a[3])) + ((b[0] + b[1]) + (b[2] + b[3])) + ((c[0] + c[1]) + (c[2] + c[3])) + ((d[0] + d[1]) + (d[2] + d[3]));
    return __builtin_amdgcn_rsqf(s * (1.0f / DM) + EPS);
}
__device__ __forceinline__ void rows_rstd(const float* rss, int row0, int fq, float (&rs)[2][4]) {
    f32x4 q[2][4];
#pragma unroll
    for (int ai = 0; ai < 2; ++ai)
#pragma unroll
        for (int m = 0; m < 4; ++m) q[ai][m] = *(const f32x4*)(rss + (size_t)(row0 + ai * HALF + m * 16) * 16 + 4 * fq);
#pragma unroll
    for (int ai = 0; ai < 2; ++ai)
#pragma unroll
        for (int m = 0; m < 4; ++m) { float s = (q[ai][m][0] + q[ai][m][1]) + (q[ai][m][2] + q[ai][m][3]); s += __shfl_xor(s, 16); s += __shfl_xor(s, 32);
            rs[ai][m] = __builtin_amdgcn_rsqf(s * (1.0f / DM) + EPS); }
}
struct EpiIn {
    static constexpr bool PERM = true, AFTER_DRAIN = false;
    bf16_t* P; const float* qna; const float* kna; const float* qnb; const float* knb; const float* tabA; const float* tabB; const float* rss; const float* bias;
    __device__ __forceinline__ void operator()(const f32x4 (&acc)[2][2][4][2], const Unit& u, int wr, int wc, int fr, int fq) const {
        const int pn = u.pn; const int row0 = u.pm * BM + wr * 64 + fr; const int bb = (u.pm * BM) / SEQ;
        if ((DBG_SKIP >> pn) & 1u) return;
        float rs[2][4]; rows_rstd(rss, row0, fq, rs);
        if (pn >= 12) {
            const int col0 = pn * 256 + wc * 32 + 8 * fq;
            f32x4 bv[2][2];
#pragma unroll
            for (int bj = 0; bj < 2; ++bj)
#pragma unroll
                for (int n = 0; n < 2; ++n) bv[bj][n] = *(const f32x4*)(bias + (size_t)bb * NIN + col0 + bj * HALF + 4 * n);
#pragma unroll
            for (int ai = 0; ai < 2; ++ai)
#pragma unroll
                for (int m = 0; m < 4; ++m) { const int row = row0 + ai * HALF + m * 16; bf16_t* rowp = P + (size_t)row * PP + col0; const float rstd = rs[ai][m];
#pragma unroll
                    for (int bj = 0; bj < 2; ++bj) { f32x4 v0 = acc[ai][bj][m][0] * rstd + bv[bj][0], v1 = acc[ai][bj][m][1] * rstd + bv[bj][1];
#pragma unroll
                        for (int j = 0; j < 4; ++j) { v0[j] = sigm(v0[j]); v1[j] = sigm(v1[j]); }
                        *(u32x4*)(rowp + bj * HALF) = pack8(v0, v1); } }
            return;
        }
        int mode, colbase; const float* gn = qna; float scale = 1.f;
        if (pn <= 1) { mode = 0; colbase = (4 * pn + wc) * 64; gn = qna; scale = QK_C2; }
        else if (pn == 2) { colbase = 512 + 64 * wc; if (wc < 2) { mode = 0; gn = kna; } else mode = 2; }
        else { const int g = (pn - 3) / 3, kind = (pn - 3) - 3 * g; colbase = 256 * pn + 64 * wc;
               if (kind == 2) mode = 2; else { mode = 1; gn = (kind == 0 ? qnb : knb) + 64 * g; scale = (kind == 0) ? QK_C2 : 1.f; } }
        const int d0 = (mode == 0) ? (32 * (fq >> 1) + 8 * (fq & 1)) : 8 * fq; const int bjs = (mode == 0) ? 16 : 32;
        f32x4 bz[2][2];
#pragma unroll
        for (int bj = 0; bj < 2; ++bj)
#pragma unroll
            for (int n = 0; n < 2; ++n) bz[bj][n] = *(const f32x4*)(bias + (size_t)bb * NIN + colbase + d0 + bj * bjs + 4 * n);
        if (mode == 2) {
#pragma unroll
            for (int ai = 0; ai < 2; ++ai)
#pragma unroll
                for (int m = 0; m < 4; ++m) { const int row = row0 + ai * HALF + m * 16; bf16_t* rowp = P + (size_t)row * PP + colbase + d0; const float rstd = rs[ai][m];
#pragma unroll
                    for (int bj = 0; bj < 2; ++bj) *(u32x4*)(rowp + bj * bjs) = pack8(acc[ai][bj][m][0] * rstd + bz[bj][0], acc[ai][bj][m][1] * rstd + bz[bj][1]); }
            return;
        }
        f32x4 gw[2][2];
#pragma unroll
        for (int bj = 0; bj < 2; ++bj)
#pragma unroll
            for (int n = 0; n < 2; ++n) gw[bj][n] = *(const f32x4*)(gn + d0 + bj * bjs + 4 * n);
#pragma unroll
        for (int ai = 0; ai < 2; ++ai)
#pragma unroll
            for (int m = 0; m < 4; ++m) {
                const int row = row0 + ai * HALF + m * 16, t = row & (SEQ - 1);
                const float rs0 = rs[ai][m];
                f32x4 zz[2][2];
#pragma unroll
                for (int bj = 0; bj < 2; ++bj)
#pragma unroll
                    for (int n = 0; n < 2; ++n) zz[bj][n] = acc[ai][bj][m][n] * rs0 + bz[bj][n];
                float ss = 0.f;
#pragma unroll
                for (int bj = 0; bj < 2; ++bj)
#pragma unroll
                    for (int n = 0; n < 2; ++n) { const f32x4 x = zz[bj][n]; ss += (x[0] * x[0] + x[1] * x[1]) + (x[2] * x[2] + x[3] * x[3]); }
                ss += __shfl_xor(ss, 16); ss += __shfl_xor(ss, 32);
                const float rstd = __builtin_amdgcn_rsqf(ss * (1.0f / 64.0f) + EPS) ;
                const float* tb = (mode == 0) ? tabA + ((((fq >> 1) ? (t & 63) : (t >> 6)) * 16 + 8 * (fq & 1)) * 2) : tabB + ((t * 32 + 8 * fq) * 2);
                f32x4 cs[4];
#pragma unroll
                for (int i = 0; i < 4; ++i) cs[i] = *(const f32x4*)(tb + 4 * i);
                f32x4 o1[2], o2[2];
#pragma unroll
                for (int n = 0; n < 2; ++n) { const f32x4 y0 = zz[0][n] * rstd * gw[0][n], y1 = zz[1][n] * rstd * gw[1][n];
#pragma unroll
                    for (int j = 0; j < 4; ++j) { const float c = cs[2 * n + (j >> 1)][(j & 1) * 2], s = cs[2 * n + (j >> 1)][(j & 1) * 2 + 1];
                        o1[n][j] = (y0[j] * c - y1[j] * s) * scale; o2[n][j] = (y1[j] * c + y0[j] * s) * scale; } }
                bf16_t* rowp = P + (size_t)row * PP + colbase + d0;
                *(u32x4*)(rowp) = pack8(o1[0], o1[1]); *(u32x4*)(rowp + bjs) = pack8(o2[0], o2[1]);
                if (m & 1) asm volatile("" ::: "memory");
            }
    }
};
template <int PASS> struct EpiBr {
    static constexpr bool PERM = true, AFTER_DRAIN = false;
    bf16_t* MX; const bf16_t* P; int gcol;
    __device__ __forceinline__ void operator()(const f32x4 (&acc)[2][2][4][2], const Unit& u, int wr, int wc, int fr, int fq) const {
        const int row0 = u.pm * BM + wr * 64 + fr, col0 = u.pn * 256 + wc * 32 + 8 * fq;
#pragma unroll
        for (int ai = 0; ai < 2; ++ai)
#pragma unroll
            for (int m = 0; m < 4; ++m) { const size_t row = (size_t)(row0 + ai * HALF + m * 16);
#pragma unroll
                for (int bj = 0; bj < 2; ++bj) { const int c = col0 + bj * HALF;
                    const u32x4 gv = *(const u32x4*)(P + row * PP + gcol + c);
                    f32x4 v0 = acc[ai][bj][m][0], v1 = acc[ai][bj][m][1];
                    v0[0] *= bf_lo(gv.x); v0[1] *= bf_hi(gv.x); v0[2] *= bf_lo(gv.y); v0[3] *= bf_hi(gv.y);
                    v1[0] *= bf_lo(gv.z); v1[1] *= bf_hi(gv.z); v1[2] *= bf_lo(gv.w); v1[3] *= bf_hi(gv.w);
                    if (PASS == 1) { const u32x4 pv = *(const u32x4*)(MX + row * DM + c);
                        v0[0] += bf_lo(pv.x); v0[1] += bf_hi(pv.x); v0[2] += bf_lo(pv.y); v0[3] += bf_hi(pv.y);
                        v1[0] += bf_lo(pv.z); v1[1] += bf_hi(pv.z); v1[2] += bf_lo(pv.w); v1[3] += bf_hi(pv.w); }
                    *(u32x4*)(MX + row * DM + c) = pack8(v0, v1); }
                if (m & 1) asm volatile("" ::: "memory"); }
    }
};
struct EpiRes {
    static constexpr bool PERM = false, AFTER_DRAIN = false;
    const float* base; float* out; const float* gt;
    bf16_t* XS; const float* gs; float* rss;
    __device__ __forceinline__ void operator()(const f32x4 (&acc)[2][2][4][2], const Unit& u, int wr, int wc, int fr, int fq) const {
        const int row0 = u.pm * BM + wr * 64 + fr, col0 = u.pn * 256 + wc * 32 + 4 * fq; const int b = (u.pm * BM) / SEQ;
        f32x4 gv[2][2], gsv[2][2];
#pragma unroll
        for (int bj = 0; bj < 2; ++bj)
#pragma unroll
            for (int n = 0; n < 2; ++n) { gv[bj][n] = *(const f32x4*)(gt + (size_t)b * 6 * DM + col0 + bj * HALF + n * 16);
                gsv[bj][n] = XS ? *(const f32x4*)(gs + (size_t)b * DM + col0 + bj * HALF + n * 16) : (f32x4){0.f, 0.f, 0.f, 0.f}; }
#pragma unroll
        for (int ai = 0; ai < 2; ++ai)
#pragma unroll
            for (int m = 0; m < 4; ++m) { const int row = row0 + ai * HALF + m * 16; const size_t off = (size_t)row * DM + col0; float ss = 0.f;
#pragma unroll
                for (int bj = 0; bj < 2; ++bj)
#pragma unroll
                    for (int n = 0; n < 2; ++n) { const f32x4 bs = *(const f32x4*)(base + off + bj * HALF + n * 16);
                        const f32x4 o = bs + gv[bj][n] * acc[ai][bj][m][n];
                        *(f32x4*)(out + off + bj * HALF + n * 16) = o;
                        if (XS) { ss += (o[0] * o[0] + o[1] * o[1]) + (o[2] * o[2] + o[3] * o[3]); const f32x4 xs = o * gsv[bj][n];
                            u32x2 w; w.x = cvt_pk_bf16(xs[0], xs[1]); w.y = cvt_pk_bf16(xs[2], xs[3]); *(u32x2*)(XS + off + bj * HALF + n * 16) = w; } }
                if (XS) { ss += __shfl_xor(ss, 16); ss += __shfl_xor(ss, 32); if (fq == 0) rss[(size_t)row * 16 + u.pn * 4 + wc] = ss; }
                if (m & 1) asm volatile("" ::: "memory"); }
    }
};
struct EpiRelu2 {
    static constexpr bool PERM = true, AFTER_DRAIN = false;
    bf16_t* H; const float* rss; const float* bias;
    __device__ __forceinline__ void operator()(const f32x4 (&acc)[2][2][4][2], const Unit& u, int wr, int wc, int fr, int fq) const {
        const int row0 = u.pm * BM + wr * 64 + fr, col0 = u.pn * 256 + wc * 32 + 8 * fq; const int b = (u.pm * BM) / SEQ;
        float rs[2][4]; rows_rstd(rss, row0, fq, rs);
        f32x4 bv[2][2];
#pragma unroll
        for (int bj = 0; bj < 2; ++bj)
#pragma unroll
            for (int n = 0; n < 2; ++n) bv[bj][n] = *(const f32x4*)(bias + (size_t)b * FF + col0 + bj * HALF + 4 * n);
#pragma unroll
        for (int ai = 0; ai < 2; ++ai)
#pragma unroll
            for (int m = 0; m < 4; ++m) { const int row = row0 + ai * HALF + m * 16; bf16_t* rowp = H + (size_t)row * FF + col0; const float rstd = rs[ai][m];
#pragma unroll
                for (int bj = 0; bj < 2; ++bj) { f32x4 v0 = acc[ai][bj][m][0] * rstd + bv[bj][0], v1 = acc[ai][bj][m][1] * rstd + bv[bj][1];
#pragma unroll
                    for (int j = 0; j < 4; ++j) { const float a = fmaxf(v0[j], 0.f), b = fmaxf(v1[j], 0.f); v0[j] = a * a; v1[j] = b * b; }
                    *(u32x4*)(rowp + bj * HALF) = pack8(v0, v1); } }
    }
};

template <class Epi, class Sched, bool ALIGN_EPI, bool SP2, int KC, int LDA>
__device__ __forceinline__ void gemm_phase(const int tid, PG8_LAS unsigned char* lds, const Gemm g, const Sched& S, const Epi& E) {
    const int wid = __builtin_amdgcn_readfirstlane(tid >> 6), lane = tid & 63, wr = wid >> 2, wc = wid & 3, fr = lane & 15, fq = lane >> 4;
    constexpr int K = KC, nt = K / BK;
    unsigned voffA[2], voffB[2];
#pragma unroll
    for (int i = 0; i < 2; ++i) { int R, C; stage_rc(tid * 16 + i * 8192, R, C); const int Rb = Epi::PERM ? ((R & ~31) + perm32(R & 31)) : R;
        voffA[i] = (unsigned)(R * LDA + C) * 2u; voffB[i] = (unsigned)(Rb * K + C) * 2u; }
    constexpr size_t kstep = (size_t)(BK * 2);
    constexpr size_t hstep = (size_t)HALF * K * 2, hstepA = (size_t)HALF * LDA * 2;
    constexpr size_t tstep = 2 * hstep, tstepA = 2 * hstepA;
    const unsigned ldsw = (unsigned)wid * 1024u;
    const int aoff = lds_byte(wr * 64 + fr, fq * 8), boff = lds_byte(wc * 32 + fr, fq * 8);
#define PG8_SA(b, h) (((b) * 2 + (h)) * HTB)
#define PG8_SB(b, h) ((4 + (b) * 2 + (h)) * HTB)
#define PG8_STAGE(bufoff, gbase, voff) do { _Pragma("unroll") for (int _i = 0; _i < 2; ++_i) \
        __builtin_amdgcn_global_load_lds((const unsigned*)((const char*)(gbase) + (voff)[_i]), (PG8_LAS unsigned*)(lds + (bufoff) + ldsw + _i * 8192), 16, 0, 0); } while (0)
#define PG8_LDA(dst, b, h) do { _Pragma("unroll") for (int m = 0; m < 4; ++m) _Pragma("unroll") for (int k = 0; k < 2; ++k) dst[m][k] = *(const PG8_LAS bf16x8*)(lds + PG8_SA(b, h) + aoff + m * 2048 + k * 1024); } while (0)
#define PG8_LDB(dst, b, h) do { _Pragma("unroll") for (int n = 0; n < 2; ++n) _Pragma("unroll") for (int k = 0; k < 2; ++k) dst[n][k] = *(const PG8_LAS bf16x8*)(lds + PG8_SB(b, h) + boff + n * 2048 + k * 1024); } while (0)
#define PG8_MMA(ai, bj, At, Bt) do { __builtin_amdgcn_s_setprio(1); _Pragma("unroll") for (int m = 0; m < 4; ++m) _Pragma("unroll") for (int n = 0; n < 2; ++n) _Pragma("unroll") for (int k = 0; k < 2; ++k) \
        acc[ai][bj][m][n] = __builtin_amdgcn_mfma_f32_16x16x32_bf16(Bt[n][k], At[m][k], acc[ai][bj][m][n], 0, 0, 0); __builtin_amdgcn_s_setprio(0); } while (0)
#define PG8_WAIT_V(n) asm volatile("s_waitcnt vmcnt(" #n ")" ::: "memory")
#define PG8_WAIT_L(n) asm volatile("s_waitcnt lgkmcnt(" #n ")" ::: "memory")
#define PG8_BAR __builtin_amdgcn_s_barrier()
#define PG8_SCHED __builtin_amdgcn_sched_barrier(0)
    Unit cur, nxt; int ui = 0;
    if (!S.next(0, cur)) return;
    f32x4 acc[2][2][4][2];
#pragma unroll
    for (int a = 0; a < 2; ++a)
#pragma unroll
        for (int b = 0; b < 2; ++b)
#pragma unroll
            for (int m = 0; m < 4; ++m)
#pragma unroll
                for (int n = 0; n < 2; ++n) acc[a][b][m][n] = (f32x4){0.f, 0.f, 0.f, 0.f};
    bf16x8 At[4][2], B0[2][2], B1[2][2];
    const char* cA = (const char*)g.A + (size_t)cur.pm * tstepA; const char* cB = (const char*)g.Bt + (size_t)cur.pn * tstep;
    S.a_ready(cur);
    if constexpr (SP2) {
        PG8_STAGE(PG8_SB(0, 0), cB, voffB); PG8_STAGE(PG8_SB(0, 1), cB + hstep, voffB); PG8_STAGE(PG8_SA(0, 0), cA, voffA); PG8_STAGE(PG8_SA(0, 1), cA + hstepA, voffA);
        if (wr == 1) PG8_BAR;
        PG8_WAIT_V(2); PG8_BAR;
        PG8_STAGE(PG8_SB(1, 0), cB + kstep, voffB); PG8_STAGE(PG8_SA(1, 0), cA + kstep, voffA); PG8_STAGE(PG8_SB(1, 1), cB + hstep + kstep, voffB);
        PG8_WAIT_V(6); PG8_BAR;
    } else {
        PG8_STAGE(PG8_SB(0, 0), cB, voffB); PG8_STAGE(PG8_SA(0, 0), cA, voffA); PG8_STAGE(PG8_SB(0, 1), cB + hstep, voffB); PG8_STAGE(PG8_SA(0, 1), cA + hstepA, voffA);
        if (wr == 1) PG8_BAR;
        PG8_WAIT_V(4); PG8_BAR;
        PG8_STAGE(PG8_SB(1, 0), cB + kstep, voffB); PG8_STAGE(PG8_SA(1, 0), cA + kstep, voffA); PG8_STAGE(PG8_SB(1, 1), cB + hstep + kstep, voffB);
        PG8_WAIT_V(6); PG8_BAR;
    }
    for (;;) {
        const bool has_next = S.next(ui + 1, nxt);
        const char* nA = has_next ? (const char*)g.A + (size_t)nxt.pm * tstepA : cA; const char* nB = has_next ? (const char*)g.Bt + (size_t)nxt.pn * tstep : cB;
#pragma unroll 1
        for (int t = 0; t < nt; t += 2) {
            const bool last = (t == nt - 2);
            const char* a1 = cA + (size_t)(t + 1) * kstep;
            const char* a2 = last ? nA : cA + (size_t)(t + 2) * kstep; const char* b2 = last ? nB : cB + (size_t)(t + 2) * kstep;
            const char* a3 = a2 + kstep; const char* b3 = b2 + kstep;
            if (last && has_next) S.a_ready(nxt);
            if constexpr (SP2) {
            PG8_LDB(B0, 0, 0); PG8_LDB(B1, 0, 1); PG8_SCHED; PG8_LDA(At, 0, 0); PG8_STAGE(PG8_SA(1, 1), a1 + hstepA, voffA);
            PG8_WAIT_V(8); PG8_WAIT_L(0); PG8_BAR; PG8_MMA(0, 0, At, B0); PG8_MMA(0, 1, At, B1); PG8_BAR; PG8_SCHED;
            PG8_LDA(At, 0, 1); PG8_STAGE(PG8_SB(0, 0), b2, voffB); PG8_STAGE(PG8_SB(0, 1), b2 + hstep, voffB); PG8_STAGE(PG8_SA(0, 0), a2, voffA);
            PG8_WAIT_V(8); PG8_WAIT_L(0); PG8_BAR; PG8_MMA(1, 0, At, B0); PG8_MMA(1, 1, At, B1); PG8_BAR; PG8_SCHED;
            PG8_LDB(B0, 1, 0); PG8_LDB(B1, 1, 1); PG8_SCHED; PG8_LDA(At, 1, 0); PG8_STAGE(PG8_SA(0, 1), a2 + hstepA, voffA);
            PG8_WAIT_V(8); PG8_WAIT_L(0); PG8_BAR; PG8_MMA(0, 0, At, B0); PG8_MMA(0, 1, At, B1); PG8_BAR; PG8_SCHED;
            PG8_LDA(At, 1, 1); PG8_STAGE(PG8_SB(1, 0), b3, voffB); PG8_STAGE(PG8_SB(1, 1), b3 + hstep, voffB); PG8_STAGE(PG8_SA(1, 0), a3, voffA);
            PG8_WAIT_V(8); PG8_WAIT_L(0); PG8_BAR; PG8_MMA(1, 0, At, B0); PG8_MMA(1, 1, At, B1); PG8_BAR; PG8_SCHED;
            } else {
            PG8_LDB(B0, 0, 0); PG8_SCHED; PG8_LDA(At, 0, 0); PG8_STAGE(PG8_SA(1, 1), a1 + hstepA, voffA);
            PG8_WAIT_L(8); PG8_BAR; PG8_WAIT_L(0); PG8_MMA(0, 0, At, B0); PG8_BAR; PG8_SCHED;
            PG8_LDB(B1, 0, 1); PG8_STAGE(PG8_SB(0, 0), b2, voffB);
            PG8_BAR; PG8_WAIT_L(0); PG8_MMA(0, 1, At, B1); PG8_BAR;
            PG8_LDA(At, 0, 1); PG8_STAGE(PG8_SA(0, 0), a2, voffA);
            PG8_BAR; PG8_WAIT_L(0); PG8_MMA(1, 0, At, B0); PG8_BAR; PG8_SCHED;
            PG8_STAGE(PG8_SB(0, 1), b2 + hstep, voffB);
            PG8_WAIT_V(6); PG8_BAR; PG8_MMA(1, 1, At, B1); PG8_BAR;
            PG8_LDB(B0, 1, 0); PG8_SCHED; PG8_LDA(At, 1, 0); PG8_STAGE(PG8_SA(0, 1), a2 + hstepA, voffA);
            PG8_WAIT_L(8); PG8_BAR; PG8_WAIT_L(0); PG8_MMA(0, 0, At, B0); PG8_BAR; PG8_SCHED;
            PG8_LDB(B1, 1, 1); PG8_STAGE(PG8_SB(1, 0), b3, voffB);
            PG8_BAR; PG8_WAIT_L(0); PG8_MMA(0, 1, At, B1); PG8_BAR;
            PG8_LDA(At, 1, 1); PG8_STAGE(PG8_SA(1, 0), a3, voffA);
            PG8_BAR; PG8_WAIT_L(0); PG8_MMA(1, 0, At, B0); PG8_BAR; PG8_SCHED;
            PG8_STAGE(PG8_SB(1, 1), b3 + hstep, voffB);
            PG8_WAIT_V(6); PG8_BAR; PG8_MMA(1, 1, At, B1); PG8_BAR;
            }
        }
        if constexpr (ALIGN_EPI) { if (wr == 0) PG8_BAR; }
        if constexpr (!Epi::AFTER_DRAIN) { E(acc, cur, wr, wc, fr, fq); S.done(cur); }
        if (!has_next) break;
#pragma unroll
        for (int a = 0; a < 2; ++a)
#pragma unroll
            for (int b = 0; b < 2; ++b)
#pragma unroll
                for (int m = 0; m < 4; ++m)
#pragma unroll
                    for (int n = 0; n < 2; ++n) acc[a][b][m][n] = (f32x4){0.f, 0.f, 0.f, 0.f};
        cur = nxt; cA = nA; cB = nB; ++ui;
        if constexpr (ALIGN_EPI) { if (wr == 1) PG8_BAR; }
    }
    PG8_WAIT_V(0);
    if constexpr (!ALIGN_EPI) { if (wr == 0) PG8_BAR; }
    PG8_BAR;
    if constexpr (Epi::AFTER_DRAIN) { E.fused(acc, cur, wr, wc, fr, fq, lds, wid, lane); S.done(cur); }
#undef PG8_SA
#undef PG8_SB
#undef PG8_STAGE
#undef PG8_LDA
#undef PG8_LDB
#undef PG8_MMA
#undef PG8_WAIT_V
#undef PG8_WAIT_L
#undef PG8_BAR
#undef PG8_SCHED
}
}
namespace attn_body {
using bf16=__hip_bfloat16;
using bf16x8=__attribute__((ext_vector_type(8)))short;
using s16x4=__attribute__((ext_vector_type(4)))short;
using f32x16=__attribute__((ext_vector_type(16)))float;
using u32x4=__attribute__((ext_vector_type(4)))unsigned;
constexpr int BATCH=8,NHEAD=8,SEQ=4096,D=64,DM=5120;
constexpr int NW=8,QBLK=32,QB=QBLK*NW,KVBLK=64,NQB=SEQ/QB;
constexpr int ATTN_PITCH=DM, ATTN_UNIT_ROWS=QB;
__device__ __forceinline__ int crow(int r,int hi){return (r&3)+8*(r>>2)+4*hi;}
#define SBAR() __builtin_amdgcn_sched_barrier(0)
__device__ __forceinline__ void cmask(f32x16&p0,f32x16&p1,int jb,int qrel,int hi){
  const float NEG=-INFINITY; int kb=64*jb+4*hi;
  #pragma unroll
  for(int r=0;r<16;++r){int kv=kb+(r&3)+8*(r>>2); if(kv>qrel)p0[r]=NEG; if(kv+32>qrel)p1[r]=NEG;}
}

constexpr int NSLOT=3, SLOTB=8192;
constexpr int LDS_K=0, LDS_V=NSLOT*SLOTB, LDS_WS=2*NSLOT*SLOTB, LDS_OST=LDS_WS+NW*64*4, LDS_BYTES=LDS_OST+NW*4096;
constexpr float C2=0.125f*1.4426950408889634f;
__device__ __forceinline__ void glds16(const void*gsrc,unsigned lds_dst){unsigned keep;
  asm volatile("s_mov_b32 %0, m0\n\ts_mov_b32 m0, %2\n\ts_nop 0\n\tglobal_load_lds_dwordx4 %1, off\n\ts_mov_b32 m0, %0":"=&s"(keep):"v"(gsrc),"s"(lds_dst):"memory");}
__device__ __forceinline__ float max3f(float a,float b,float c){float r;asm("v_max3_f32 %0, %1, %2, %3":"=v"(r):"v"(a),"v"(b),"v"(c));return r;}
__device__ __forceinline__ float max2f(float a,float b){float r;asm("v_max_f32_e32 %0, %1, %2":"=v"(r):"v"(a),"v"(b));return r;}
__device__ __forceinline__ float fadd_s(float a,float b){float r;asm("v_add_f32_e32 %0, %1, %2":"=v"(r):"v"(a),"v"(b));return r;}
__device__ __forceinline__ float fsub_s(float a,float b){float r;asm("v_sub_f32_e32 %0, %1, %2":"=v"(r):"v"(a),"v"(b));return r;}
typedef float f32x2_t __attribute__((ext_vector_type(2))); typedef __bf16 bf16x2_t __attribute__((ext_vector_type(2)));
__device__ __forceinline__ unsigned cvtpk_s(float lo,float hi){f32x2_t v={lo,hi};bf16x2_t b=__builtin_convertvector(v,bf16x2_t);return __builtin_bit_cast(unsigned,b);}
#define WAIT_BAR(N) asm volatile("s_waitcnt vmcnt(" #N ") lgkmcnt(0)\n\ts_barrier":::"memory")

__device__ __forceinline__ void qkt(f32x16&p0,f32x16&p1,const char*Kslot,const bf16x8*qr,const f32x16&negm,int r32,int hi){
  const char*kb=Kslot+hi*1024+r32*16;
  #pragma unroll
  for(int d0=0;d0<4;++d0){
    const bf16x8 b0=*reinterpret_cast<const bf16x8*>(kb+d0*2048);
    const bf16x8 b1=*reinterpret_cast<const bf16x8*>(kb+d0*2048+512);
    if(d0==0){p0=__builtin_amdgcn_mfma_f32_32x32x16_bf16(b0,qr[0],negm,0,0,0);p1=__builtin_amdgcn_mfma_f32_32x32x16_bf16(b1,qr[0],negm,0,0,0);}
    else{p0=__builtin_amdgcn_mfma_f32_32x32x16_bf16(b0,qr[d0],p0,0,0,0);p1=__builtin_amdgcn_mfma_f32_32x32x16_bf16(b1,qr[d0],p1,0,0,0);}}
}
typedef __attribute__((address_space(3))) const char* lds_cptr;
typedef short v4i16_t __attribute__((ext_vector_type(4)));
__device__ __forceinline__ void kload8(bf16x8*kf,lds_cptr kp){
  kf[0]=*(const __attribute__((address_space(3))) bf16x8*)(kp);      kf[1]=*(const __attribute__((address_space(3))) bf16x8*)(kp+512);
  kf[2]=*(const __attribute__((address_space(3))) bf16x8*)(kp+2048); kf[3]=*(const __attribute__((address_space(3))) bf16x8*)(kp+2560);
  kf[4]=*(const __attribute__((address_space(3))) bf16x8*)(kp+4096); kf[5]=*(const __attribute__((address_space(3))) bf16x8*)(kp+4608);
  kf[6]=*(const __attribute__((address_space(3))) bf16x8*)(kp+6144); kf[7]=*(const __attribute__((address_space(3))) bf16x8*)(kp+6656);
}
__device__ __forceinline__ void kload2(bf16x8*kf,lds_cptr kp,int j){ kf[2*j]=*(const __attribute__((address_space(3))) bf16x8*)(kp+j*2048); kf[2*j+1]=*(const __attribute__((address_space(3))) bf16x8*)(kp+j*2048+512); }
__device__ __forceinline__ s16x4 vtr(lds_cptr p){ return __builtin_bit_cast(s16x4,__builtin_amdgcn_ds_read_tr16_b64_v4i16((__attribute__((address_space(3))) v4i16_t*)p)); }
__device__ __forceinline__ float rowmax(const f32x16&p0,const f32x16&p1){
  float a=max3f(p0[0],p0[1],p1[0]),b=max3f(p0[2],p0[3],p1[1]);a=max3f(a,p1[2],p1[3]);
  #pragma unroll
  for(int r=4;r<16;r+=4){a=max3f(a,p0[r],p0[r+1]);b=max3f(b,p0[r+2],p0[r+3]);a=max3f(a,p1[r],p1[r+1]);b=max3f(b,p1[r+2],p1[r+3]);}
  const float m=max2f(a,b);
  auto rr=__builtin_amdgcn_permlane32_swap(__float_as_uint(m),__float_as_uint(m),false,false);
  return max2f(__uint_as_float(rr[0]),__uint_as_float(rr[1]));
}
__device__ __forceinline__ void pv(f32x16*o,int vb,bf16x8 pa0,bf16x8 pa1,bf16x8 pa2,bf16x8 pa3){
  #pragma unroll
  for(int d0=0;d0<2;++d0){s16x4 lo[4],hi[4];
    #pragma unroll
    for(int ks=0;ks<4;++ks){
      asm volatile("ds_read_b64_tr_b16 %0,%1 offset:%c2":"=&v"(lo[ks]):"v"(vb),"i"(d0*4096+ks*1024):"memory");
      asm volatile("ds_read_b64_tr_b16 %0,%1 offset:%c2":"=&v"(hi[ks]):"v"(vb),"i"(d0*4096+ks*1024+512):"memory");}
    asm volatile("s_waitcnt lgkmcnt(0)":::"memory");SBAR();
    #define PK(k) (bf16x8){lo[k][0],lo[k][1],lo[k][2],lo[k][3],hi[k][0],hi[k][1],hi[k][2],hi[k][3]}
    o[d0]=__builtin_amdgcn_mfma_f32_32x32x16_bf16(pa0,PK(0),o[d0],0,0,0);
    o[d0]=__builtin_amdgcn_mfma_f32_32x32x16_bf16(pa1,PK(1),o[d0],0,0,0);
    o[d0]=__builtin_amdgcn_mfma_f32_32x32x16_bf16(pa2,PK(2),o[d0],0,0,0);
    o[d0]=__builtin_amdgcn_mfma_f32_32x32x16_bf16(pa3,PK(3),o[d0],0,0,0);
    #undef PK
  }
}

#ifndef ATTN_STORE16
#define ATTN_STORE16(p,v) (*(u32x4*)(p)=(v))
#endif
template<int THRL> __device__ __forceinline__ void attn_unit(int b,int h,int qb,const bf16*Q,const bf16*__restrict__ K,const bf16*__restrict__ V,bf16*O,char*shm,const int tid){
  const int lane=tid&63,r32=lane&31,hi=lane>>5; const int wid=__builtin_amdgcn_readfirstlane(tid>>6);
  const long rowbase=(long)b*SEQ; const int q0=qb*QB;
  const bf16*Qw=Q+(rowbase+q0+wid*QBLK)*DM+h*D;
  const bf16*Kh=K+rowbase*DM+(h>>2)*D,*Vh=V+rowbase*DM+(h>>2)*D;
  const unsigned lds0=(unsigned)(uintptr_t)shm;
  float*wsf=(float*)(shm+LDS_WS)+wid*64;
  const bf16*ksrc=Kh+(long)lane*DM+wid*8;
  const bf16*vsrc=Vh+(long)(16*(wid&3)+(lane>>2))*DM+(wid>>2)*32+(lane&3)*8;
  const unsigned kdst=lds0+LDS_K+wid*1024, vdst=lds0+LDS_V+wid*1024;
  #define DMA_K(t,slot) glds16(ksrc+(long)(t)*KVBLK*DM,(unsigned)__builtin_amdgcn_readfirstlane(kdst+(slot)))
  #define DMA_V(t,slot) glds16(vsrc+(long)(t)*KVBLK*DM,(unsigned)__builtin_amdgcn_readfirstlane(vdst+(slot)))
  const int vb0=(int)(lds0+LDS_V)+((lane>>4)&1)*32+(lane&3)*8+(4*hi+((lane&15)>>2))*64;
  const char*Kbase=shm+LDS_K; bf16x8 kf[8];
  const lds_cptr shm3=(lds_cptr)shm; const lds_cptr kp0=shm3+LDS_K+hi*1024+r32*16; const lds_cptr vp0=shm3+LDS_V+((lane>>4)&1)*32+(lane&3)*8+(4*hi+((lane&15)>>2))*64;
  const int NT=SEQ/KVBLK;
  DMA_K(0,0);DMA_V(0,0);DMA_K(1,SLOTB);
  bf16x8 qr[4];
  #pragma unroll
  for(int d0=0;d0<4;++d0)qr[d0]=*reinterpret_cast<const bf16x8*>(&Qw[(long)r32*DM+d0*16+hi*8]);
  float mhat=0.f,l_reg=0.f;f32x16 o[2];o[0]=f32x16{};o[1]=f32x16{};f32x16 negm=f32x16{};asm volatile("":"+v"(negm));
  const int qrel=wid*QBLK+r32;
  #define CMASK(P0,P1,t) do{}while(0)
  bool resc=false;
  #define START(P0,P1) do{ const float rm=rowmax(P0,P1); resc=false; \
    { const float dl=rm; mhat=fadd_s(mhat,dl); \
      _Pragma("unroll") for(int r=0;r<16;++r){P0[r]=fsub_s(P0[r],dl);P1[r]=fsub_s(P1[r],dl);} \
      _Pragma("unroll") for(int r=0;r<16;++r)negm[r]=-mhat; asm volatile("":"+v"(negm)); } \
    _Pragma("unroll") for(int r=0;r<16;++r)P0[r]=__builtin_amdgcn_exp2f(P0[r]); }while(0)
  #define RESC() do{ if(resc){ asm volatile("s_waitcnt lgkmcnt(0)":::"memory"); \
      _Pragma("unroll") for(int d_=0;d_<2;++d_) _Pragma("unroll") for(int r=0;r<16;++r)o[d_][r]*=wsf[crow(r,hi)]; } }while(0)
  f32x16 pA0,pA1,pB0,pB1;
  int sl_prev=0,sl_cur=0,sl_next=SLOTB;
  #define ROT() do{sl_prev=sl_cur;sl_cur=sl_next;sl_next=(sl_next==(NSLOT-1)*SLOTB)?0:sl_next+SLOTB;}while(0)
  DMA_K(2,2*SLOTB);
  WAIT_BAR(3);
  qkt(pA0,pA1,Kbase,qr,negm,r32,hi);asm volatile("s_nop 15\n\ts_nop 7":"+v"(pA0),"+v"(pA1));CMASK(pA0,pA1,0);
  START(pA0,pA1);
  _Pragma("unroll") for(int r=0;r<16;++r)pA1[r]=__builtin_amdgcn_exp2f(pA1[r]);
  WAIT_BAR(0);
  DMA_K(3,0);DMA_V(1,SLOTB);
  ROT();
  kload8(kf,kp0+sl_cur);
  WAIT_BAR(2);
  s16x4 vlo[8],vhi[8]; u32x4 pw0,pw1,pw2,pw3;
  #define PKW(P,B) cvtpk_s(P[B],P[B+1])
  #define PAF(k) __builtin_bit_cast(bf16x8,pw##k)
  #define VFR(i) (bf16x8){vlo[i][0],vlo[i][1],vlo[i][2],vlo[i][3],vhi[i][0],vhi[i][1],vhi[i][2],vhi[i][3]}
  #define PIN(x) asm volatile("":"+v"(x))
  #define MX3(a,b,c) __builtin_fmaxf(__builtin_fmaxf((a),(b)),(c))
  #define GAPA(MF,A0,A1,A2,A3,W0,W1,PW) do{ MF; sacc+=A0; sacc+=A1; sacc+=A2; sacc+=A3; PIN(sacc); W0; W1; PIN(PW); SBAR(); }while(0)
  #define EX(v) __builtin_amdgcn_exp2f(v)
  #define GAPB(MF,X,B) do{ MF; X[B]=EX(X[B]); X[B+1]=EX(X[B+1]); X[B+2]=EX(X[B+2]); X[B+3]=EX(X[B+3]); PIN(X); SBAR(); }while(0)
  #define VRD(i) do{ vlo[i]=vtr(vp_+(((i)>>2)*4096+((i)&3)*1024)); vhi[i]=vtr(vp_+(((i)>>2)*4096+((i)&3)*1024+512)); }while(0)
  #define KRD(G,j) do{ if(G){ kload2(kf,kp0+sl_next,j); SBAR(); } }while(0)
  #define STEP(C0,C1,P0,P1,t,GK,GV,GL) do{ SBAR(); \
    const lds_cptr vp_=vp0+sl_prev; \
    VRD(0); SBAR(); float sacc=(P0[0]+P0[1]); \
    GAPA(C0=__builtin_amdgcn_mfma_f32_32x32x16_bf16(kf[0],qr[0],negm,0,0,0), P0[2],P0[3],P0[4],P0[5],     pw0[0]=PKW(P0,0), pw0[1]=PKW(P0,2), pw0); \
    VRD(4); SBAR(); GAPA(C1=__builtin_amdgcn_mfma_f32_32x32x16_bf16(kf[1],qr[0],negm,0,0,0), P0[6],P0[7],P0[8],P0[9],     pw0[2]=PKW(P0,4), pw0[3]=PKW(P0,6), pw0); \
    VRD(1); SBAR(); GAPA(C0=__builtin_amdgcn_mfma_f32_32x32x16_bf16(kf[2],qr[1],C0,0,0,0),   P0[10],P0[11],P0[12],P0[13], pw1[0]=PKW(P0,8), pw1[1]=PKW(P0,10), pw1); \
    VRD(5); SBAR(); GAPA(C1=__builtin_amdgcn_mfma_f32_32x32x16_bf16(kf[3],qr[1],C1,0,0,0),   P0[14],P0[15],P1[0],P1[1],   pw1[2]=PKW(P0,12),pw1[3]=PKW(P0,14), pw1); \
    VRD(2); SBAR(); GAPA(C0=__builtin_amdgcn_mfma_f32_32x32x16_bf16(kf[4],qr[2],C0,0,0,0),   P1[2],P1[3],P1[4],P1[5],     pw2[0]=PKW(P1,0), pw2[1]=PKW(P1,2), pw2); \
    VRD(6); SBAR(); GAPA(C1=__builtin_amdgcn_mfma_f32_32x32x16_bf16(kf[5],qr[2],C1,0,0,0),   P1[6],P1[7],P1[8],P1[9],     pw2[2]=PKW(P1,4), pw2[3]=PKW(P1,6), pw2); \
    VRD(3); SBAR(); GAPA(C0=__builtin_amdgcn_mfma_f32_32x32x16_bf16(kf[6],qr[3],C0,0,0,0),   P1[10],P1[11],P1[12],P1[13], pw3[0]=PKW(P1,8), pw3[1]=PKW(P1,10), pw3); \
    VRD(7); SBAR(); GAPA(C1=__builtin_amdgcn_mfma_f32_32x32x16_bf16(kf[7],qr[3],C1,0,0,0),   P1[14],P1[15],0.f,0.f,       pw3[2]=PKW(P1,12),pw3[3]=PKW(P1,14), pw3); \
    l_reg+=sacc; \
    if(GK){DMA_K((t)+3,sl_cur);} if(GV){DMA_V((t)+1,sl_next);} \
    CMASK(C0,C1,t); \
    { float a=MX3(C0[0],C0[1],C1[0]),b=MX3(C0[2],C0[3],C1[1]); a=MX3(a,C1[2],C1[3]); \
      _Pragma("unroll") for(int r=4;r<16;r+=4){a=MX3(a,C0[r],C0[r+1]);b=MX3(b,C0[r+2],C0[r+3]);a=MX3(a,C1[r],C1[r+1]);b=MX3(b,C1[r+2],C1[r+3]);} \
      float rm=__builtin_fmaxf(a,b); { auto rr=__builtin_amdgcn_permlane32_swap(__float_as_uint(rm),__float_as_uint(rm),false,false); rm=__builtin_fmaxf(__uint_as_float(rr[0]),__uint_as_float(rr[1])); } \
      resc=false; \
      if(__builtin_expect(__any(rm>(float)THRL),0)){ const float dl=__builtin_fmaxf(rm,0.f); mhat+=dl; \
        _Pragma("unroll") for(int r=0;r<16;++r){C0[r]-=dl;C1[r]-=dl;} \
        _Pragma("unroll") for(int r=0;r<16;++r)negm[r]=-mhat; asm volatile("":"+v"(negm)); \
        const float f=__builtin_amdgcn_exp2f(-dl); l_reg*=f; if(hi==0)wsf[r32]=f; resc=true; } } \
    SBAR(); \
    GAPB(o[0]=__builtin_amdgcn_mfma_f32_32x32x16_bf16(PAF(0),VFR(0),o[0],0,0,0), C0,0); \
    GAPB(o[1]=__builtin_amdgcn_mfma_f32_32x32x16_bf16(PAF(0),VFR(4),o[1],0,0,0), C0,4); \
    KRD(GL,0); GAPB(o[0]=__builtin_amdgcn_mfma_f32_32x32x16_bf16(PAF(1),VFR(1),o[0],0,0,0), C0,8); \
    KRD(GL,1); GAPB(o[1]=__builtin_amdgcn_mfma_f32_32x32x16_bf16(PAF(1),VFR(5),o[1],0,0,0), C0,12); \
    KRD(GL,2); GAPB(o[0]=__builtin_amdgcn_mfma_f32_32x32x16_bf16(PAF(2),VFR(2),o[0],0,0,0), C1,0); \
    KRD(GL,3); GAPB(o[1]=__builtin_amdgcn_mfma_f32_32x32x16_bf16(PAF(2),VFR(6),o[1],0,0,0), C1,4); \
    GAPB(o[0]=__builtin_amdgcn_mfma_f32_32x32x16_bf16(PAF(3),VFR(3),o[0],0,0,0), C1,8); \
    GAPB(o[1]=__builtin_amdgcn_mfma_f32_32x32x16_bf16(PAF(3),VFR(7),o[1],0,0,0), C1,12); \
    }while(0)
  int t=1;
  #undef CMASK
  #define CMASK(P0,P1,t) do{}while(0)
  for(;t+5<NT;t+=2){
    STEP(pB0,pB1,pA0,pA1,t,true,true,true);     WAIT_BAR(2); RESC(); ROT();
    STEP(pA0,pA1,pB0,pB1,t+1,true,true,true);   WAIT_BAR(2); RESC(); ROT();
  }
  #undef CMASK
  #define CMASK(P0,P1,t) do{}while(0)
  #define ENDW(tt) do{ if((tt)+3<NT){WAIT_BAR(2);} else if((tt)+2<NT){WAIT_BAR(1);} else {WAIT_BAR(0);} }while(0)
  for(;t+1<NT;t+=2){
    STEP(pB0,pB1,pA0,pA1,t,(t+3<NT),(t+1<NT),(t+1<NT));       ENDW(t);   RESC(); ROT();
    STEP(pA0,pA1,pB0,pB1,t+1,(t+4<NT),(t+2<NT),(t+2<NT));     ENDW(t+1); RESC(); ROT();
  }
  STEP(pB0,pB1,pA0,pA1,NT-1,false,false,false); RESC();
  { float sacc=pB0[0]+pB0[1]; _Pragma("unroll") for(int r=2;r<16;++r)sacc+=pB0[r]; _Pragma("unroll") for(int r=0;r<16;++r)sacc+=pB1[r]; l_reg+=sacc;
    pw0=(u32x4){PKW(pB0,0),PKW(pB0,2),PKW(pB0,4),PKW(pB0,6)};pw1=(u32x4){PKW(pB0,8),PKW(pB0,10),PKW(pB0,12),PKW(pB0,14)};pw2=(u32x4){PKW(pB1,0),PKW(pB1,2),PKW(pB1,4),PKW(pB1,6)};pw3=(u32x4){PKW(pB1,8),PKW(pB1,10),PKW(pB1,12),PKW(pB1,14)};
    SBAR(); pv(o,vb0+sl_cur,PAF(0),PAF(1),PAF(2),PAF(3)); }
  #undef PKW
  #undef PAF
  #undef VFR
  #undef PIN
  #undef MX3
  #undef GAPA
  #undef GAPB
  #undef EX
  #undef VRD
  #undef KRD
  #undef STEP
  #undef ENDW
  {auto rr=__builtin_amdgcn_permlane32_swap(__float_as_uint(l_reg),__float_as_uint(l_reg),false,false);l_reg=__uint_as_float(rr[0])+__uint_as_float(rr[1]);}
  if(hi==0)wsf[32+r32]=l_reg;asm volatile("s_waitcnt lgkmcnt(0)":::"memory");
  float rli[16];
  #pragma unroll
  for(int r=0;r<16;++r)rli[r]=__builtin_amdgcn_rcpf(wsf[32+crow(r,hi)]);
  bf16*Ow=O+(rowbase+q0+wid*QBLK)*DM+h*D;
  { bf16*stg=(bf16*)(shm+LDS_OST)+wid*2048;
    #pragma unroll
    for(int r=0;r<16;++r){const int orow=crow(r,hi);
      #pragma unroll
      for(int d0=0;d0<2;++d0)stg[orow*64+d0*32+r32]=__float2bfloat16(o[d0][r]*rli[r]);}
    asm volatile("s_waitcnt lgkmcnt(0)":::"memory");
    #pragma unroll
    for(int i=0;i<4;++i){const int row=i*8+(lane>>3),ch=lane&7; const u32x4 v=*(const u32x4*)(stg+row*64+ch*8); ATTN_STORE16(Ow+(long)row*DM+ch*8,v);} }
  asm volatile("s_waitcnt lgkmcnt(0)\n\ts_barrier":::"memory");
  #undef DMA_K
  #undef DMA_V
  #undef CMASK
  #undef START
  #undef RESC
  #undef ROT
}
constexpr int ATTN_LDS_BYTES=LDS_BYTES;
#undef SBAR
#undef WAIT_BAR
}
namespace dil {
#define DLAS __attribute__((address_space(3)))
typedef unsigned short bf16_t;
typedef short bf16x8 __attribute__((ext_vector_type(8)));
typedef short s16x4 __attribute__((ext_vector_type(4)));
typedef float f32x16 __attribute__((ext_vector_type(16)));
typedef unsigned u32x4 __attribute__((ext_vector_type(4)));
constexpr int ROWB = 144;
constexpr int WAVE_LDS = 32 * ROWB + 256;
__device__ __forceinline__ int crow(int r, int hi) { return (r & 3) + 8 * (r >> 2) + 4 * hi; }
typedef float f32x2d __attribute__((ext_vector_type(2))); typedef __bf16 bf16x2d __attribute__((ext_vector_type(2)));
__device__ __forceinline__ unsigned cvtpk(float lo, float hi) { const f32x2d v = {lo, hi}; const bf16x2d b = __builtin_convertvector(v, bf16x2d); return __builtin_bit_cast(unsigned, b); }
__device__ __forceinline__ int clampi(int v) { return v < 0 ? 0 : (v > SEQ - 1 ? SEQ - 1 : v); }

__device__ __forceinline__ void load_tile(const bf16_t* Pb, int base, int dg, int m0, int kcol, int vcol, int lane, bf16x8 (&kf)[4], u32x4 (&vr)[4], bool doK, bool doV) {
    const int r32 = lane & 31, hi = lane >> 5;
    const int tk = clampi(base + dg * (m0 + r32));
    const bf16_t* kp = Pb + (size_t)tk * PP + kcol + 8 * hi;
    if (doK) {
#pragma unroll
    for (int d0 = 0; d0 < 4; ++d0) kf[d0] = *(const bf16x8*)(kp + 16 * d0); }
    if (doV)
#pragma unroll
    for (int c = 0; c < 4; ++c) { const int tv = clampi(base + dg * (m0 + 8 * c + (lane >> 3)));
        vr[c] = *(const u32x4*)(Pb + (size_t)tv * PP + vcol + 8 * (lane & 7)); }
}

__device__ __forceinline__ void dil_group(const bf16_t* Pb, int base, int qstride, int dg, int rho, int ntile, int qcol, DLAS unsigned char* wl, DLAS float* sc, int lane, int vaddr,
                                          float& m_run, float& l_run, f32x16& o0, f32x16& o1) {
    const int r32 = lane & 31, hi = lane >> 5; const int kcol = qcol + 256, vcol = qcol + 512;
    bf16x8 qf[4];
    { const bf16_t* qp = Pb + (size_t)(base + qstride * r32) * PP + qcol + 8 * hi;
#pragma unroll
      for (int d0 = 0; d0 < 4; ++d0) qf[d0] = *(const bf16x8*)(qp + 16 * d0); }
    bf16x8 kf[4], kn[4]; u32x4 vr[4];
    load_tile(Pb, base, dg, -64, kcol, vcol, lane, kf, vr, true, false);
    for (int T = 0; T < ntile; ++T) {
        const int m0 = -64 + 32 * T;
        load_tile(Pb, base, dg, m0, kcol, vcol, lane, kn, vr, false, true);
        if (T + 1 < ntile) load_tile(Pb, base, dg, m0 + 32, kcol, vcol, lane, kn, vr, true, false);
        f32x16 p = {};
#pragma unroll
        for (int d0 = 0; d0 < 4; ++d0) p = __builtin_amdgcn_mfma_f32_32x32x16_bf16(kf[d0], qf[d0], p, 0, 0, 0);
#pragma unroll
        for (int c = 0; c < 4; ++c) *(DLAS u32x4*)(wl + (8 * c + (lane >> 3)) * ROWB + (lane & 7) * 16) = vr[c];
        bool valid[16]; float mx = -1e30f;
#pragma unroll
        for (int r = 0; r < 16; ++r) { const int m = m0 + crow(r, hi); const int tok = base + dg * m;
            valid[r] = ((unsigned)(m - rho * r32 + 64) <= 128u) && ((unsigned)tok < (unsigned)SEQ);
            p[r] = valid[r] ? p[r] : -1e30f; mx = fmaxf(mx, p[r]); }
        mx = fmaxf(mx, __shfl_xor(mx, 32));
        const float m_new = fmaxf(m_run, mx), alpha = __builtin_amdgcn_exp2f(m_run - m_new); m_run = m_new;
        float psum = 0.f;
#pragma unroll
        for (int r = 0; r < 16; ++r) { const float e = valid[r] ? __builtin_amdgcn_exp2f(p[r] - m_new) : 0.f; p[r] = e; psum += e; }
        l_run = l_run * alpha + psum;
        if (!__all(alpha == 1.0f)) {
            if (hi == 0) sc[r32] = alpha;
#pragma unroll
            for (int r = 0; r < 16; ++r) { const float a = sc[crow(r, hi)]; o0[r] *= a; o1[r] *= a; }
        }
        u32x4 pk0, pk1;
        pk0.x = cvtpk(p[0], p[1]); pk0.y = cvtpk(p[2], p[3]); pk0.z = cvtpk(p[4], p[5]); pk0.w = cvtpk(p[6], p[7]);
        pk1.x = cvtpk(p[8], p[9]); pk1.y = cvtpk(p[10], p[11]); pk1.z = cvtpk(p[12], p[13]); pk1.w = cvtpk(p[14], p[15]);
        const bf16x8 pa0 = __builtin_bit_cast(bf16x8, pk0), pa1 = __builtin_bit_cast(bf16x8, pk1);
#pragma unroll
        for (int s = 0; s < 2; ++s) {
#pragma unroll
            for (int d0 = 0; d0 < 2; ++d0) {
                DLAS unsigned char* va = wl + vaddr + (16 * s + 4 * hi) * ROWB + d0 * 64;
                const s16x4 lo = __builtin_bit_cast(s16x4, __builtin_amdgcn_ds_read_tr16_b64_v4i16((DLAS s16x4*)va));
                const s16x4 hh = __builtin_bit_cast(s16x4, __builtin_amdgcn_ds_read_tr16_b64_v4i16((DLAS s16x4*)(va + 8 * ROWB)));
                const bf16x8 vf = (bf16x8){lo[0], lo[1], lo[2], lo[3], hh[0], hh[1], hh[2], hh[3]};
                if (d0 == 0) o0 = __builtin_amdgcn_mfma_f32_32x32x16_bf16(s == 0 ? pa0 : pa1, vf, o0, 0, 0, 0);
                else         o1 = __builtin_amdgcn_mfma_f32_32x32x16_bf16(s == 0 ? pa0 : pa1, vf, o1, 0, 0, 0);
            }
        }
#pragma unroll
        for (int i = 0; i < 4; ++i) kf[i] = kn[i];
    }
}
__device__ __forceinline__ void dil_pass1(bf16_t* P, int grp, int j, DLAS unsigned char* wl, int lane, float* SO, float* SM, float* SL) {
    const int r32 = lane & 31, hi = lane >> 5; const int b = grp >> 5, h = (grp >> 3) & 3, blk = grp & 7; const int base = 512 * blk + 32 * j;
    const bf16_t* Pb = P + (size_t)b * SEQ * PP; DLAS float* sc = (DLAS float*)(wl + 32 * ROWB);
    const int vaddr = ((lane & 15) >> 2) * ROWB + (((lane >> 4) & 1) * 16 + (lane & 3) * 4) * 2;
    float m_run = -1e30f, l_run = 0.f; f32x16 o0 = {}, o1 = {};
    dil_group(Pb, base, 1, 1, 1, 5, C_B0 + 64 * h, wl, sc, lane, vaddr, m_run, l_run, o0, o1);
    l_run += __shfl_xor(l_run, 32);
    const size_t srow = ((size_t)(b * 4 + h) * SEQ + base);
    if (hi == 0) { SM[srow + r32] = m_run; SL[srow + r32] = l_run; }
#pragma unroll
    for (int r = 0; r < 16; ++r) { float* so = SO + (srow + crow(r, hi)) * 64 + r32; so[0] = o0[r]; so[32] = o1[r]; }
}
__device__ __forceinline__ void dil_pass2(bf16_t* P, int grp, int rr, DLAS unsigned char* wl, int lane, const float* SO, const float* SM, const float* SL) {
    const int r32 = lane & 31, hi = lane >> 5; const int b = grp >> 5, h = (grp >> 3) & 3, blk = grp & 7; const int base = 512 * blk + rr;
    bf16_t* Pb = P + (size_t)b * SEQ * PP; DLAS float* sc = (DLAS float*)(wl + 32 * ROWB);
    const int vaddr = ((lane & 15) >> 2) * ROWB + (((lane >> 4) & 1) * 16 + (lane & 3) * 4) * 2;
    const size_t srow = ((size_t)(b * 4 + h) * SEQ + base);
    float m_run = SM[srow + 16 * r32], l_run = (hi == 0) ? SL[srow + 16 * r32] : 0.f; f32x16 o0, o1;
#pragma unroll
    for (int r = 0; r < 16; ++r) { const float* so = SO + (srow + 16 * crow(r, hi)) * 64 + r32; o0[r] = so[0]; o1[r] = so[32]; }
#pragma unroll 1
    for (int g = 1; g <= 2; ++g) dil_group(Pb, base, 16, 1 << (2 * g), 16 >> (2 * g), g == 1 ? 8 : 5, C_B0 + 768 * g + 64 * h, wl, sc, lane, vaddr, m_run, l_run, o0, o1);
    l_run += __shfl_xor(l_run, 32);
    if (hi == 0) sc[32 + r32] = __builtin_amdgcn_rcpf(l_run);
    bf16_t* op = Pb + (size_t)base * PP + C_OB + 64 * h + r32;
#pragma unroll
    for (int r = 0; r < 16; ++r) { const int q = crow(r, hi); const float inv = sc[32 + q];
        const __hip_bfloat16 a = __float2bfloat16(o0[r] * inv), c = __float2bfloat16(o1[r] * inv);
        op[(size_t)(16 * q) * PP] = __builtin_bit_cast(unsigned short, a); op[(size_t)(16 * q) * PP + 32] = __builtin_bit_cast(unsigned short, c); }
}
}


namespace naive {
__device__ __forceinline__ float bf2f(unsigned short v) { return __uint_as_float((unsigned)v << 16); }
__device__ __forceinline__ float wmax(float v) {
#pragma unroll
    for (int o = 1; o < 64; o <<= 1) v = fmaxf(v, __shfl_xor(v, o));
    return v;
}
__device__ __forceinline__ float wsum(float v) {
#pragma unroll
    for (int o = 1; o < 64; o <<= 1) v += __shfl_xor(v, o);
    return v;
}
__device__ __forceinline__ void dense_task(unsigned short* P, int task, __attribute__((address_space(3))) float* qs, int lane) {
    const int m = task >> 3, hq = task & 7, b = m >> 12;
    unsigned short* prow = P + (size_t)m * PP + C_QA + 64 * hq;
    qs[lane] = bf2f(prow[lane]);
    const unsigned short* kb = P + (size_t)b * SEQ * PP + C_KA + 64 * (hq >> 2);
    const unsigned short* vb = P + (size_t)b * SEQ * PP + C_VA + 64 * (hq >> 2);
    float m_run = -1e30f, l = 0.f, o = 0.f;
    for (int kc = 0; kc < SEQ / 64; ++kc) {
        const unsigned short* kr = kb + (size_t)(kc * 64 + lane) * PP;
        float s = 0.f;
#pragma unroll 8
        for (int d = 0; d < 64; ++d) s += qs[d] * bf2f(kr[d]);
        const float m_new = fmaxf(m_run, wmax(s)), alpha = __builtin_amdgcn_exp2f(m_run - m_new), p = __builtin_amdgcn_exp2f(s - m_new);
        m_run = m_new; l = l * alpha + wsum(p); o *= alpha;
        for (int j = 0; j < 64; ++j) o += __shfl(p, j) * bf2f(vb[(size_t)(kc * 64 + j) * PP + lane]);
    }
    const __hip_bfloat16 r = __float2bfloat16(o / l);
    prow[lane] = __builtin_bit_cast(unsigned short, r);
}
__device__ __forceinline__ void dil_task(unsigned short* P, int task, __attribute__((address_space(3))) float* qs, int lane) {
    const int m = task >> 2, h = task & 3, b = m >> 12, t = m & (SEQ - 1);
    const unsigned short* Pb = P + (size_t)b * SEQ * PP;
    float m_run = -1e30f, l = 0.f, o = 0.f;
    for (int g = 0; g < 3; ++g) {
        const int dg = 1 << (2 * g); const int qcol = C_B0 + 768 * g + 64 * h, kcol = qcol + 256, vcol = qcol + 512;
        qs[lane] = bf2f(Pb[(size_t)t * PP + qcol + lane]);
        for (int c = 0; c < 3; ++c) {
            const int j = -64 + 64 * c + lane, tok = t + dg * j; const bool valid = (j <= 64) && (tok >= 0) && (tok < SEQ);
            const unsigned short* kr = Pb + (size_t)(valid ? tok : t) * PP + kcol;
            float s = 0.f;
#pragma unroll 8
            for (int d = 0; d < 64; ++d) s += qs[d] * bf2f(kr[d]);
            s = valid ? s : -1e30f;
            const float m_new = fmaxf(m_run, wmax(s)), alpha = __builtin_amdgcn_exp2f(m_run - m_new), p = valid ? __builtin_amdgcn_exp2f(s - m_new) : 0.f;
            m_run = m_new; l = l * alpha + wsum(p); o *= alpha;
            for (int jj = 0; jj < 64; ++jj) { int tk = t + dg * (-64 + 64 * c + jj); tk = tk < 0 ? 0 : (tk > SEQ - 1 ? SEQ - 1 : tk);
                o += __shfl(p, jj) * bf2f(Pb[(size_t)tk * PP + vcol + lane]); }
        }
    }
    const __hip_bfloat16 r = __float2bfloat16(o / l);
    P[(size_t)m * PP + C_OB + 64 * h + lane] = __builtin_bit_cast(unsigned short, r);
}
}


namespace naive {
__device__ __forceinline__ float blo(unsigned w) { return __uint_as_float(w << 16); }
__device__ __forceinline__ float bhi(unsigned w) { return __uint_as_float(w & 0xffff0000u); }
__device__ __forceinline__ unsigned short f2b(float v) { const __hip_bfloat16 r = __float2bfloat16(v); return __builtin_bit_cast(unsigned short, r); }
__device__ __forceinline__ float dotcol(const unsigned short* arow, const float* W, int K, int N, int c) {
    float s = 0.f;
    for (int k = 0; k < K; k += 2) { const unsigned w2 = *(const unsigned*)(arow + k); s += blo(w2) * W[(size_t)k * N + c]; s += bhi(w2) * W[(size_t)(k + 1) * N + c]; }
    return s;
}
__device__ __forceinline__ void gin_task(int w, int lane, const unsigned short* XN, unsigned short* P, const float* win, const float* qna, const float* kna, const float* qnb, const float* knb) {
    const int m = w / 80, cg = w % 80, c = 64 * cg + lane, t = m & (SEQ - 1);
    if (!NAIVE_GIN && !((DBG_SKIP >> (cg >> 2)) & 1u)) return;
    const float z = dotcol(XN + (size_t)m * DM, win, DM, NIN, c);
    float o;
    if (cg >= 48) o = 1.0f / (1.0f + expf(-z));
    else {
        int mode; const float* gn = qna; float scale = 1.f;
        if (cg < 8) { mode = 0; gn = qna; scale = QK_C2; }
        else if (cg < 10) { mode = 0; gn = kna; }
        else if (cg < 12) mode = 2;
        else { const int g = (cg - 12) / 12, rem = (cg - 12) % 12; if (rem < 4) { mode = 1; gn = qnb + 64 * g; scale = QK_C2; } else if (rem < 8) { mode = 1; gn = knb + 64 * g; } else mode = 2; }
        if (mode == 2) o = z;
        else {
            const float ss = wsum(z * z), y = z * (1.0f / sqrtf(ss * (1.0f / 64.0f) + EPS)) * gn[lane];
            float ang; bool first; float partner;
            if (mode == 0) { const int dd = lane & 31, i = dd & 15, pos = (lane >> 5) ? (t & 63) : (t >> 6); ang = (float)pos * powf(10000.0f, -(float)i / 16.0f); first = dd < 16; partner = __shfl_xor(y, 16); }
            else { const int i = lane & 31; ang = (float)t * powf(10000.0f, -(float)i / 32.0f); first = lane < 32; partner = __shfl_xor(y, 32); }
            const double a = (double)ang; const float cs = (float)cos(a), sn = (float)sin(a);
            o = (first ? (y * cs - partner * sn) : (y * cs + partner * sn)) * scale;
        }
    }
    P[(size_t)m * PP + c] = f2b(o);
}
}

#define LAS __attribute__((address_space(3)))
typedef unsigned short bf16;
typedef unsigned v4u __attribute__((ext_vector_type(4)));
typedef float f32x4 __attribute__((ext_vector_type(4)));
constexpr int NWAVES = 8;
constexpr size_t MiB = 1u << 20;
constexpr size_t WS_ADA = 1 * MiB, WS_TABB = 2 * MiB, WS_TABA = 3 * MiB;
constexpr size_t WS_WIN = 4 * MiB, WS_WA = 44 * MiB, WS_WB = 48 * MiB, WS_WO = 50 * MiB, WS_W1 = 58 * MiB, WS_W2 = 90 * MiB;
constexpr size_t WS_XN = 122 * MiB, WS_P = 186 * MiB, WS_XSB = 442 * MiB, WS_RSS = 506 * MiB, WS_END = 508 * MiB;
constexpr size_t WS_BIASA = 64 * 1024, WS_GS = 704 * 1024, WS_BIASF = 3 * MiB + 64 * 1024;
constexpr int RING_BYTES = 131072, LDS_BYTES = 147456;
constexpr int NPHASE = 2 + 6 * DEPTH;

__device__ __forceinline__ unsigned f2bf(float f) { unsigned u = __builtin_bit_cast(unsigned, f); return (u + 0x7fffu + ((u >> 16) & 1u)) >> 16; }
__device__ __forceinline__ unsigned pk2(float lo, float hi) { return f2bf(lo) | (f2bf(hi) << 16); }
#define LDS_WAIT() asm volatile("s_waitcnt lgkmcnt(0)" ::: "memory")
__device__ __forceinline__ float wave_sum(float v) {
#pragma unroll
    for (int o = 1; o < 64; o <<= 1) v += __shfl_xor(v, o);
    return v;
}
__device__ __forceinline__ int win_dst_row(int n) {
    const int pn = n >> 8, u = n & 255, wc = u >> 6, d = u & 63, e = d & 7;
    if (pn >= 12) return n;
    int bj, fq;
    if (pn <= 1 || (pn == 2 && wc < 2)) { bj = (d >> 4) & 1; fq = 2 * (d >> 5) + ((d >> 3) & 1); }
    else { bj = d >> 5; fq = (d >> 3) & 3; }
    return (pn << 8) + 128 * bj + 32 * wc + 8 * fq + e;
}
__device__ __forceinline__ void p0_transpose_item(const float* W, int K, int N, bf16* WT, bool perm, LAS float* scr, int item, int lane) {
    const int nblk = N / 32, kb = item / nblk, nb = item % nblk, k0 = 64 * kb, n0 = 32 * nb;
#pragma unroll 8
    for (int i = 0; i < 32; ++i) { const int kk = 2 * i + (lane >> 5); scr[kk * 33 + (lane & 31)] = W[(size_t)(k0 + kk) * N + n0 + (lane & 31)]; }
    LDS_WAIT(); asm volatile("" ::: "memory");
    const int c = lane & 7;
#pragma unroll
    for (int j = 0; j < 4; ++j) { const int n = (lane >> 3) + 8 * j; const LAS float* s = scr + (8 * c) * 33 + n;
        v4u o; o.x = pk2(s[0 * 33], s[1 * 33]); o.y = pk2(s[2 * 33], s[3 * 33]); o.z = pk2(s[4 * 33], s[5 * 33]); o.w = pk2(s[6 * 33], s[7 * 33]);
        const int row = perm ? win_dst_row(n0 + n) : (n0 + n);
        *(v4u*)(WT + (size_t)row * K + k0 + 8 * c) = o; }
    LDS_WAIT(); asm volatile("" ::: "memory");
}

__device__ __forceinline__ void gemv8_block(const float* W, int N, int n0, const LAS float* vec, LAS float* red, float* dst, int dstride, const float* addv, int wave, int lane) {
    const int cg = lane & 15, rg = lane >> 4;
    f32x4 a[8];
#pragma unroll
    for (int b = 0; b < 8; ++b) a[b] = (f32x4){0.f, 0.f, 0.f, 0.f};
    const float* wp = W + (size_t)(wave * 128 + rg) * N + n0 + 4 * cg;
#pragma unroll 8
    for (int i = 0; i < 32; ++i) { const f32x4 wv = *(const f32x4*)(wp + (size_t)(4 * i) * N); const int kk = wave * 128 + 4 * i + rg;
#pragma unroll
        for (int b = 0; b < 8; ++b) a[b] += wv * vec[b * DM + kk]; }
#pragma unroll
    for (int b = 0; b < 8; ++b)
#pragma unroll
        for (int j = 0; j < 4; ++j) { float v = a[b][j]; v += __shfl_xor(v, 16); v += __shfl_xor(v, 32); a[b][j] = v; }
    if (rg == 0) {
#pragma unroll
        for (int b = 0; b < 8; ++b) *(LAS f32x4*)(red + (wave * 8 + b) * 64 + 4 * cg) = a[b];
    }
    __syncthreads();
    { float s = addv ? addv[n0 + lane] : 0.f;
#pragma unroll
      for (int w2 = 0; w2 < 8; ++w2) s += red[(w2 * 8 + wave) * 64 + lane];
      dst[(size_t)wave * dstride + n0 + lane] = s; }
    __syncthreads();
}

#define XB_TMO      128
#define XB_XCNT(j)  (256  + 64 * (j))
#define XB_XSUB(j)  (1280 + 64 * (j))
#define XB_XGEN(j)  (2304 + 64 * (j))
#define XB_TOP      3328
#define XB_TOPGEN   3392
#define XCD_BAR_WORDS 3456
#define XB_SPIN_CAP (1u << 18)

__device__ __forceinline__ unsigned xb_ld(unsigned* p)              { return __hip_atomic_load(p, __ATOMIC_RELAXED, __HIP_MEMORY_SCOPE_AGENT); }
__device__ __forceinline__ unsigned xb_add(unsigned* p, unsigned v) { return __hip_atomic_fetch_add(p, v, __ATOMIC_RELAXED, __HIP_MEMORY_SCOPE_AGENT); }
__device__ __forceinline__ unsigned xb_xcc_id() { return (unsigned)__builtin_amdgcn_s_getreg((3 << 11) | 20) & 0xFu; }
#define XB_SPIN(cond, bar) do { unsigned _sp = 0; while (cond) { __builtin_amdgcn_s_sleep(1); \
    if ((++_sp & 255u) == 0u) { if (xb_ld(&(bar)[XB_TMO])) break; if (_sp > XB_SPIN_CAP) { atomicAdd(&(bar)[XB_TMO], 1u); break; } } } } while (0)

struct XcdBarrier {
    unsigned* bar; unsigned x;
    volatile LAS unsigned* st;
};

__device__ __forceinline__ XcdBarrier xcd_barrier_post(unsigned* bar, volatile LAS unsigned* st, bool leader) {
    XcdBarrier b; b.bar = bar; b.x = xb_xcc_id(); b.st = st;
    if (leader) (void)xb_add(&bar[XB_XCNT(b.x)], 1u);
    return b;
}
__device__ __forceinline__ void xcd_barrier_complete(unsigned* bar, unsigned x, unsigned& nloc, unsigned& nx) {
    const unsigned G = gridDim.x * gridDim.y * gridDim.z;
    unsigned sum, cnt, mine, sp = 0u;
    for (;;) {
        sum = 0u; cnt = 0u; mine = 0u;
#pragma unroll
        for (unsigned j = 0; j < 16; ++j) { const unsigned c = xb_ld(&bar[XB_XCNT(j)]); sum += c; cnt += (c > 0u) ? 1u : 0u; mine = (j == x) ? c : mine; }
        if (sum == G) break;
        __builtin_amdgcn_s_sleep(1);
        if ((++sp & 255u) == 0u) { if (xb_ld(&bar[XB_TMO])) break; if (sp > XB_SPIN_CAP) { atomicAdd(&bar[XB_TMO], 1u); break; } }
    }
    nloc = mine > 0u ? mine : 1u; nx = cnt > 0u ? cnt : 1u;
}

__device__ __forceinline__ void xcd_barrier(const XcdBarrier& b, bool leader) {
    asm volatile("s_waitcnt vmcnt(0)" ::: "memory");
    __syncthreads();
    if (leader) {
        unsigned* bar = b.bar;
        __builtin_amdgcn_s_waitcnt(0);
        unsigned nloc = b.st[0], nx = b.st[1];
        if (nloc == 0u) { xcd_barrier_complete(bar, b.x, nloc, nx); b.st[0] = nloc; b.st[1] = nx; }
        const unsigned old = xb_add(&bar[XB_XSUB(b.x)], 1u);
        const unsigned gen = old / nloc;
        if (old + 1u == (gen + 1u) * nloc) {
            __builtin_amdgcn_fence(__ATOMIC_RELEASE, "agent");
            asm volatile("s_waitcnt vmcnt(0)" ::: "memory");
            const unsigned og = xb_add(&bar[XB_TOP], 1u);
            const unsigned tg = og / nx;
            if (og + 1u == (tg + 1u) * nx) xb_add(&bar[XB_TOPGEN], 1u);
            else XB_SPIN(xb_ld(&bar[XB_TOPGEN]) == tg, bar);
            __builtin_amdgcn_fence(__ATOMIC_ACQUIRE, "agent");
            xb_add(&bar[XB_XGEN(b.x)], 1u);
            asm volatile("s_waitcnt vmcnt(0)" ::: "memory");
        } else {
            XB_SPIN(xb_ld(&bar[XB_XGEN(b.x)]) == gen, bar);
            __builtin_amdgcn_fence(__ATOMIC_ACQUIRE, "agent");
            asm volatile("s_waitcnt vmcnt(0)" ::: "memory");
        }
    }
    __syncthreads();
}

struct Args { const float* in[16]; float* out; unsigned char* ws; int ph_lo, ph_hi; };

typedef const Args __attribute__((address_space(4))) CArgs;
template <int ph> __device__ __forceinline__ void run_phase(CArgs* ap0, const int wave0, unsigned char* lds) {
    LAS unsigned char* L = (LAS unsigned char*)lds;
        int zz = 0; asm volatile("" : "+v"(zz));
        const int lane = __builtin_amdgcn_mbcnt_hi(~0u, __builtin_amdgcn_mbcnt_lo(~0u, zz)), wave = wave0;
        const int tid = wave * 64 + lane;
        int bx = blockIdx.x; asm volatile("" : "+s"(bx));
        const int G = gridDim.x; const int vcu = (G % 8 == 0) ? (bx % 8) * (G / 8) + bx / 8 : bx;
        const int gw = vcu * NWAVES + wave, NGW = G * NWAVES;
        CArgs* ap = ap0; asm volatile("" : "+s"(ap));
        unsigned char* ws = ap->ws;
        float* ADA = (float*)(ws + WS_ADA); float* TABB = (float*)(ws + WS_TABB); float* TABA = (float*)(ws + WS_TABA);
        bf16* XN = (bf16*)(ws + WS_XN); bf16* P = (bf16*)(ws + WS_P); bf16* HB = (bf16*)(ws + WS_P);
        const float* x_in = ap->in[0]; float* out = ap->out;
        if (ph == 0) {
            {
                LAS float* cact = (LAS float*)L;
                LAS float* red = (LAS float*)(L + 32768);
                for (int i = tid; i < BATCH * DM; i += NWAVES * 64) { const float v = ap->in[1][i]; cact[i] = v * __builtin_amdgcn_rcpf(1.0f + __expf(-v)); }
                __syncthreads();
                for (int it = bx; it < DEPTH * 96; it += G) {
                    const int l = it / 96, n0 = (it % 96) * 64;
                    gemv8_block(ap->in[2] + (size_t)l * DM * 6 * DM, 6 * DM, n0, cact, red, ADA + (size_t)l * BATCH * 6 * DM, 6 * DM, ap->in[3] + (size_t)l * 6 * DM, wave, lane);
                }
            }
            {
                for (int e = bx * NWAVES * 64 + tid; e < SEQ * 32 + 64 * 16; e += G * NWAVES * 64) {
                    int pos, i; float fr; float* dst;
                    if (e < SEQ * 32) { pos = e >> 5; i = e & 31; fr = (float)i * (1.0f / 32.0f); dst = TABB + 2 * (size_t)e; }
                    else { const int e2 = e - SEQ * 32; pos = e2 >> 4; i = e2 & 15; fr = (float)i * (1.0f / 16.0f); dst = TABA + 2 * (size_t)e2; }
                    const float inv = exp2f(-fr * 13.287712379549449f);
                    const float ang = (float)pos * inv;
                    const double turns = (double)ang * 0.15915494309189535;
                    const float fpart = (float)(turns - rint(turns));
#if TAB_DOUBLE
                    dst[0] = (float)cos((double)ang); dst[1] = (float)sin((double)ang);
#else
                    dst[0] = __builtin_amdgcn_cosf(fpart); dst[1] = __builtin_amdgcn_sinf(fpart);
#endif
                }
            }
            {
                LAS float* scr = (LAS float*)(L + wave * 16384);
                constexpr int I_IN = (DM / 64) * (NIN / 32), I_A = (512 / 64) * (DM / 32), I_B = (256 / 64) * (DM / 32), I_O = (DM / 64) * (DM / 32), I_1 = (DM / 64) * (FF / 32), I_2 = (FF / 64) * (DM / 32);
                constexpr int I_L = I_IN + I_A + I_B + I_O + I_1 + I_2;
                __syncthreads();
                for (int it = gw; it < DEPTH * I_L; it += NGW) {
                    const int l = it / I_L; int r = it - l * I_L;
                    if (r < I_IN) { p0_transpose_item(ap->in[6] + (size_t)l * DM * NIN, DM, NIN, (bf16*)(ws + WS_WIN) + (size_t)l * NIN * DM, true, scr, r, lane); continue; } r -= I_IN;
                    if (r < I_A) { p0_transpose_item(ap->in[11] + (size_t)l * 512 * DM, 512, DM, (bf16*)(ws + WS_WA) + (size_t)l * DM * 512, false, scr, r, lane); continue; } r -= I_A;
                    if (r < I_B) { p0_transpose_item(ap->in[12] + (size_t)l * 256 * DM, 256, DM, (bf16*)(ws + WS_WB) + (size_t)l * DM * 256, false, scr, r, lane); continue; } r -= I_B;
                    if (r < I_O) { p0_transpose_item(ap->in[13] + (size_t)l * DM * DM, DM, DM, (bf16*)(ws + WS_WO) + (size_t)l * DM * DM, false, scr, r, lane); continue; } r -= I_O;
                    if (r < I_1) { p0_transpose_item(ap->in[14] + (size_t)l * DM * FF, DM, FF, (bf16*)(ws + WS_W1) + (size_t)l * FF * DM, false, scr, r, lane); continue; } r -= I_1;
                    p0_transpose_item(ap->in[15] + (size_t)l * FF * DM, FF, DM, (bf16*)(ws + WS_W2) + (size_t)l * DM * FF, false, scr, r, lane);
                }
                __syncthreads();
            }
        } else {
            const int l = (ph - 2) / 6, sub6 = (ph - 2) % 6;
            const int sub = (ph == 1) ? 0 : (sub6 == 0 ? 1 : sub6 == 1 ? 2 : sub6 == 2 ? 3 : sub6 == 3 ? 4 : sub6 == 4 ? 6 : 7);
            const float* ada_l = ADA + (size_t)l * BATCH * 6 * DM;
            float* RSS = (float*)(ws + WS_RSS); float* GSV = (float*)(ws + WS_GS); float* BIASA = (float*)(ws + WS_BIASA); float* BIASF = (float*)(ws + WS_BIASF); bf16* XSB = (bf16*)(ws + WS_XSB);
            if (sub == 0) {
                { LAS float* shv = (LAS float*)L;
                  LAS float* red = (LAS float*)(L + 32768);
                  for (int it = bx; it < DEPTH * 144; it += G) {
                      const int ll = it / 144, r = it % 144; const bool isA = r < 80; const int n0 = (isA ? r : r - 80) * 64, N = isA ? NIN : FF;
                      const float* W = (isA ? ap->in[6] + (size_t)ll * DM * NIN : ap->in[14] + (size_t)ll * DM * FF);
                      const float* adl = ADA + (size_t)ll * BATCH * 6 * DM + (isA ? 0 : 3 * DM);
                      for (int i = tid; i < BATCH * DM; i += NWAVES * 64) shv[i] = adl[(size_t)(i >> 10) * 6 * DM + (i & 1023)];
                      __syncthreads();
                      gemv8_block(W, N, n0, shv, red, isA ? BIASA + (size_t)ll * BATCH * NIN : BIASF + (size_t)ll * BATCH * FF, N, nullptr, wave, lane);
                  } }
                for (int e = bx * NWAVES * 64 + tid; e < 2 * DEPTH * BATCH * DM; e += G * NWAVES * 64) {
                    const int which = e >> 15, ll = (e >> 13) & 3, b = (e >> 10) & 7, c = e & 1023;
                    GSV[e] = (which ? ap->in[5] : ap->in[4])[ll * DM + c] * (1.0f + ADA[((size_t)ll * BATCH + b) * 6 * DM + (which ? 4 : 1) * DM + c]);
                }
                { f32x4 gg[4];
#pragma unroll
                  for (int j = 0; j < 4; ++j) gg[j] = *(const f32x4*)(ap->in[4] + 256 * j + 4 * lane);
                  for (int m = gw; m < MTOK; m += NGW) {
                    const int b = m >> 12; const f32x4* xr = (const f32x4*)(x_in + (size_t)m * DM) + lane;
                    f32x4 v[4]; float s = 0.f;
#pragma unroll
                    for (int j = 0; j < 4; ++j) { v[j] = xr[64 * j]; s += (v[j][0] * v[j][0] + v[j][1] * v[j][1]) + (v[j][2] * v[j][2] + v[j][3] * v[j][3]); }
                    s = wave_sum(s);
                    if (lane < 16) RSS[(size_t)m * 16 + lane] = (lane == 0) ? s : 0.f;
                    const float* ab = ADA + (size_t)b * 6 * DM + DM;
                    unsigned long long* o8 = (unsigned long long*)(XN + (size_t)m * DM) + lane;
#pragma unroll
                    for (int j = 0; j < 4; ++j) { const f32x4 sc = *(const f32x4*)(ab + 256 * j + 4 * lane);
                        const f32x4 y = v[j] * gg[j] * (sc + 1.0f);
                        o8[64 * j] = (unsigned long long)pk2(y[0], y[1]) | ((unsigned long long)pk2(y[2], y[3]) << 32); }
                  } }
            } else if (sub == 1) {
                pg8::Gemm g{XN, (const bf16*)(ws + WS_WIN) + (size_t)l * NIN * DM, MTOK, NIN, DM, DM}; pg8::StaticOrder S; S.init(MTOK, NIN, G, bx);
                pg8::EpiIn E{P, ap->in[7] + l * 64, ap->in[8] + l * 64, ap->in[9] + l * 192, ap->in[10] + l * 192, TABA, TABB, RSS, BIASA + (size_t)l * BATCH * NIN};
#if NAIVE_GIN
                for (int w = gw; w < MTOK * 80; w += NGW) naive::gin_task(w, lane, XN, P, ap->in[6] + (size_t)l * DM * NIN, ap->in[7] + l * 64, ap->in[8] + l * 64, ap->in[9] + l * 192, ap->in[10] + l * 192);
#else
#ifndef NO_GIN
                pg8::gemm_phase<pg8::EpiIn, pg8::StaticOrder, true, true, DM, DM>(tid, L, g, S, E);
#if DBG_GEMM2 & 1
                pg8::gemm_phase<pg8::EpiIn, pg8::StaticOrder, true, true, DM, DM>(tid, L, g, S, E);
#endif
#endif
#if DBG_SKIP
                for (int w = gw; w < MTOK * 80; w += NGW) naive::gin_task(w, lane, XN, P, ap->in[6] + (size_t)l * DM * NIN, ap->in[7] + l * 64, ap->in[8] + l * 64, ap->in[9] + l * 192, ap->in[10] + l * 192);
#endif
#endif
            } else if (sub == 2) {
                for (int u = vcu; u < BATCH * 8 * 16; u += G) {
                    const int i = u / G, uu = i * G + vcu;
                    const int b = uu >> 7, h = (uu >> 4) & 7, qb = uu & 15;
#if !defined(NO_ATT) && !NAIVE_ATT
                    attn_body::attn_unit<8>(b, h, qb, (const attn_body::bf16*)P + C_QA, (const attn_body::bf16*)P + C_KA, (const attn_body::bf16*)P + C_VA, (attn_body::bf16*)P + C_QA, (char*)lds, tid);
#endif
                }
                __syncthreads();
#if NAIVE_ATT
                for (int w = gw; w < MTOK * 8; w += NGW) naive::dense_task(P, w, (LAS float*)(L + wave * 256), lane);
                __syncthreads();
#endif
#if NAIVE_DIL
                for (int w = gw; w < MTOK * 4; w += NGW) naive::dil_task(P, w, (LAS float*)(L + wave * 256), lane);
#elif !defined(NO_DIL)
                { float* SO = (float*)(ws + WS_XN); float* SM = (float*)(ws + WS_XN + 32 * MiB); float* SL = (float*)(ws + WS_XN + 33 * MiB);
                  for (int grp = vcu; grp < BATCH * 4 * 8; grp += G) {
#pragma unroll 1
                    for (int k2 = 0; k2 < 2; ++k2) dil::dil_pass1(P, grp, wave + 8 * k2, L + wave * dil::WAVE_LDS, lane, SO, SM, SL);
                    asm volatile("s_waitcnt vmcnt(0)" ::: "memory"); __syncthreads();
#pragma unroll 1
                    for (int k2 = 0; k2 < 2; ++k2) dil::dil_pass2(P, grp, wave + 8 * k2, L + wave * dil::WAVE_LDS, lane, SO, SM, SL);
                    __syncthreads();
                  } }
#endif
                __syncthreads();
            } else if (sub == 3) {
                { pg8::Gemm g{P + C_QA, (const bf16*)(ws + WS_WA) + (size_t)l * DM * 512, MTOK, DM, 512, PP}; pg8::StaticOrder S; S.init(MTOK, DM, G, bx);

#if NAIVE_BR
                for (int w = gw; w < MTOK * 16; w += NGW) { const int m = w >> 4, c = 64 * (w & 15) + lane;
                    const float za = naive::dotcol(P + (size_t)m * PP + C_QA, ap->in[11] + (size_t)l * 512 * DM, 512, DM, c), zb = naive::dotcol(P + (size_t)m * PP + C_OB, ap->in[12] + (size_t)l * 256 * DM, 256, DM, c);
                    const float ga = naive::bf2f(P[(size_t)m * PP + C_GA + c]), gb = naive::bf2f(P[(size_t)m * PP + C_GB + c]);
                    XN[(size_t)m * DM + c] = naive::f2b(ga * za + gb * zb); }
#else
#ifndef NO_BR0
pg8::EpiBr<0> E{XN, P, C_GA}; pg8::gemm_phase<pg8::EpiBr<0>, pg8::StaticOrder, true, true, 512, PP>(tid, L, g, S, E);
#endif
#endif
 }
                { pg8::Gemm g{P + C_OB, (const bf16*)(ws + WS_WB) + (size_t)l * DM * 256, MTOK, DM, 256, PP}; pg8::StaticOrder S; S.init(MTOK, DM, G, bx);

#if NAIVE_BR

#else
#ifndef NO_BR1
pg8::EpiBr<1> E{XN, P, C_GB}; pg8::gemm_phase<pg8::EpiBr<1>, pg8::StaticOrder, true, true, 256, PP>(tid, L, g, S, E);
#endif
#endif
 }
            } else if (sub == 4) {
                pg8::Gemm g{XN, (const bf16*)(ws + WS_WO) + (size_t)l * DM * DM, MTOK, DM, DM, DM}; pg8::StaticOrder S; S.init(MTOK, DM, G, bx);
                pg8::EpiRes E{l == 0 ? x_in : out, out, ada_l + 2 * DM, XSB, GSV + (size_t)(DEPTH + l) * BATCH * DM, RSS};
#if NAIVE_OUT
                for (int w = gw; w < MTOK * 16; w += NGW) { const int m = w >> 4, c = 64 * (w & 15) + lane;
                    const float z = naive::dotcol(XN + (size_t)m * DM, ap->in[13] + (size_t)l * DM * DM, DM, DM, c);
                    out[(size_t)m * DM + c] = (l == 0 ? x_in : out)[(size_t)m * DM + c] + ada_l[(size_t)(m >> 12) * 6 * DM + 2 * DM + c] * z; }
#else
#ifndef NO_RES
pg8::gemm_phase<pg8::EpiRes, pg8::StaticOrder, true, true, DM, DM>(tid, L, g, S, E);
#endif
#endif

            } else if (sub == 6) {
                pg8::Gemm g{XSB, (const bf16*)(ws + WS_W1) + (size_t)l * FF * DM, MTOK, FF, DM, DM}; pg8::StaticOrder S; S.init(MTOK, FF, G, bx);
                pg8::EpiRelu2 E{HB, RSS, BIASF + (size_t)l * BATCH * FF};
#if NAIVE_F1
                for (int w = gw; w < MTOK * 64; w += NGW) { const int m = w >> 6, c = 64 * (w & 63) + lane;
                    const float z = fmaxf(naive::dotcol(XN + (size_t)m * DM, ap->in[14] + (size_t)l * DM * FF, DM, FF, c), 0.f);
                    HB[(size_t)m * FF + c] = naive::f2b(z * z); }
#else
#ifndef NO_F1
pg8::gemm_phase<pg8::EpiRelu2, pg8::StaticOrder, true, true, DM, DM>(tid, L, g, S, E);
#if DBG_GEMM2 & 4
pg8::gemm_phase<pg8::EpiRelu2, pg8::StaticOrder, true, true, DM, DM>(tid, L, g, S, E);
#endif
#endif
#endif

            } else {
                pg8::Gemm g{HB, (const bf16*)(ws + WS_W2) + (size_t)l * DM * FF, MTOK, DM, FF, FF}; pg8::StaticOrder S; S.init(MTOK, DM, G, bx);
                pg8::EpiRes E{out, out, ada_l + 5 * DM, (l + 1 < DEPTH) ? XN : (bf16*)nullptr, GSV + (size_t)((l + 1 < DEPTH) ? (l + 1) : 0) * BATCH * DM, RSS};
#if NAIVE_F2
                for (int w = gw; w < MTOK * 16; w += NGW) { const int m = w >> 4, c = 64 * (w & 15) + lane;
                    const float z = naive::dotcol(HB + (size_t)m * FF, ap->in[15] + (size_t)l * FF * DM, FF, DM, c);
                    out[(size_t)m * DM + c] = out[(size_t)m * DM + c] + ada_l[(size_t)(m >> 12) * 6 * DM + 5 * DM + c] * z; }
#else
#ifndef NO_RES
pg8::gemm_phase<pg8::EpiRes, pg8::StaticOrder, true, true, FF, FF>(tid, L, g, S, E);
#endif
#endif

            }
        }
}

__global__ void __launch_bounds__(NWAVES * 64, 2) mk_fwd(Args args) {
    extern __shared__ __attribute__((aligned(16))) unsigned char lds[];
    CArgs* ap0 = (CArgs*)__builtin_amdgcn_kernarg_segment_ptr();
    const int ph_lo = ap0->ph_lo, ph_hi = ap0->ph_hi;
    const int wave0 = __builtin_amdgcn_readfirstlane(threadIdx.x >> 6);
    volatile LAS unsigned* bst = (volatile LAS unsigned*)((LAS unsigned char*)lds + RING_BYTES + 64);
    if (threadIdx.x == 0) { bst[0] = 0u; bst[1] = 0u; }
    __syncthreads();
    unsigned* barw = (unsigned*)ap0->ws;
    const unsigned xbx = xcd_barrier_post(barw, bst, threadIdx.x == 0).x;
#define RUN(PH) if (ph_lo <= (PH) && (PH) < ph_hi) { run_phase<(PH)>(ap0, wave0, lds); if (DBG_P02 && (PH) <= 1) { __syncthreads(); run_phase<((PH) <= 1 ? (PH) : 0)>(ap0, wave0, lds); } if ((PH) + 1 < ph_hi) { if ((PH) == 0) cg::this_grid().sync(); else { int z_ = 0; asm volatile("" : "+v"(z_)); const bool ld_ = (wave0 == 0) && (__builtin_amdgcn_mbcnt_hi(~0u, __builtin_amdgcn_mbcnt_lo(~0u, z_)) == 0); XcdBarrier xb_; xb_.bar = barw; xb_.x = xbx; xb_.st = bst; for (int xs_ = 0; xs_ <= DBG_SYNCX; ++xs_) xcd_barrier(xb_, ld_); } } }
#define RUN8(B) RUN(B) RUN(B + 1) RUN(B + 2) RUN(B + 3) RUN(B + 4) RUN(B + 5) RUN(B + 6) RUN(B + 7)
    RUN(0) RUN(1) RUN8(2) RUN8(10) RUN8(18)
#undef RUN8
#undef RUN
}

extern "C" void kernel_launch(void* const* d_in, const int* in_sizes, int n_in, void* d_out, int out_size, void* d_ws, size_t ws_size, hipStream_t stream) {
    static int grid = 0;
    if (grid == 0) {
        if (n_in != 16 || out_size != MTOK * DM || ws_size < WS_END) { fprintf(stderr, "kernel_launch: unexpected shapes (n_in %d out %d ws %zu)\n", n_in, out_size, ws_size); grid = -1; return; }
        int dev = 0, cus = 0, per_cu = 0;
        if (hipGetDevice(&dev) != hipSuccess || hipDeviceGetAttribute(&cus, hipDeviceAttributeMultiprocessorCount, dev) != hipSuccess) { grid = -1; return; }
        if (hipFuncSetAttribute((const void*)mk_fwd, hipFuncAttributeMaxDynamicSharedMemorySize, LDS_BYTES) != hipSuccess) { fprintf(stderr, "kernel_launch: hipFuncSetAttribute failed\n"); grid = -1; return; }
        if (hipOccupancyMaxActiveBlocksPerMultiprocessor(&per_cu, (const void*)mk_fwd, NWAVES * 64, LDS_BYTES) != hipSuccess || per_cu < 1) per_cu = 1;
        (void)hipGetLastError();
        grid = cus * 1;
        fprintf(stderr, "kernel_launch: grid %d (occupancy query %d per CU)\n", grid, per_cu);
    }
    if (grid < 0) return;
    if (hipMemsetAsync(d_ws, 0, 16384, stream) != hipSuccess) { fprintf(stderr, "kernel_launch: memset failed\n"); return; }
    Args a{};
    for (int i = 0; i < 16; ++i) a.in[i] = (const float*)d_in[i];
    a.out = (float*)d_out; a.ws = (unsigned char*)d_ws;
#if MK_PER_PHASE
    for (int ph = 0; ph < NPHASE; ++ph) { a.ph_lo = ph; a.ph_hi = ph + 1; hipLaunchKernelGGL(mk_fwd, dim3(grid), dim3(NWAVES * 64), LDS_BYTES, stream, a); }
#else
    a.ph_lo = 0; a.ph_hi = NPHASE;
    void* kargs[] = {&a};
    hipError_t e = hipLaunchCooperativeKernel((void*)mk_fwd, dim3(grid), dim3(NWAVES * 64), kargs, LDS_BYTES, stream);
    if (e != hipSuccess) fprintf(stderr, "cooperative launch failed: %s (grid %d)\n", hipGetErrorString(e), grid);
#endif
}
```

```cpp
#include <hip/hip_runtime.h>
#include <hip/hip_bf16.h>
#include <hip/hip_cooperative_groups.h>
#include <cstdio>
#include <cstdint>
#include <cmath>
namespace cg = cooperative_groups;

#ifndef MK_PER_PHASE
#define MK_PER_PHASE 0
#endif

#ifndef NAIVE_ATT
#define NAIVE_ATT 0
#endif
#ifndef NAIVE_DIL
#define NAIVE_DIL 0
#endif

#ifndef NAIVE_GEMM
#define NAIVE_GEMM 0
#endif

#ifndef NAIVE_GIN
#define NAIVE_GIN NAIVE_GEMM
#endif
#ifndef NAIVE_BR
#define NAIVE_BR NAIVE_GEMM
#endif
#ifndef NAIVE_OUT
#define NAIVE_OUT NAIVE_GEMM
#endif
#ifndef NAIVE_F1
#define NAIVE_F1 NAIVE_GEMM
#endif
#ifndef NAIVE_F2
#define NAIVE_F2 NAIVE_GEMM
#endif

#ifndef TAB_DOUBLE
#define TAB_DOUBLE 1
#endif

#ifndef DBG_SKIP
#define DBG_SKIP 0u
#endif

#ifndef DBG_SYNCX
#define DBG_SYNCX 0
#endif
#ifndef DBG_DIL2
#define DBG_DIL2 0
#endif
#ifndef DBG_GEMM2
#define DBG_GEMM2 0
#endif

#ifndef DBG_P02
#define DBG_P02 0
#endif

#ifndef DBG_SPIN_SUB
#define DBG_SPIN_SUB (-1)
#endif

#ifndef DBG_SPIN_BAR
#define DBG_SPIN_BAR 0
#endif

#ifndef LOCAL_SEAMS
#define LOCAL_SEAMS 1
#endif

#ifndef DBG_CENSUS
#define DBG_CENSUS 0
#endif

constexpr int BATCH = 8, SEQ = 4096, DM = 1024, DEPTH = 4, FF = 4096, NIN = 5120;
constexpr int MTOK = BATCH * SEQ;
constexpr int PP = 5120;
constexpr int C_QA = 0, C_KA = 512, C_VA = 640, C_B0 = 768, C_GA = 3072, C_GB = 4096, C_OB = 768;
constexpr float QK_C2 = 0.125f * 1.4426950408889634f;
constexpr float EPS = 1e-6f;

namespace pg8 {
#define PG8_LAS __attribute__((address_space(3)))
typedef unsigned short bf16_t;
typedef short bf16x8 __attribute__((ext_vector_type(8)));
typedef float f32x4 __attribute__((ext_vector_type(4)));
typedef unsigned u32x4 __attribute__((ext_vector_type(4)));
constexpr int BM = 256, BK = 64, HALF = 128, HTB = HALF * BK * 2  , STAGE_BYTES = 8 * HTB, NXCD = 8, WGM = 8;

__host__ __device__ __forceinline__ int lds_byte(int r, int c) { const int st = (r >> 4) * 2 + (c >> 5), rr = r & 15, cc = c & 31, ob = rr * 64 + cc * 2; return st * 1024 + (ob ^ (((ob >> 9) & 1) << 5)); }
__host__ __device__ __forceinline__ void stage_rc(int b, int& R, int& C) { const int st = b / 1024, sb = b % 1024, swz = sb ^ (((sb >> 9) & 1) << 5); R = (st >> 1) * 16 + swz / 64; C = (st & 1) * 32 + (swz % 64) / 2; }
__host__ __device__ __forceinline__ int perm32(int rho) { const int n = rho >> 4, i = rho & 15; return 8 * (i >> 2) + 4 * n + (i & 3); }

struct Unit { int pm, pn; };
struct Gemm { const bf16_t* A; const bf16_t* Bt; int M, N, K, lda; };

struct StaticOrder {
    int nM, nN, nwg, G, c;
    __host__ __device__ void init(int M, int N, int G_, int c_) { nM = M / BM; nN = N / BM; nwg = nM * nN; G = G_; c = c_; }
    __host__ __device__ bool next(int i, Unit& u) const {
        const long L = (long)i * G + c; if (L >= nwg) return false;
        int wgid = (int)L; { const int q = nwg / NXCD, r = nwg % NXCD, xcd = wgid % NXCD, off = wgid / NXCD; wgid = (xcd < r ? xcd * (q + 1) : r * (q + 1) + (xcd - r) * q) + off; }
        const int nig = WGM * nN, gid = wgid / nig, fm = gid * WGM, gsz = (nM - fm) < WGM ? (nM - fm) : WGM;
        u.pm = fm + ((wgid % nig) % gsz); u.pn = (wgid % nig) / gsz; return true;
    }
    __device__ __forceinline__ void a_ready(const Unit&) const {}
    __device__ __forceinline__ void done(const Unit&) const {}
};

typedef float f32x2c __attribute__((ext_vector_type(2))); typedef __bf16 bf16x2c __attribute__((ext_vector_type(2)));
__device__ __forceinline__ unsigned cvt_pk_bf16(float lo, float hi) { const f32x2c v = {lo, hi}; const bf16x2c b = __builtin_convertvector(v, bf16x2c); return __builtin_bit_cast(unsigned, b); }
typedef float f32x2 __attribute__((ext_vector_type(2)));
typedef unsigned u32x2 __attribute__((ext_vector_type(2)));
__device__ __forceinline__ float bf_lo(unsigned w) { return __uint_as_float(w << 16); }
__device__ __forceinline__ float bf_hi(unsigned w) { return __uint_as_float(w & 0xffff0000u); }
__device__ __forceinline__ float sigm(float v) { return __builtin_amdgcn_rcpf(1.0f + __builtin_amdgcn_exp2f(-1.4426950408889634f * v)); }
__device__ __forceinline__ u32x4 pack8(const f32x4 a, const f32x4 b) { u32x4 w; w.x = cvt_pk_bf16(a[0], a[1]); w.y = cvt_pk_bf16(a[2], a[3]); w.z = cvt_pk_bf16(b[0], b[1]); w.w = cvt_pk_bf16(b[2], b[3]); return w; }

__device__ __forceinline__ float row_rstd(const float* rss, int row) {
    const f32x4* p = (const f32x4*)(rss + (size_t)row * 16); const f32x4 a = p[0], b = p[1], c = p[2], d = p[3];
    const float s = ((a[0] + a[1]) + (a[2] + a[3])) + ((b[0] + b[1]) + (b[2] + b[3])) + ((c[0] + c[1]) + (c[2] + c[3])) + ((d[0] + d[1]) + (d[2] + d[3]));
    return __builtin_amdgcn_rsqf(s * (1.0f / DM) + EPS);
}
__device__ __forceinline__ void rows_rstd(const float* rss, int row0, int fq, float (&rs)[2][4]) {
    f32x4 q[2][4];
#pragma unroll
    for (int ai = 0; ai < 2; ++ai)
#pragma unroll
        for (int m = 0; m < 4; ++m) q[ai][m] = *(const f32x4*)(rss + (size_t)(row0 + ai * HALF + m * 16) * 16 + 4 * fq);
#pragma unroll
    for (int ai = 0; ai < 2; ++ai)
#pragma unroll
        for (int m = 0; m < 4; ++m) { float s = (q[ai][m][0] + q[ai][m][1]) + (q[ai][m][2] + q[ai][m][3]); s += __shfl_xor(s, 16); s += __shfl_xor(s, 32);
            rs[ai][m] = __builtin_amdgcn_rsqf(s * (1.0f / DM) + EPS); }
}
struct EpiIn {
    static constexpr bool PERM = true, AFTER_DRAIN = false;
    bf16_t* P; const float* qna; const float* kna; const float* qnb; const float* knb; const float* tabA; const float* tabB; const float* rss; const float* bias;
    __device__ __forceinline__ void operator()(const f32x4 (&acc)[2][2][4][2], const Unit& u, int wr, int wc, int fr, int fq) const {
        const int pn = u.pn; const int row0 = u.pm * BM + wr * 64 + fr; const int bb = (u.pm * BM) / SEQ;
        if ((DBG_SKIP >> pn) & 1u) return;
        float rs[2][4]; rows_rstd(rss, row0, fq, rs);
        if (pn >= 12) {
            const int col0 = pn * 256 + wc * 32 + 8 * fq;
            f32x4 bv[2][2];
#pragma unroll
            for (int bj = 0; bj < 2; ++bj)
#pragma unroll
                for (int n = 0; n < 2; ++n) bv[bj][n] = *(const f32x4*)(bias + (size_t)bb * NIN + col0 + bj * HALF + 4 * n);
#pragma unroll
            for (int ai = 0; ai < 2; ++ai)
#pragma unroll
                for (int m = 0; m < 4; ++m) { const int row = row0 + ai * HALF + m * 16; bf16_t* rowp = P + (size_t)row * PP + col0; const float rstd = rs[ai][m];
#pragma unroll
                    for (int bj = 0; bj < 2; ++bj) { f32x4 v0 = acc[ai][bj][m][0] * rstd + bv[bj][0], v1 = acc[ai][bj][m][1] * rstd + bv[bj][1];
#pragma unroll
                        for (int j = 0; j < 4; ++j) { v0[j] = sigm(v0[j]); v1[j] = sigm(v1[j]); }
                        *(u32x4*)(rowp + bj * HALF) = pack8(v0, v1); } }
            return;
        }
        int mode, colbase; const float* gn = qna; float scale = 1.f;
        if (pn <= 1) { mode = 0; colbase = (4 * pn + wc) * 64; gn = qna; scale = QK_C2; }
        else if (pn == 2) { colbase = 512 + 64 * wc; if (wc < 2) { mode = 0; gn = kna; } else mode = 2; }
        else { const int g = (pn - 3) / 3, kind = (pn - 3) - 3 * g; colbase = 256 * pn + 64 * wc;
               if (kind == 2) mode = 2; else { mode = 1; gn = (kind == 0 ? qnb : knb) + 64 * g; scale = (kind == 0) ? QK_C2 : 1.f; } }
        const int d0 = (mode == 0) ? (32 * (fq >> 1) + 8 * (fq & 1)) : 8 * fq; const int bjs = (mode == 0) ? 16 : 32;
        f32x4 bz[2][2];
#pragma unroll
        for (int bj = 0; bj < 2; ++bj)
#pragma unroll
            for (int n = 0; n < 2; ++n) bz[bj][n] = *(const f32x4*)(bias + (size_t)bb * NIN + colbase + d0 + bj * bjs + 4 * n);
        if (mode == 2) {
#pragma unroll
            for (int ai = 0; ai < 2; ++ai)
#pragma unroll
                for (int m = 0; m < 4; ++m) { const int row = row0 + ai * HALF + m * 16; bf16_t* rowp = P + (size_t)row * PP + colbase + d0; const float rstd = rs[ai][m];
#pragma unroll
                    for (int bj = 0; bj < 2; ++bj) *(u32x4*)(rowp + bj * bjs) = pack8(acc[ai][bj][m][0] * rstd + bz[bj][0], acc[ai][bj][m][1] * rstd + bz[bj][1]); }
            return;
        }
        f32x4 gw[2][2];
#pragma unroll
        for (int bj = 0; bj < 2; ++bj)
#pragma unroll
            for (int n = 0; n < 2; ++n) gw[bj][n] = *(const f32x4*)(gn + d0 + bj * bjs + 4 * n);
#pragma unroll
        for (int ai = 0; ai < 2; ++ai)
#pragma unroll
            for (int m = 0; m < 4; ++m) {
                const int row = row0 + ai * HALF + m * 16, t = row & (SEQ - 1);
                const float rs0 = rs[ai][m];
                f32x4 zz[2][2];
#pragma unroll
                for (int bj = 0; bj < 2; ++bj)
#pragma unroll
                    for (int n = 0; n < 2; ++n) zz[bj][n] = acc[ai][bj][m][n] * rs0 + bz[bj][n];
                float ss = 0.f;
#pragma unroll
                for (int bj = 0; bj < 2; ++bj)
#pragma unroll
                    for (int n = 0; n < 2; ++n) { const f32x4 x = zz[bj][n]; ss += (x[0] * x[0] + x[1] * x[1]) + (x[2] * x[2] + x[3] * x[3]); }
                ss += __shfl_xor(ss, 16); ss += __shfl_xor(ss, 32);
                const float rstd = __builtin_amdgcn_rsqf(ss * (1.0f / 64.0f) + EPS) ;
                const float* tb = (mode == 0) ? tabA + ((((fq >> 1) ? (t & 63) : (t >> 6)) * 16 + 8 * (fq & 1)) * 2) : tabB + ((t * 32 + 8 * fq) * 2);
                f32x4 cs[4];
#pragma unroll
                for (int i = 0; i < 4; ++i) cs[i] = *(const f32x4*)(tb + 4 * i);
                f32x4 o1[2], o2[2];
#pragma unroll
                for (int n = 0; n < 2; ++n) { const f32x4 y0 = zz[0][n] * rstd * gw[0][n], y1 = zz[1][n] * rstd * gw[1][n];
#pragma unroll
                    for (int j = 0; j < 4; ++j) { const float c = cs[2 * n + (j >> 1)][(j & 1) * 2], s = cs[2 * n + (j >> 1)][(j & 1) * 2 + 1];
                        o1[n][j] = (y0[j] * c - y1[j] * s) * scale; o2[n][j] = (y1[j] * c + y0[j] * s) * scale; } }
                bf16_t* rowp = P + (size_t)row * PP + colbase + d0;
                *(u32x4*)(rowp) = pack8(o1[0], o1[1]); *(u32x4*)(rowp + bjs) = pack8(o2[0], o2[1]);
                if (m & 1) asm volatile("" ::: "memory");
            }
    }
};
template <int PASS> struct EpiBr {
    static constexpr bool PERM = true, AFTER_DRAIN = false;
    bf16_t* MX; const bf16_t* P; int gcol;
    __device__ __forceinline__ void operator()(const f32x4 (&acc)[2][2][4][2], const Unit& u, int wr, int wc, int fr, int fq) const {
        const int row0 = u.pm * BM + wr * 64 + fr, col0 = u.pn * 256 + wc * 32 + 8 * fq;
#pragma unroll
        for (int ai = 0; ai < 2; ++ai)
#pragma unroll
            for (int m = 0; m < 4; ++m) { const size_t row = (size_t)(row0 + ai * HALF + m * 16);
#pragma unroll
                for (int bj = 0; bj < 2; ++bj) { const int c = col0 + bj * HALF;
                    const u32x4 gv = *(const u32x4*)(P + row * PP + gcol + c);
                    f32x4 v0 = acc[ai][bj][m][0], v1 = acc[ai][bj][m][1];
                    v0[0] *= bf_lo(gv.x); v0[1] *= bf_hi(gv.x); v0[2] *= bf_lo(gv.y); v0[3] *= bf_hi(gv.y);
                    v1[0] *= bf_lo(gv.z); v1[1] *= bf_hi(gv.z); v1[2] *= bf_lo(gv.w); v1[3] *= bf_hi(gv.w);
                    if (PASS == 1) { const u32x4 pv = *(const u32x4*)(MX + row * DM + c);
                        v0[0] += bf_lo(pv.x); v0[1] += bf_hi(pv.x); v0[2] += bf_lo(pv.y); v0[3] += bf_hi(pv.y);
                        v1[0] += bf_lo(pv.z); v1[1] += bf_hi(pv.z); v1[2] += bf_lo(pv.w); v1[3] += bf_hi(pv.w); }
                    *(u32x4*)(MX + row * DM + c) = pack8(v0, v1); }
                if (m & 1) asm volatile("" ::: "memory"); }
    }
};
struct EpiRes {
    static constexpr bool PERM = false, AFTER_DRAIN = false;
    const float* base; float* out; const float* gt;
    bf16_t* XS; const float* gs; float* rss; int xpitch;
    __device__ __forceinline__ void operator()(const f32x4 (&acc)[2][2][4][2], const Unit& u, int wr, int wc, int fr, int fq) const {
        const int row0 = u.pm * BM + wr * 64 + fr, col0 = u.pn * 256 + wc * 32 + 4 * fq; const int b = (u.pm * BM) / SEQ;
        f32x4 gv[2][2], gsv[2][2];
#pragma unroll
        for (int bj = 0; bj < 2; ++bj)
#pragma unroll
            for (int n = 0; n < 2; ++n) { gv[bj][n] = *(const f32x4*)(gt + (size_t)b * 6 * DM + col0 + bj * HALF + n * 16);
                gsv[bj][n] = XS ? *(const f32x4*)(gs + (size_t)b * DM + col0 + bj * HALF + n * 16) : (f32x4){0.f, 0.f, 0.f, 0.f}; }
#pragma unroll
        for (int ai = 0; ai < 2; ++ai)
#pragma unroll
            for (int m = 0; m < 4; ++m) { const int row = row0 + ai * HALF + m * 16; const size_t off = (size_t)row * DM + col0; float ss = 0.f;
#pragma unroll
                for (int bj = 0; bj < 2; ++bj)
#pragma unroll
                    for (int n = 0; n < 2; ++n) { const f32x4 bs = *(const f32x4*)(base + off + bj * HALF + n * 16);
                        const f32x4 o = bs + gv[bj][n] * acc[ai][bj][m][n];
                        *(f32x4*)(out + off + bj * HALF + n * 16) = o;
                        if (XS) { ss += (o[0] * o[0] + o[1] * o[1]) + (o[2] * o[2] + o[3] * o[3]); const f32x4 xs = o * gsv[bj][n];
                            u32x2 w; w.x = cvt_pk_bf16(xs[0], xs[1]); w.y = cvt_pk_bf16(xs[2], xs[3]); *(u32x2*)(XS + (size_t)row * xpitch + col0 + bj * HALF + n * 16) = w; } }
                if (XS) { ss += __shfl_xor(ss, 16); ss += __shfl_xor(ss, 32); if (fq == 0) rss[(size_t)row * 16 + u.pn * 4 + wc] = ss; }
                if (m & 1) asm volatile("" ::: "memory"); }
    }
};
struct EpiRelu2 {
    static constexpr bool PERM = true, AFTER_DRAIN = false;
    bf16_t* H; const float* rss; const float* bias;
    __device__ __forceinline__ void operator()(const f32x4 (&acc)[2][2][4][2], const Unit& u, int wr, int wc, int fr, int fq) const {
        const int row0 = u.pm * BM + wr * 64 + fr, col0 = u.pn * 256 + wc * 32 + 8 * fq; const int b = (u.pm * BM) / SEQ;
        float rs[2][4]; rows_rstd(rss, row0, fq, rs);
        f32x4 bv[2][2];
#pragma unroll
        for (int bj = 0; bj < 2; ++bj)
#pragma unroll
            for (int n = 0; n < 2; ++n) bv[bj][n] = *(const f32x4*)(bias + (size_t)b * FF + col0 + bj * HALF + 4 * n);
#pragma unroll
        for (int ai = 0; ai < 2; ++ai)
#pragma unroll
            for (int m = 0; m < 4; ++m) { const int row = row0 + ai * HALF + m * 16; bf16_t* rowp = H + (size_t)row * PP + col0; const float rstd = rs[ai][m];
#pragma unroll
                for (int bj = 0; bj < 2; ++bj) { f32x4 v0 = acc[ai][bj][m][0] * rstd + bv[bj][0], v1 = acc[ai][bj][m][1] * rstd + bv[bj][1];
#pragma unroll
                    for (int j = 0; j < 4; ++j) { const float a = fmaxf(v0[j], 0.f), b = fmaxf(v1[j], 0.f); v0[j] = a * a; v1[j] = b * b; }
                    *(u32x4*)(rowp + bj * HALF) = pack8(v0, v1); } }
    }
};

template <class Epi, class Sched, bool ALIGN_EPI, bool SP2, int KC, int LDA>
__device__ __forceinline__ void gemm_phase(const int tid, PG8_LAS unsigned char* lds, const Gemm g, const Sched& S, const Epi& E) {
    const int wid = __builtin_amdgcn_readfirstlane(tid >> 6), lane = tid & 63, wr = wid >> 2, wc = wid & 3, fr = lane & 15, fq = lane >> 4;
    constexpr int K = KC, nt = K / BK;
    unsigned voffA[2], voffB[2];
#pragma unroll
    for (int i = 0; i < 2; ++i) { int R, C; stage_rc(tid * 16 + i * 8192, R, C); const int Rb = Epi::PERM ? ((R & ~31) + perm32(R & 31)) : R;
        voffA[i] = (unsigned)(R * LDA + C) * 2u; voffB[i] = (unsigned)(Rb * K + C) * 2u; }
    constexpr size_t kstep = (size_t)(BK * 2);
    constexpr size_t hstep = (size_t)HALF * K * 2, hstepA = (size_t)HALF * LDA * 2;
    constexpr size_t tstep = 2 * hstep, tstepA = 2 * hstepA;
    const unsigned ldsw = (unsigned)wid * 1024u;
    const int aoff = lds_byte(wr * 64 + fr, fq * 8), boff = lds_byte(wc * 32 + fr, fq * 8);
#define PG8_SA(b, h) (((b) * 2 + (h)) * HTB)
#define PG8_SB(b, h) ((4 + (b) * 2 + (h)) * HTB)
#define PG8_STAGE(bufoff, gbase, voff) do { _Pragma("unroll") for (int _i = 0; _i < 2; ++_i) \
        __builtin_amdgcn_global_load_lds((const unsigned*)((const char*)(gbase) + (voff)[_i]), (PG8_LAS unsigned*)(lds + (bufoff) + ldsw + _i * 8192), 16, 0, 0); } while (0)
#define PG8_LDA(dst, b, h) do { _Pragma("unroll") for (int m = 0; m < 4; ++m) _Pragma("unroll") for (int k = 0; k < 2; ++k) dst[m][k] = *(const PG8_LAS bf16x8*)(lds + PG8_SA(b, h) + aoff + m * 2048 + k * 1024); } while (0)
#define PG8_LDB(dst, b, h) do { _Pragma("unroll") for (int n = 0; n < 2; ++n) _Pragma("unroll") for (int k = 0; k < 2; ++k) dst[n][k] = *(const PG8_LAS bf16x8*)(lds + PG8_SB(b, h) + boff + n * 2048 + k * 1024); } while (0)
#define PG8_MMA(ai, bj, At, Bt) do { __builtin_amdgcn_s_setprio(1); _Pragma("unroll") for (int m = 0; m < 4; ++m) _Pragma("unroll") for (int n = 0; n < 2; ++n) _Pragma("unroll") for (int k = 0; k < 2; ++k) \
        acc[ai][bj][m][n] = __builtin_amdgcn_mfma_f32_16x16x32_bf16(Bt[n][k], At[m][k], acc[ai][bj][m][n], 0, 0, 0); __builtin_amdgcn_s_setprio(0); } while (0)
#define PG8_WAIT_V(n) asm volatile("s_waitcnt vmcnt(" #n ")" ::: "memory")
#define PG8_WAIT_L(n) asm volatile("s_waitcnt lgkmcnt(" #n ")" ::: "memory")
#define PG8_BAR __builtin_amdgcn_s_barrier()
#define PG8_SCHED __builtin_amdgcn_sched_barrier(0)
    Unit cur, nxt; int ui = 0;
    if (!S.next(0, cur)) return;
    f32x4 acc[2][2][4][2];
#pragma unroll
    for (int a = 0; a < 2; ++a)
#pragma unroll
        for (int b = 0; b < 2; ++b)
#pragma unroll
            for (int m = 0; m < 4; ++m)
#pragma unroll
                for (int n = 0; n < 2; ++n) acc[a][b][m][n] = (f32x4){0.f, 0.f, 0.f, 0.f};
    bf16x8 At[4][2], B0[2][2], B1[2][2];
    const char* cA = (const char*)g.A + (size_t)cur.pm * tstepA; const char* cB = (const char*)g.Bt + (size_t)cur.pn * tstep;
    S.a_ready(cur);
    if constexpr (SP2) {
        PG8_STAGE(PG8_SB(0, 0), cB, voffB); PG8_STAGE(PG8_SB(0, 1), cB + hstep, voffB); PG8_STAGE(PG8_SA(0, 0), cA, voffA); PG8_STAGE(PG8_SA(0, 1), cA + hstepA, voffA);
        if (wr == 1) PG8_BAR;
        PG8_WAIT_V(2); PG8_BAR;
        PG8_STAGE(PG8_SB(1, 0), cB + kstep, voffB); PG8_STAGE(PG8_SA(1, 0), cA + kstep, voffA); PG8_STAGE(PG8_SB(1, 1), cB + hstep + kstep, voffB);
        PG8_WAIT_V(6); PG8_BAR;
    } else {
        PG8_STAGE(PG8_SB(0, 0), cB, voffB); PG8_STAGE(PG8_SA(0, 0), cA, voffA); PG8_STAGE(PG8_SB(0, 1), cB + hstep, voffB); PG8_STAGE(PG8_SA(0, 1), cA + hstepA, voffA);
        if (wr == 1) PG8_BAR;
        PG8_WAIT_V(4); PG8_BAR;
        PG8_STAGE(PG8_SB(1, 0), cB + kstep, voffB); PG8_STAGE(PG8_SA(1, 0), cA + kstep, voffA); PG8_STAGE(PG8_SB(1, 1), cB + hstep + kstep, voffB);
        PG8_WAIT_V(6); PG8_BAR;
    }
    for (;;) {
        const bool has_next = S.next(ui + 1, nxt);
        const char* nA = has_next ? (const char*)g.A + (size_t)nxt.pm * tstepA : cA; const char* nB = has_next ? (const char*)g.Bt + (size_t)nxt.pn * tstep : cB;
#pragma unroll 1
        for (int t = 0; t < nt; t += 2) {
            const bool last = (t == nt - 2);
            const char* a1 = cA + (size_t)(t + 1) * kstep;
            const char* a2 = last ? nA : cA + (size_t)(t + 2) * kstep; const char* b2 = last ? nB : cB + (size_t)(t + 2) * kstep;
            const char* a3 = a2 + kstep; const char* b3 = b2 + kstep;
            if (last && has_next) S.a_ready(nxt);
            if constexpr (SP2) {
            PG8_LDB(B0, 0, 0); PG8_LDB(B1, 0, 1); PG8_SCHED; PG8_LDA(At, 0, 0); PG8_STAGE(PG8_SA(1, 1), a1 + hstepA, voffA);
            PG8_WAIT_V(8); PG8_WAIT_L(0); PG8_BAR; PG8_MMA(0, 0, At, B0); PG8_MMA(0, 1, At, B1); PG8_BAR; PG8_SCHED;
            PG8_LDA(At, 0, 1); PG8_STAGE(PG8_SB(0, 0), b2, voffB); PG8_STAGE(PG8_SB(0, 1), b2 + hstep, voffB); PG8_STAGE(PG8_SA(0, 0), a2, voffA);
            PG8_WAIT_V(8); PG8_WAIT_L(0); PG8_BAR; PG8_MMA(1, 0, At, B0); PG8_MMA(1, 1, At, B1); PG8_BAR; PG8_SCHED;
            PG8_LDB(B0, 1, 0); PG8_LDB(B1, 1, 1); PG8_SCHED; PG8_LDA(At, 1, 0); PG8_STAGE(PG8_SA(0, 1), a2 + hstepA, voffA);
            PG8_WAIT_V(8); PG8_WAIT_L(0); PG8_BAR; PG8_MMA(0, 0, At, B0); PG8_MMA(0, 1, At, B1); PG8_BAR; PG8_SCHED;
            PG8_LDA(At, 1, 1); PG8_STAGE(PG8_SB(1, 0), b3, voffB); PG8_STAGE(PG8_SB(1, 1), b3 + hstep, voffB); PG8_STAGE(PG8_SA(1, 0), a3, voffA);
            PG8_WAIT_V(8); PG8_WAIT_L(0); PG8_BAR; PG8_MMA(1, 0, At, B0); PG8_MMA(1, 1, At, B1); PG8_BAR; PG8_SCHED;
            } else {
            PG8_LDB(B0, 0, 0); PG8_SCHED; PG8_LDA(At, 0, 0); PG8_STAGE(PG8_SA(1, 1), a1 + hstepA, voffA);
            PG8_WAIT_L(8); PG8_BAR; PG8_WAIT_L(0); PG8_MMA(0, 0, At, B0); PG8_BAR; PG8_SCHED;
            PG8_LDB(B1, 0, 1); PG8_STAGE(PG8_SB(0, 0), b2, voffB);
            PG8_BAR; PG8_WAIT_L(0); PG8_MMA(0, 1, At, B1); PG8_BAR;
            PG8_LDA(At, 0, 1); PG8_STAGE(PG8_SA(0, 0), a2, voffA);
            PG8_BAR; PG8_WAIT_L(0); PG8_MMA(1, 0, At, B0); PG8_BAR; PG8_SCHED;
            PG8_STAGE(PG8_SB(0, 1), b2 + hstep, voffB);
            PG8_WAIT_V(6); PG8_BAR; PG8_MMA(1, 1, At, B1); PG8_BAR;
            PG8_LDB(B0, 1, 0); PG8_SCHED; PG8_LDA(At, 1, 0); PG8_STAGE(PG8_SA(0, 1), a2 + hstepA, voffA);
            PG8_WAIT_L(8); PG8_BAR; PG8_WAIT_L(0); PG8_MMA(0, 0, At, B0); PG8_BAR; PG8_SCHED;
            PG8_LDB(B1, 1, 1); PG8_STAGE(PG8_SB(1, 0), b3, voffB);
            PG8_BAR; PG8_WAIT_L(0); PG8_MMA(0, 1, At, B1); PG8_BAR;
            PG8_LDA(At, 1, 1); PG8_STAGE(PG8_SA(1, 0), a3, voffA);
            PG8_BAR; PG8_WAIT_L(0); PG8_MMA(1, 0, At, B0); PG8_BAR; PG8_SCHED;
            PG8_STAGE(PG8_SB(1, 1), b3 + hstep, voffB);
            PG8_WAIT_V(6); PG8_BAR; PG8_MMA(1, 1, At, B1); PG8_BAR;
            }
        }
        if constexpr (ALIGN_EPI) { if (wr == 0) PG8_BAR; }
        if constexpr (!Epi::AFTER_DRAIN) { E(acc, cur, wr, wc, fr, fq); S.done(cur); }
        if (!has_next) break;
#pragma unroll
        for (int a = 0; a < 2; ++a)
#pragma unroll
            for (int b = 0; b < 2; ++b)
#pragma unroll
                for (int m = 0; m < 4; ++m)
#pragma unroll
                    for (int n = 0; n < 2; ++n) acc[a][b][m][n] = (f32x4){0.f, 0.f, 0.f, 0.f};
        cur = nxt; cA = nA; cB = nB; ++ui;
        if constexpr (ALIGN_EPI) { if (wr == 1) PG8_BAR; }
    }
    PG8_WAIT_V(0);
    if constexpr (!ALIGN_EPI) { if (wr == 0) PG8_BAR; }
    PG8_BAR;
    if constexpr (Epi::AFTER_DRAIN) { E.fused(acc, cur, wr, wc, fr, fq, lds, wid, lane); S.done(cur); }
#undef PG8_SA
#undef PG8_SB
#undef PG8_STAGE
#undef PG8_LDA
#undef PG8_LDB
#undef PG8_MMA
#undef PG8_WAIT_V
#undef PG8_WAIT_L
#undef PG8_BAR
#undef PG8_SCHED
}
}
namespace attn_body {
using bf16=__hip_bfloat16;
using bf16x8=__attribute__((ext_vector_type(8)))short;
using s16x4=__attribute__((ext_vector_type(4)))short;
using f32x16=__attribute__((ext_vector_type(16)))float;
using u32x4=__attribute__((ext_vector_type(4)))unsigned;
constexpr int BATCH=8,NHEAD=8,SEQ=4096,D=64,DM=5120;
constexpr int NW=8,QBLK=32,QB=QBLK*NW,KVBLK=64,NQB=SEQ/QB;
constexpr int ATTN_PITCH=DM, ATTN_UNIT_ROWS=QB;
__device__ __forceinline__ int crow(int r,int hi){return (r&3)+8*(r>>2)+4*hi;}
#define SBAR() __builtin_amdgcn_sched_barrier(0)
__device__ __forceinline__ void cmask(f32x16&p0,f32x16&p1,int jb,int qrel,int hi){
  const float NEG=-INFINITY; int kb=64*jb+4*hi;
  #pragma unroll
  for(int r=0;r<16;++r){int kv=kb+(r&3)+8*(r>>2); if(kv>qrel)p0[r]=NEG; if(kv+32>qrel)p1[r]=NEG;}
}

constexpr int NSLOT=3, SLOTB=8192;
constexpr int LDS_K=0, LDS_V=NSLOT*SLOTB, LDS_WS=2*NSLOT*SLOTB, LDS_OST=LDS_WS+NW*64*4, LDS_BYTES=LDS_OST+NW*4096;
constexpr float C2=0.125f*1.4426950408889634f;
__device__ __forceinline__ void glds16(const void*gsrc,unsigned lds_dst){unsigned keep;
  asm volatile("s_mov_b32 %0, m0\n\ts_mov_b32 m0, %2\n\ts_nop 0\n\tglobal_load_lds_dwordx4 %1, off\n\ts_mov_b32 m0, %0":"=&s"(keep):"v"(gsrc),"s"(lds_dst):"memory");}
__device__ __forceinline__ float max3f(float a,float b,float c){float r;asm("v_max3_f32 %0, %1, %2, %3":"=v"(r):"v"(a),"v"(b),"v"(c));return r;}
__device__ __forceinline__ float max2f(float a,float b){float r;asm("v_max_f32_e32 %0, %1, %2":"=v"(r):"v"(a),"v"(b));return r;}
__device__ __forceinline__ float fadd_s(float a,float b){float r;asm("v_add_f32_e32 %0, %1, %2":"=v"(r):"v"(a),"v"(b));return r;}
__device__ __forceinline__ float fsub_s(float a,float b){float r;asm("v_sub_f32_e32 %0, %1, %2":"=v"(r):"v"(a),"v"(b));return r;}
typedef float f32x2_t __attribute__((ext_vector_type(2))); typedef __bf16 bf16x2_t __attribute__((ext_vector_type(2)));
__device__ __forceinline__ unsigned cvtpk_s(float lo,float hi){f32x2_t v={lo,hi};bf16x2_t b=__builtin_convertvector(v,bf16x2_t);return __builtin_bit_cast(unsigned,b);}
#define WAIT_BAR(N) asm volatile("s_waitcnt vmcnt(" #N ") lgkmcnt(0)\n\ts_barrier":::"memory")

__device__ __forceinline__ void qkt(f32x16&p0,f32x16&p1,const char*Kslot,const bf16x8*qr,const f32x16&negm,int r32,int hi){
  const char*kb=Kslot+hi*1024+r32*16;
  #pragma unroll
  for(int d0=0;d0<4;++d0){
    const bf16x8 b0=*reinterpret_cast<const bf16x8*>(kb+d0*2048);
    const bf16x8 b1=*reinterpret_cast<const bf16x8*>(kb+d0*2048+512);
    if(d0==0){p0=__builtin_amdgcn_mfma_f32_32x32x16_bf16(b0,qr[0],negm,0,0,0);p1=__builtin_amdgcn_mfma_f32_32x32x16_bf16(b1,qr[0],negm,0,0,0);}
    else{p0=__builtin_amdgcn_mfma_f32_32x32x16_bf16(b0,qr[d0],p0,0,0,0);p1=__builtin_amdgcn_mfma_f32_32x32x16_bf16(b1,qr[d0],p1,0,0,0);}}
}
typedef __attribute__((address_space(3))) const char* lds_cptr;
typedef short v4i16_t __attribute__((ext_vector_type(4)));
__device__ __forceinline__ void kload8(bf16x8*kf,lds_cptr kp){
  kf[0]=*(const __attribute__((address_space(3))) bf16x8*)(kp);      kf[1]=*(const __attribute__((address_space(3))) bf16x8*)(kp+512);
  kf[2]=*(const __attribute__((address_space(3))) bf16x8*)(kp+2048); kf[3]=*(const __attribute__((address_space(3))) bf16x8*)(kp+2560);
  kf[4]=*(const __attribute__((address_space(3))) bf16x8*)(kp+4096); kf[5]=*(const __attribute__((address_space(3))) bf16x8*)(kp+4608);
  kf[6]=*(const __attribute__((address_space(3))) bf16x8*)(kp+6144); kf[7]=*(const __attribute__((address_space(3))) bf16x8*)(kp+6656);
}
__device__ __forceinline__ void kload2(bf16x8*kf,lds_cptr kp,int j){ kf[2*j]=*(const __attribute__((address_space(3))) bf16x8*)(kp+j*2048); kf[2*j+1]=*(const __attribute__((address_space(3))) bf16x8*)(kp+j*2048+512); }
__device__ __forceinline__ s16x4 vtr(lds_cptr p){ return __builtin_bit_cast(s16x4,__builtin_amdgcn_ds_read_tr16_b64_v4i16((__attribute__((address_space(3))) v4i16_t*)p)); }
__device__ __forceinline__ float rowmax(const f32x16&p0,const f32x16&p1){
  float a=max3f(p0[0],p0[1],p1[0]),b=max3f(p0[2],p0[3],p1[1]);a=max3f(a,p1[2],p1[3]);
  #pragma unroll
  for(int r=4;r<16;r+=4){a=max3f(a,p0[r],p0[r+1]);b=max3f(b,p0[r+2],p0[r+3]);a=max3f(a,p1[r],p1[r+1]);b=max3f(b,p1[r+2],p1[r+3]);}
  const float m=max2f(a,b);
  auto rr=__builtin_amdgcn_permlane32_swap(__float_as_uint(m),__float_as_uint(m),false,false);
  return max2f(__uint_as_float(rr[0]),__uint_as_float(rr[1]));
}
__device__ __forceinline__ void pv(f32x16*o,int vb,bf16x8 pa0,bf16x8 pa1,bf16x8 pa2,bf16x8 pa3){
  #pragma unroll
  for(int d0=0;d0<2;++d0){s16x4 lo[4],hi[4];
    #pragma unroll
    for(int ks=0;ks<4;++ks){
      asm volatile("ds_read_b64_tr_b16 %0,%1 offset:%c2":"=&v"(lo[ks]):"v"(vb),"i"(d0*4096+ks*1024):"memory");
      asm volatile("ds_read_b64_tr_b16 %0,%1 offset:%c2":"=&v"(hi[ks]):"v"(vb),"i"(d0*4096+ks*1024+512):"memory");}
    asm volatile("s_waitcnt lgkmcnt(0)":::"memory");SBAR();
    #define PK(k) (bf16x8){lo[k][0],lo[k][1],lo[k][2],lo[k][3],hi[k][0],hi[k][1],hi[k][2],hi[k][3]}
    o[d0]=__builtin_amdgcn_mfma_f32_32x32x16_bf16(pa0,PK(0),o[d0],0,0,0);
    o[d0]=__builtin_amdgcn_mfma_f32_32x32x16_bf16(pa1,PK(1),o[d0],0,0,0);
    o[d0]=__builtin_amdgcn_mfma_f32_32x32x16_bf16(pa2,PK(2),o[d0],0,0,0);
    o[d0]=__builtin_amdgcn_mfma_f32_32x32x16_bf16(pa3,PK(3),o[d0],0,0,0);
    #undef PK
  }
}

#ifndef ATTN_STORE16
#define ATTN_STORE16(p,v) (*(u32x4*)(p)=(v))
#endif
template<int THRL> __device__ __forceinline__ void attn_unit(int b,int h,int qb,const bf16*Q,const bf16*__restrict__ K,const bf16*__restrict__ V,bf16*O,char*shm,const int tid){
  const int lane=tid&63,r32=lane&31,hi=lane>>5; const int wid=__builtin_amdgcn_readfirstlane(tid>>6);
  const long rowbase=(long)b*SEQ; const int q0=qb*QB;
  const bf16*Qw=Q+(rowbase+q0+wid*QBLK)*DM+h*D;
  const bf16*Kh=K+rowbase*DM+(h>>2)*D,*Vh=V+rowbase*DM+(h>>2)*D;
  const unsigned lds0=(unsigned)(uintptr_t)shm;
  float*wsf=(float*)(shm+LDS_WS)+wid*64;
  const bf16*ksrc=Kh+(long)lane*DM+wid*8;
  const bf16*vsrc=Vh+(long)(16*(wid&3)+(lane>>2))*DM+(wid>>2)*32+(lane&3)*8;
  const unsigned kdst=lds0+LDS_K+wid*1024, vdst=lds0+LDS_V+wid*1024;
  #define DMA_K(t,slot) glds16(ksrc+(long)(t)*KVBLK*DM,(unsigned)__builtin_amdgcn_readfirstlane(kdst+(slot)))
  #define DMA_V(t,slot) glds16(vsrc+(long)(t)*KVBLK*DM,(unsigned)__builtin_amdgcn_readfirstlane(vdst+(slot)))
  const int vb0=(int)(lds0+LDS_V)+((lane>>4)&1)*32+(lane&3)*8+(4*hi+((lane&15)>>2))*64;
  const char*Kbase=shm+LDS_K; bf16x8 kf[8];
  const lds_cptr shm3=(lds_cptr)shm; const lds_cptr kp0=shm3+LDS_K+hi*1024+r32*16; const lds_cptr vp0=shm3+LDS_V+((lane>>4)&1)*32+(lane&3)*8+(4*hi+((lane&15)>>2))*64;
  const int NT=SEQ/KVBLK;
  DMA_K(0,0);DMA_V(0,0);DMA_K(1,SLOTB);
  bf16x8 qr[4];
  #pragma unroll
  for(int d0=0;d0<4;++d0)qr[d0]=*reinterpret_cast<const bf16x8*>(&Qw[(long)r32*DM+d0*16+hi*8]);
  float mhat=0.f,l_reg=0.f;f32x16 o[2];o[0]=f32x16{};o[1]=f32x16{};f32x16 negm=f32x16{};asm volatile("":"+v"(negm));
  const int qrel=wid*QBLK+r32;
  #define CMASK(P0,P1,t) do{}while(0)
  bool resc=false;
  #define START(P0,P1) do{ const float rm=rowmax(P0,P1); resc=false; \
    { const float dl=rm; mhat=fadd_s(mhat,dl); \
      _Pragma("unroll") for(int r=0;r<16;++r){P0[r]=fsub_s(P0[r],dl);P1[r]=fsub_s(P1[r],dl);} \
      _Pragma("unroll") for(int r=0;r<16;++r)negm[r]=-mhat; asm volatile("":"+v"(negm)); } \
    _Pragma("unroll") for(int r=0;r<16;++r)P0[r]=__builtin_amdgcn_exp2f(P0[r]); }while(0)
  #define RESC() do{ if(resc){ asm volatile("s_waitcnt lgkmcnt(0)":::"memory"); \
      _Pragma("unroll") for(int d_=0;d_<2;++d_) _Pragma("unroll") for(int r=0;r<16;++r)o[d_][r]*=wsf[crow(r,hi)]; } }while(0)
  f32x16 pA0,pA1,pB0,pB1;
  int sl_prev=0,sl_cur=0,sl_next=SLOTB;
  #define ROT() do{sl_prev=sl_cur;sl_cur=sl_next;sl_next=(sl_next==(NSLOT-1)*SLOTB)?0:sl_next+SLOTB;}while(0)
  DMA_K(2,2*SLOTB);
  WAIT_BAR(3);
  qkt(pA0,pA1,Kbase,qr,negm,r32,hi);asm volatile("s_nop 15\n\ts_nop 7":"+v"(pA0),"+v"(pA1));CMASK(pA0,pA1,0);
  START(pA0,pA1);
  _Pragma("unroll") for(int r=0;r<16;++r)pA1[r]=__builtin_amdgcn_exp2f(pA1[r]);
  WAIT_BAR(0);
  DMA_K(3,0);DMA_V(1,SLOTB);
  ROT();
  kload8(kf,kp0+sl_cur);
  WAIT_BAR(2);
  s16x4 vlo[8],vhi[8]; u32x4 pw0,pw1,pw2,pw3;
  #define PKW(P,B) cvtpk_s(P[B],P[B+1])
  #define PAF(k) __builtin_bit_cast(bf16x8,pw##k)
  #define VFR(i) (bf16x8){vlo[i][0],vlo[i][1],vlo[i][2],vlo[i][3],vhi[i][0],vhi[i][1],vhi[i][2],vhi[i][3]}
  #define PIN(x) asm volatile("":"+v"(x))
  #define MX3(a,b,c) __builtin_fmaxf(__builtin_fmaxf((a),(b)),(c))
  #define GAPA(MF,A0,A1,A2,A3,W0,W1,PW) do{ MF; sacc+=A0; sacc+=A1; sacc+=A2; sacc+=A3; PIN(sacc); W0; W1; PIN(PW); SBAR(); }while(0)
  #define EX(v) __builtin_amdgcn_exp2f(v)
  #define GAPB(MF,X,B) do{ MF; X[B]=EX(X[B]); X[B+1]=EX(X[B+1]); X[B+2]=EX(X[B+2]); X[B+3]=EX(X[B+3]); PIN(X); SBAR(); }while(0)
  #define VRD(i) do{ vlo[i]=vtr(vp_+(((i)>>2)*4096+((i)&3)*1024)); vhi[i]=vtr(vp_+(((i)>>2)*4096+((i)&3)*1024+512)); }while(0)
  #define KRD(G,j) do{ if(G){ kload2(kf,kp0+sl_next,j); SBAR(); } }while(0)
  #define STEP(C0,C1,P0,P1,t,GK,GV,GL) do{ SBAR(); \
    const lds_cptr vp_=vp0+sl_prev; \
    VRD(0); SBAR(); float sacc=(P0[0]+P0[1]); \
    GAPA(C0=__builtin_amdgcn_mfma_f32_32x32x16_bf16(kf[0],qr[0],negm,0,0,0), P0[2],P0[3],P0[4],P0[5],     pw0[0]=PKW(P0,0), pw0[1]=PKW(P0,2), pw0); \
    VRD(4); SBAR(); GAPA(C1=__builtin_amdgcn_mfma_f32_32x32x16_bf16(kf[1],qr[0],negm,0,0,0), P0[6],P0[7],P0[8],P0[9],     pw0[2]=PKW(P0,4), pw0[3]=PKW(P0,6), pw0); \
    VRD(1); SBAR(); GAPA(C0=__builtin_amdgcn_mfma_f32_32x32x16_bf16(kf[2],qr[1],C0,0,0,0),   P0[10],P0[11],P0[12],P0[13], pw1[0]=PKW(P0,8), pw1[1]=PKW(P0,10), pw1); \
    VRD(5); SBAR(); GAPA(C1=__builtin_amdgcn_mfma_f32_32x32x16_bf16(kf[3],qr[1],C1,0,0,0),   P0[14],P0[15],P1[0],P1[1],   pw1[2]=PKW(P0,12),pw1[3]=PKW(P0,14), pw1); \
    VRD(2); SBAR(); GAPA(C0=__builtin_amdgcn_mfma_f32_32x32x16_bf16(kf[4],qr[2],C0,0,0,0),   P1[2],P1[3],P1[4],P1[5],     pw2[0]=PKW(P1,0), pw2[1]=PKW(P1,2), pw2); \
    VRD(6); SBAR(); GAPA(C1=__builtin_amdgcn_mfma_f32_32x32x16_bf16(kf[5],qr[2],C1,0,0,0),   P1[6],P1[7],P1[8],P1[9],     pw2[2]=PKW(P1,4), pw2[3]=PKW(P1,6), pw2); \
    VRD(3); SBAR(); GAPA(C0=__builtin_amdgcn_mfma_f32_32x32x16_bf16(kf[6],qr[3],C0,0,0,0),   P1[10],P1[11],P1[12],P1[13], pw3[0]=PKW(P1,8), pw3[1]=PKW(P1,10), pw3); \
    VRD(7); SBAR(); GAPA(C1=__builtin_amdgcn_mfma_f32_32x32x16_bf16(kf[7],qr[3],C1,0,0,0),   P1[14],P1[15],0.f,0.f,       pw3[2]=PKW(P1,12),pw3[3]=PKW(P1,14), pw3); \
    l_reg+=sacc; \
    if(GK){DMA_K((t)+3,sl_cur);} if(GV){DMA_V((t)+1,sl_next);} \
    CMASK(C0,C1,t); \
    { float a=MX3(C0[0],C0[1],C1[0]),b=MX3(C0[2],C0[3],C1[1]); a=MX3(a,C1[2],C1[3]); \
      _Pragma("unroll") for(int r=4;r<16;r+=4){a=MX3(a,C0[r],C0[r+1]);b=MX3(b,C0[r+2],C0[r+3]);a=MX3(a,C1[r],C1[r+1]);b=MX3(b,C1[r+2],C1[r+3]);} \
      float rm=__builtin_fmaxf(a,b); { auto rr=__builtin_amdgcn_permlane32_swap(__float_as_uint(rm),__float_as_uint(rm),false,false); rm=__builtin_fmaxf(__uint_as_float(rr[0]),__uint_as_float(rr[1])); } \
      resc=false; \
      if(__builtin_expect(__any(rm>(float)THRL),0)){ const float dl=__builtin_fmaxf(rm,0.f); mhat+=dl; \
        _Pragma("unroll") for(int r=0;r<16;++r){C0[r]-=dl;C1[r]-=dl;} \
        _Pragma("unroll") for(int r=0;r<16;++r)negm[r]=-mhat; asm volatile("":"+v"(negm)); \
        const float f=__builtin_amdgcn_exp2f(-dl); l_reg*=f; if(hi==0)wsf[r32]=f; resc=true; } } \
    SBAR(); \
    GAPB(o[0]=__builtin_amdgcn_mfma_f32_32x32x16_bf16(PAF(0),VFR(0),o[0],0,0,0), C0,0); \
    GAPB(o[1]=__builtin_amdgcn_mfma_f32_32x32x16_bf16(PAF(0),VFR(4),o[1],0,0,0), C0,4); \
    KRD(GL,0); GAPB(o[0]=__builtin_amdgcn_mfma_f32_32x32x16_bf16(PAF(1),VFR(1),o[0],0,0,0), C0,8); \
    KRD(GL,1); GAPB(o[1]=__builtin_amdgcn_mfma_f32_32x32x16_bf16(PAF(1),VFR(5),o[1],0,0,0), C0,12); \
    KRD(GL,2); GAPB(o[0]=__builtin_amdgcn_mfma_f32_32x32x16_bf16(PAF(2),VFR(2),o[0],0,0,0), C1,0); \
    KRD(GL,3); GAPB(o[1]=__builtin_amdgcn_mfma_f32_32x32x16_bf16(PAF(2),VFR(6),o[1],0,0,0), C1,4); \
    GAPB(o[0]=__builtin_amdgcn_mfma_f32_32x32x16_bf16(PAF(3),VFR(3),o[0],0,0,0), C1,8); \
    GAPB(o[1]=__builtin_amdgcn_mfma_f32_32x32x16_bf16(PAF(3),VFR(7),o[1],0,0,0), C1,12); \
    }while(0)
  int t=1;
  #undef CMASK
  #define CMASK(P0,P1,t) do{}while(0)
  for(;t+5<NT;t+=2){
    STEP(pB0,pB1,pA0,pA1,t,true,true,true);     WAIT_BAR(2); RESC(); ROT();
    STEP(pA0,pA1,pB0,pB1,t+1,true,true,true);   WAIT_BAR(2); RESC(); ROT();
  }
  #undef CMASK
  #define CMASK(P0,P1,t) do{}while(0)
  #define ENDW(tt) do{ if((tt)+3<NT){WAIT_BAR(2);} else if((tt)+2<NT){WAIT_BAR(1);} else {WAIT_BAR(0);} }while(0)
  for(;t+1<NT;t+=2){
    STEP(pB0,pB1,pA0,pA1,t,(t+3<NT),(t+1<NT),(t+1<NT));       ENDW(t);   RESC(); ROT();
    STEP(pA0,pA1,pB0,pB1,t+1,(t+4<NT),(t+2<NT),(t+2<NT));     ENDW(t+1); RESC(); ROT();
  }
  STEP(pB0,pB1,pA0,pA1,NT-1,false,false,false); RESC();
  { float sacc=pB0[0]+pB0[1]; _Pragma("unroll") for(int r=2;r<16;++r)sacc+=pB0[r]; _Pragma("unroll") for(int r=0;r<16;++r)sacc+=pB1[r]; l_reg+=sacc;
    pw0=(u32x4){PKW(pB0,0),PKW(pB0,2),PKW(pB0,4),PKW(pB0,6)};pw1=(u32x4){PKW(pB0,8),PKW(pB0,10),PKW(pB0,12),PKW(pB0,14)};pw2=(u32x4){PKW(pB1,0),PKW(pB1,2),PKW(pB1,4),PKW(pB1,6)};pw3=(u32x4){PKW(pB1,8),PKW(pB1,10),PKW(pB1,12),PKW(pB1,14)};
    SBAR(); pv(o,vb0+sl_cur,PAF(0),PAF(1),PAF(2),PAF(3)); }
  #undef PKW
  #undef PAF
  #undef VFR
  #undef PIN
  #undef MX3
  #undef GAPA
  #undef GAPB
  #undef EX
  #undef VRD
  #undef KRD
  #undef STEP
  #undef ENDW
  {auto rr=__builtin_amdgcn_permlane32_swap(__float_as_uint(l_reg),__float_as_uint(l_reg),false,false);l_reg=__uint_as_float(rr[0])+__uint_as_float(rr[1]);}
  if(hi==0)wsf[32+r32]=l_reg;asm volatile("s_waitcnt lgkmcnt(0)":::"memory");
  float rli[16];
  #pragma unroll
  for(int r=0;r<16;++r)rli[r]=__builtin_amdgcn_rcpf(wsf[32+crow(r,hi)]);
  bf16*Ow=O+(rowbase+q0+wid*QBLK)*DM+h*D;
  { bf16*stg=(bf16*)(shm+LDS_OST)+wid*2048;
    #pragma unroll
    for(int r=0;r<16;++r){const int orow=crow(r,hi);
      #pragma unroll
      for(int d0=0;d0<2;++d0)stg[orow*64+d0*32+r32]=__float2bfloat16(o[d0][r]*rli[r]);}
    asm volatile("s_waitcnt lgkmcnt(0)":::"memory");
    #pragma unroll
    for(int i=0;i<4;++i){const int row=i*8+(lane>>3),ch=lane&7; const u32x4 v=*(const u32x4*)(stg+row*64+ch*8); ATTN_STORE16(Ow+(long)row*DM+ch*8,v);} }
  asm volatile("s_waitcnt lgkmcnt(0)\n\ts_barrier":::"memory");
  #undef DMA_K
  #undef DMA_V
  #undef CMASK
  #undef START
  #undef RESC
  #undef ROT
}
constexpr int ATTN_LDS_BYTES=LDS_BYTES;
#undef SBAR
#undef WAIT_BAR
}
namespace dil {
#define DLAS __attribute__((address_space(3)))
typedef unsigned short bf16_t;
typedef short bf16x8 __attribute__((ext_vector_type(8)));
typedef short s16x4 __attribute__((ext_vector_type(4)));
typedef float f32x16 __attribute__((ext_vector_type(16)));
typedef unsigned u32x4 __attribute__((ext_vector_type(4)));
constexpr int ROWB = 144;
constexpr int WAVE_LDS = 32 * ROWB + 256;
__device__ __forceinline__ int crow(int r, int hi) { return (r & 3) + 8 * (r >> 2) + 4 * hi; }
typedef float f32x2d __attribute__((ext_vector_type(2))); typedef __bf16 bf16x2d __attribute__((ext_vector_type(2)));
__device__ __forceinline__ unsigned cvtpk(float lo, float hi) { const f32x2d v = {lo, hi}; const bf16x2d b = __builtin_convertvector(v, bf16x2d); return __builtin_bit_cast(unsigned, b); }
__device__ __forceinline__ int clampi(int v) { return v < 0 ? 0 : (v > SEQ - 1 ? SEQ - 1 : v); }

__device__ __forceinline__ void load_tile(const bf16_t* Pb, int base, int dg, int m0, int kcol, int vcol, int lane, bf16x8 (&kf)[4], u32x4 (&vr)[4], bool doK, bool doV) {
    const int r32 = lane & 31, hi = lane >> 5;
    const int tk = clampi(base + dg * (m0 + r32));
    const bf16_t* kp = Pb + (size_t)tk * PP + kcol + 8 * hi;
    if (doK) {
#pragma unroll
    for (int d0 = 0; d0 < 4; ++d0) kf[d0] = *(const bf16x8*)(kp + 16 * d0); }
    if (doV)
#pragma unroll
    for (int c = 0; c < 4; ++c) { const int tv = clampi(base + dg * (m0 + 8 * c + (lane >> 3)));
        vr[c] = *(const u32x4*)(Pb + (size_t)tv * PP + vcol + 8 * (lane & 7)); }
}

__device__ __forceinline__ void dil_group(const bf16_t* Pb, int base, int qstride, int dg, int rho, int ntile, int qcol, DLAS unsigned char* wl, DLAS float* sc, int lane, int vaddr,
                                          float& m_run, float& l_run, f32x16& o0, f32x16& o1) {
    const int r32 = lane & 31, hi = lane >> 5; const int kcol = qcol + 256, vcol = qcol + 512;
    bf16x8 qf[4];
    { const bf16_t* qp = Pb + (size_t)(base + qstride * r32) * PP + qcol + 8 * hi;
#pragma unroll
      for (int d0 = 0; d0 < 4; ++d0) qf[d0] = *(const bf16x8*)(qp + 16 * d0); }
    bf16x8 kf[4], kn[4]; u32x4 vr[4];
    load_tile(Pb, base, dg, -64, kcol, vcol, lane, kf, vr, true, false);
    for (int T = 0; T < ntile; ++T) {
        const int m0 = -64 + 32 * T;
        load_tile(Pb, base, dg, m0, kcol, vcol, lane, kn, vr, false, true);
        if (T + 1 < ntile) load_tile(Pb, base, dg, m0 + 32, kcol, vcol, lane, kn, vr, true, false);
        f32x16 p = {};
#pragma unroll
        for (int d0 = 0; d0 < 4; ++d0) p = __builtin_amdgcn_mfma_f32_32x32x16_bf16(kf[d0], qf[d0], p, 0, 0, 0);
#pragma unroll
        for (int c = 0; c < 4; ++c) *(DLAS u32x4*)(wl + (8 * c + (lane >> 3)) * ROWB + (lane & 7) * 16) = vr[c];
        bool valid[16]; float mx = -1e30f;
#pragma unroll
        for (int r = 0; r < 16; ++r) { const int m = m0 + crow(r, hi); const int tok = base + dg * m;
            valid[r] = ((unsigned)(m - rho * r32 + 64) <= 128u) && ((unsigned)tok < (unsigned)SEQ);
            p[r] = valid[r] ? p[r] : -1e30f; mx = fmaxf(mx, p[r]); }
        mx = fmaxf(mx, __shfl_xor(mx, 32));
        const float m_new = fmaxf(m_run, mx), alpha = __builtin_amdgcn_exp2f(m_run - m_new); m_run = m_new;
        float psum = 0.f;
#pragma unroll
        for (int r = 0; r < 16; ++r) { const float e = valid[r] ? __builtin_amdgcn_exp2f(p[r] - m_new) : 0.f; p[r] = e; psum += e; }
        l_run = l_run * alpha + psum;
        if (!__all(alpha == 1.0f)) {
            if (hi == 0) sc[r32] = alpha;
#pragma unroll
            for (int r = 0; r < 16; ++r) { const float a = sc[crow(r, hi)]; o0[r] *= a; o1[r] *= a; }
        }
        u32x4 pk0, pk1;
        pk0.x = cvtpk(p[0], p[1]); pk0.y = cvtpk(p[2], p[3]); pk0.z = cvtpk(p[4], p[5]); pk0.w = cvtpk(p[6], p[7]);
        pk1.x = cvtpk(p[8], p[9]); pk1.y = cvtpk(p[10], p[11]); pk1.z = cvtpk(p[12], p[13]); pk1.w = cvtpk(p[14], p[15]);
        const bf16x8 pa0 = __builtin_bit_cast(bf16x8, pk0), pa1 = __builtin_bit_cast(bf16x8, pk1);
#pragma unroll
        for (int s = 0; s < 2; ++s) {
#pragma unroll
            for (int d0 = 0; d0 < 2; ++d0) {
                DLAS unsigned char* va = wl + vaddr + (16 * s + 4 * hi) * ROWB + d0 * 64;
                const s16x4 lo = __builtin_bit_cast(s16x4, __builtin_amdgcn_ds_read_tr16_b64_v4i16((DLAS s16x4*)va));
                const s16x4 hh = __builtin_bit_cast(s16x4, __builtin_amdgcn_ds_read_tr16_b64_v4i16((DLAS s16x4*)(va + 8 * ROWB)));
                const bf16x8 vf = (bf16x8){lo[0], lo[1], lo[2], lo[3], hh[0], hh[1], hh[2], hh[3]};
                if (d0 == 0) o0 = __builtin_amdgcn_mfma_f32_32x32x16_bf16(s == 0 ? pa0 : pa1, vf, o0, 0, 0, 0);
                else         o1 = __builtin_amdgcn_mfma_f32_32x32x16_bf16(s == 0 ? pa0 : pa1, vf, o1, 0, 0, 0);
            }
        }
#pragma unroll
        for (int i = 0; i < 4; ++i) kf[i] = kn[i];
    }
}
__device__ __forceinline__ void dil_pass1(bf16_t* P, int grp, int j, DLAS unsigned char* wl, int lane, float* SO, float* SM, float* SL) {
    const int r32 = lane & 31, hi = lane >> 5; const int b = grp >> 5, h = (grp >> 3) & 3, blk = grp & 7; const int base = 512 * blk + 32 * j;
    const bf16_t* Pb = P + (size_t)b * SEQ * PP; DLAS float* sc = (DLAS float*)(wl + 32 * ROWB);
    const int vaddr = ((lane & 15) >> 2) * ROWB + (((lane >> 4) & 1) * 16 + (lane & 3) * 4) * 2;
    float m_run = -1e30f, l_run = 0.f; f32x16 o0 = {}, o1 = {};
    dil_group(Pb, base, 1, 1, 1, 5, C_B0 + 64 * h, wl, sc, lane, vaddr, m_run, l_run, o0, o1);
    l_run += __shfl_xor(l_run, 32);
    const size_t srow = (size_t)h * SEQ + base; SO += (size_t)b * 2097152; SM += (size_t)b * 2097152; SL += (size_t)b * 2097152;
    if (hi == 0) { SM[srow + r32] = m_run; SL[srow + r32] = l_run; }
#pragma unroll
    for (int r = 0; r < 16; ++r) { float* so = SO + (srow + crow(r, hi)) * 64 + r32; so[0] = o0[r]; so[32] = o1[r]; }
}
__device__ __forceinline__ void dil_pass2(bf16_t* P, int grp, int rr, DLAS unsigned char* wl, int lane, const float* SO, const float* SM, const float* SL) {
    const int r32 = lane & 31, hi = lane >> 5; const int b = grp >> 5, h = (grp >> 3) & 3, blk = grp & 7; const int base = 512 * blk + rr;
    bf16_t* Pb = P + (size_t)b * SEQ * PP; DLAS float* sc = (DLAS float*)(wl + 32 * ROWB);
    const int vaddr = ((lane & 15) >> 2) * ROWB + (((lane >> 4) & 1) * 16 + (lane & 3) * 4) * 2;
    const size_t srow = (size_t)h * SEQ + base; SO += (size_t)b * 2097152; SM += (size_t)b * 2097152; SL += (size_t)b * 2097152;
    float m_run = SM[srow + 16 * r32], l_run = (hi == 0) ? SL[srow + 16 * r32] : 0.f; f32x16 o0, o1;
#pragma unroll
    for (int r = 0; r < 16; ++r) { const float* so = SO + (srow + 16 * crow(r, hi)) * 64 + r32; o0[r] = so[0]; o1[r] = so[32]; }
#pragma unroll 1
    for (int g = 1; g <= 2; ++g) dil_group(Pb, base, 16, 1 << (2 * g), 16 >> (2 * g), g == 1 ? 8 : 5, C_B0 + 768 * g + 64 * h, wl, sc, lane, vaddr, m_run, l_run, o0, o1);
    l_run += __shfl_xor(l_run, 32);
    if (hi == 0) sc[32 + r32] = __builtin_amdgcn_rcpf(l_run);
    bf16_t* op = Pb + (size_t)base * PP + C_OB + 64 * h + r32;
#pragma unroll
    for (int r = 0; r < 16; ++r) { const int q = crow(r, hi); const float inv = sc[32 + q];
        const __hip_bfloat16 a = __float2bfloat16(o0[r] * inv), c = __float2bfloat16(o1[r] * inv);
        op[(size_t)(16 * q) * PP] = __builtin_bit_cast(unsigned short, a); op[(size_t)(16 * q) * PP + 32] = __builtin_bit_cast(unsigned short, c); }
}
}


namespace naive {
__device__ __forceinline__ float bf2f(unsigned short v) { return __uint_as_float((unsigned)v << 16); }
__device__ __forceinline__ float wmax(float v) {
#pragma unroll
    for (int o = 1; o < 64; o <<= 1) v = fmaxf(v, __shfl_xor(v, o));
    return v;
}
__device__ __forceinline__ float wsum(float v) {
#pragma unroll
    for (int o = 1; o < 64; o <<= 1) v += __shfl_xor(v, o);
    return v;
}
__device__ __forceinline__ void dense_task(unsigned short* P, int task, __attribute__((address_space(3))) float* qs, int lane) {
    const int m = task >> 3, hq = task & 7, b = m >> 12;
    unsigned short* prow = P + (size_t)m * PP + C_QA + 64 * hq;
    qs[lane] = bf2f(prow[lane]);
    const unsigned short* kb = P + (size_t)b * SEQ * PP + C_KA + 64 * (hq >> 2);
    const unsigned short* vb = P + (size_t)b * SEQ * PP + C_VA + 64 * (hq >> 2);
    float m_run = -1e30f, l = 0.f, o = 0.f;
    for (int kc = 0; kc < SEQ / 64; ++kc) {
        const unsigned short* kr = kb + (size_t)(kc * 64 + lane) * PP;
        float s = 0.f;
#pragma unroll 8
        for (int d = 0; d < 64; ++d) s += qs[d] * bf2f(kr[d]);
        const float m_new = fmaxf(m_run, wmax(s)), alpha = __builtin_amdgcn_exp2f(m_run - m_new), p = __builtin_amdgcn_exp2f(s - m_new);
        m_run = m_new; l = l * alpha + wsum(p); o *= alpha;
        for (int j = 0; j < 64; ++j) o += __shfl(p, j) * bf2f(vb[(size_t)(kc * 64 + j) * PP + lane]);
    }
    const __hip_bfloat16 r = __float2bfloat16(o / l);
    prow[lane] = __builtin_bit_cast(unsigned short, r);
}
__device__ __forceinline__ void dil_task(unsigned short* P, int task, __attribute__((address_space(3))) float* qs, int lane) {
    const int m = task >> 2, h = task & 3, b = m >> 12, t = m & (SEQ - 1);
    const unsigned short* Pb = P + (size_t)b * SEQ * PP;
    float m_run = -1e30f, l = 0.f, o = 0.f;
    for (int g = 0; g < 3; ++g) {
        const int dg = 1 << (2 * g); const int qcol = C_B0 + 768 * g + 64 * h, kcol = qcol + 256, vcol = qcol + 512;
        qs[lane] = bf2f(Pb[(size_t)t * PP + qcol + lane]);
        for (int c = 0; c < 3; ++c) {
            const int j = -64 + 64 * c + lane, tok = t + dg * j; const bool valid = (j <= 64) && (tok >= 0) && (tok < SEQ);
            const unsigned short* kr = Pb + (size_t)(valid ? tok : t) * PP + kcol;
            float s = 0.f;
#pragma unroll 8
            for (int d = 0; d < 64; ++d) s += qs[d] * bf2f(kr[d]);
            s = valid ? s : -1e30f;
            const float m_new = fmaxf(m_run, wmax(s)), alpha = __builtin_amdgcn_exp2f(m_run - m_new), p = valid ? __builtin_amdgcn_exp2f(s - m_new) : 0.f;
            m_run = m_new; l = l * alpha + wsum(p); o *= alpha;
            for (int jj = 0; jj < 64; ++jj) { int tk = t + dg * (-64 + 64 * c + jj); tk = tk < 0 ? 0 : (tk > SEQ - 1 ? SEQ - 1 : tk);
                o += __shfl(p, jj) * bf2f(Pb[(size_t)tk * PP + vcol + lane]); }
        }
    }
    const __hip_bfloat16 r = __float2bfloat16(o / l);
    P[(size_t)m * PP + C_OB + 64 * h + lane] = __builtin_bit_cast(unsigned short, r);
}
}


namespace naive {
__device__ __forceinline__ float blo(unsigned w) { return __uint_as_float(w << 16); }
__device__ __forceinline__ float bhi(unsigned w) { return __uint_as_float(w & 0xffff0000u); }
__device__ __forceinline__ unsigned short f2b(float v) { const __hip_bfloat16 r = __float2bfloat16(v); return __builtin_bit_cast(unsigned short, r); }
__device__ __forceinline__ float dotcol(const unsigned short* arow, const float* W, int K, int N, int c) {
    float s = 0.f;
    for (int k = 0; k < K; k += 2) { const unsigned w2 = *(const unsigned*)(arow + k); s += blo(w2) * W[(size_t)k * N + c]; s += bhi(w2) * W[(size_t)(k + 1) * N + c]; }
    return s;
}
__device__ __forceinline__ void gin_task(int w, int lane, const unsigned short* XN, unsigned short* P, const float* win, const float* qna, const float* kna, const float* qnb, const float* knb) {
    const int m = w / 80, cg = w % 80, c = 64 * cg + lane, t = m & (SEQ - 1);
    if (!NAIVE_GIN && !((DBG_SKIP >> (cg >> 2)) & 1u)) return;
    const float z = dotcol(XN + (size_t)m * DM, win, DM, NIN, c);
    float o;
    if (cg >= 48) o = 1.0f / (1.0f + expf(-z));
    else {
        int mode; const float* gn = qna; float scale = 1.f;
        if (cg < 8) { mode = 0; gn = qna; scale = QK_C2; }
        else if (cg < 10) { mode = 0; gn = kna; }
        else if (cg < 12) mode = 2;
        else { const int g = (cg - 12) / 12, rem = (cg - 12) % 12; if (rem < 4) { mode = 1; gn = qnb + 64 * g; scale = QK_C2; } else if (rem < 8) { mode = 1; gn = knb + 64 * g; } else mode = 2; }
        if (mode == 2) o = z;
        else {
            const float ss = wsum(z * z), y = z * (1.0f / sqrtf(ss * (1.0f / 64.0f) + EPS)) * gn[lane];
            float ang; bool first; float partner;
            if (mode == 0) { const int dd = lane & 31, i = dd & 15, pos = (lane >> 5) ? (t & 63) : (t >> 6); ang = (float)pos * powf(10000.0f, -(float)i / 16.0f); first = dd < 16; partner = __shfl_xor(y, 16); }
            else { const int i = lane & 31; ang = (float)t * powf(10000.0f, -(float)i / 32.0f); first = lane < 32; partner = __shfl_xor(y, 32); }
            const double a = (double)ang; const float cs = (float)cos(a), sn = (float)sin(a);
            o = (first ? (y * cs - partner * sn) : (y * cs + partner * sn)) * scale;
        }
    }
    P[(size_t)m * PP + c] = f2b(o);
}
}

#define LAS __attribute__((address_space(3)))
typedef unsigned short bf16;
typedef unsigned v4u __attribute__((ext_vector_type(4)));
typedef float f32x4 __attribute__((ext_vector_type(4)));
constexpr int NWAVES = 8;
constexpr size_t MiB = 1u << 20;
constexpr size_t WS_ADA = 1 * MiB, WS_TABB = 2 * MiB, WS_TABA = 3 * MiB;
constexpr size_t WS_WIN = 4 * MiB, WS_WA = 44 * MiB, WS_WB = 48 * MiB, WS_WO = 50 * MiB, WS_W1 = 58 * MiB, WS_W2 = 90 * MiB;
constexpr size_t WS_XN = 122 * MiB, WS_P = 186 * MiB, WS_XSB = 442 * MiB, WS_RSS = 506 * MiB, WS_END = 508 * MiB;
constexpr size_t WS_BIASA = 64 * 1024, WS_GS = 704 * 1024, WS_BIASF = 3 * MiB + 64 * 1024;
constexpr int RING_BYTES = 131072, LDS_BYTES = 147456;
constexpr int NPHASE = 2 + 6 * DEPTH;

__device__ __forceinline__ unsigned f2bf(float f) { unsigned u = __builtin_bit_cast(unsigned, f); return (u + 0x7fffu + ((u >> 16) & 1u)) >> 16; }
__device__ __forceinline__ unsigned pk2(float lo, float hi) { return f2bf(lo) | (f2bf(hi) << 16); }
#define LDS_WAIT() asm volatile("s_waitcnt lgkmcnt(0)" ::: "memory")
__device__ __forceinline__ float wave_sum(float v) {
#pragma unroll
    for (int o = 1; o < 64; o <<= 1) v += __shfl_xor(v, o);
    return v;
}
__device__ __forceinline__ int win_dst_row(int n) {
    const int pn = n >> 8, u = n & 255, wc = u >> 6, d = u & 63, e = d & 7;
    if (pn >= 12) return n;
    int bj, fq;
    if (pn <= 1 || (pn == 2 && wc < 2)) { bj = (d >> 4) & 1; fq = 2 * (d >> 5) + ((d >> 3) & 1); }
    else { bj = d >> 5; fq = (d >> 3) & 3; }
    return (pn << 8) + 128 * bj + 32 * wc + 8 * fq + e;
}
__device__ __forceinline__ void p0_transpose_item(const float* W, int K, int N, bf16* WT, bool perm, LAS float* scr, int item, int lane) {
    const int nblk = N / 32, kb = item / nblk, nb = item % nblk, k0 = 64 * kb, n0 = 32 * nb;
#pragma unroll
    for (int i = 0; i < 8; ++i) { const int kk = 8 * i + (lane >> 3), ch = lane & 7;
        const f32x4 v = *(const f32x4*)(W + (size_t)(k0 + kk) * N + n0 + 4 * ch);
        LAS float* d = scr + kk * 33 + 4 * ch; d[0] = v[0]; d[1] = v[1]; d[2] = v[2]; d[3] = v[3]; }
    LDS_WAIT(); asm volatile("" ::: "memory");
    const int c = lane & 7;
#pragma unroll
    for (int j = 0; j < 4; ++j) { const int n = (lane >> 3) + 8 * j; const LAS float* s = scr + (8 * c) * 33 + n;
        v4u o; o.x = pk2(s[0 * 33], s[1 * 33]); o.y = pk2(s[2 * 33], s[3 * 33]); o.z = pk2(s[4 * 33], s[5 * 33]); o.w = pk2(s[6 * 33], s[7 * 33]);
        const int row = perm ? win_dst_row(n0 + n) : (n0 + n);
        *(v4u*)(WT + (size_t)row * K + k0 + 8 * c) = o; }
    LDS_WAIT(); asm volatile("" ::: "memory");
}

__device__ __forceinline__ void gemv8_block(const float* W, int N, int n0, const LAS float* vec, LAS float* red, float* dst, int dstride, const float* addv, int wave, int lane) {
    const int cg = lane & 15, rg = lane >> 4;
    f32x4 a[8];
#pragma unroll
    for (int b = 0; b < 8; ++b) a[b] = (f32x4){0.f, 0.f, 0.f, 0.f};
    const float* wp = W + (size_t)(wave * 128 + rg) * N + n0 + 4 * cg;
#pragma unroll 8
    for (int i = 0; i < 32; ++i) { const f32x4 wv = *(const f32x4*)(wp + (size_t)(4 * i) * N); const int kk = wave * 128 + 4 * i + rg;
#pragma unroll
        for (int b = 0; b < 8; ++b) a[b] += wv * vec[b * DM + kk]; }
#pragma unroll
    for (int b = 0; b < 8; ++b)
#pragma unroll
        for (int j = 0; j < 4; ++j) { float v = a[b][j]; v += __shfl_xor(v, 16); v += __shfl_xor(v, 32); a[b][j] = v; }
    if (rg == 0) {
#pragma unroll
        for (int b = 0; b < 8; ++b) *(LAS f32x4*)(red + (wave * 8 + b) * 64 + 4 * cg) = a[b];
    }
    __syncthreads();
    { float s = addv ? addv[n0 + lane] : 0.f;
#pragma unroll
      for (int w2 = 0; w2 < 8; ++w2) s += red[(w2 * 8 + wave) * 64 + lane];
      dst[(size_t)wave * dstride + n0 + lane] = s; }
    __syncthreads();
}

#define XB_TMO      128
#define XB_XCNT(j)  (256  + 64 * (j))
#define XB_XSUB(j)  (1280 + 64 * (j))
#define XB_XGEN(j)  (2304 + 64 * (j))
#define XB_TOP      3328
#define XB_TOPGEN   3392
#define XCD_BAR_WORDS 3456
#define XB_SPIN_CAP (1u << 18)

__device__ __forceinline__ unsigned xb_ld(unsigned* p)              { return __hip_atomic_load(p, __ATOMIC_RELAXED, __HIP_MEMORY_SCOPE_AGENT); }
__device__ __forceinline__ unsigned xb_add(unsigned* p, unsigned v) { return __hip_atomic_fetch_add(p, v, __ATOMIC_RELAXED, __HIP_MEMORY_SCOPE_AGENT); }
__device__ __forceinline__ unsigned xb_xcc_id() { return (unsigned)__builtin_amdgcn_s_getreg((3 << 11) | 20) & 0xFu; }
#define XB_SPIN(cond, bar) do { unsigned _sp = 0; while (cond) { __builtin_amdgcn_s_sleep(1); \
    if ((++_sp & 255u) == 0u) { if (xb_ld(&(bar)[XB_TMO])) break; if (_sp > XB_SPIN_CAP) { atomicAdd(&(bar)[XB_TMO], 1u); break; } } } } while (0)

struct XcdBarrier {
    unsigned* bar; unsigned x;
    volatile LAS unsigned* st;
};

__device__ __forceinline__ XcdBarrier xcd_barrier_post(unsigned* bar, volatile LAS unsigned* st, bool leader) {
    XcdBarrier b; b.bar = bar; b.x = xb_xcc_id(); b.st = st;
    if (leader) (void)xb_add(&bar[XB_XCNT(b.x)], 1u);
    return b;
}
__device__ __forceinline__ void xcd_barrier_complete(unsigned* bar, unsigned x, unsigned& nloc, unsigned& nx) {
    const unsigned G = gridDim.x * gridDim.y * gridDim.z;
    unsigned sum, cnt, mine, sp = 0u;
    for (;;) {
        sum = 0u; cnt = 0u; mine = 0u;
#pragma unroll
        for (unsigned j = 0; j < 16; ++j) { const unsigned c = xb_ld(&bar[XB_XCNT(j)]); sum += c; cnt += (c > 0u) ? 1u : 0u; mine = (j == x) ? c : mine; }
        if (sum == G) break;
        __builtin_amdgcn_s_sleep(1);
        if ((++sp & 255u) == 0u) { if (xb_ld(&bar[XB_TMO])) break; if (sp > XB_SPIN_CAP) { atomicAdd(&bar[XB_TMO], 1u); break; } }
    }
    nloc = mine > 0u ? mine : 1u; nx = cnt > 0u ? cnt : 1u;
}

__device__ __forceinline__ void xcd_barrier(const XcdBarrier& b, bool leader) {
    asm volatile("s_waitcnt vmcnt(0)" ::: "memory");
    __syncthreads();
    if (leader) {
        unsigned* bar = b.bar;
        __builtin_amdgcn_s_waitcnt(0);
        unsigned nloc = b.st[0], nx = b.st[1];
        if (nloc == 0u) { xcd_barrier_complete(bar, b.x, nloc, nx); b.st[0] = nloc; b.st[1] = nx; }
        const unsigned old = xb_add(&bar[XB_XSUB(b.x)], 1u);
        const unsigned gen = old / nloc;
        if (old + 1u == (gen + 1u) * nloc) {
            __builtin_amdgcn_fence(__ATOMIC_RELEASE, "agent");
            asm volatile("s_waitcnt vmcnt(0)" ::: "memory");
            const unsigned og = xb_add(&bar[XB_TOP], 1u);
            const unsigned tg = og / nx;
            if (og + 1u == (tg + 1u) * nx) xb_add(&bar[XB_TOPGEN], 1u);
            else XB_SPIN(xb_ld(&bar[XB_TOPGEN]) == tg, bar);
            __builtin_amdgcn_fence(__ATOMIC_ACQUIRE, "agent");
            xb_add(&bar[XB_XGEN(b.x)], 1u);
            asm volatile("s_waitcnt vmcnt(0)" ::: "memory");
        } else {
            XB_SPIN(xb_ld(&bar[XB_XGEN(b.x)]) == gen, bar);
            __builtin_amdgcn_fence(__ATOMIC_ACQUIRE, "agent");
            asm volatile("s_waitcnt vmcnt(0)" ::: "memory");
        }
    }
    __syncthreads();
}

#define LB_CNT(g)   (3584 + 64 * (g))
#define LB_XMAX(g)  (3456 + (g))
#define LB_XMIN(g)  (3464 + (g))
__device__ __forceinline__ void grp_barrier(unsigned* bar, int vg, unsigned nloc, bool leader) {
    asm volatile("s_waitcnt vmcnt(0)" ::: "memory");
    __syncthreads();
    if (leader) {
        __builtin_amdgcn_s_waitcnt(0);
        const unsigned old = xb_add(&bar[LB_CNT(vg)], 1u), want = (old / nloc + 1u) * nloc;
        XB_SPIN(xb_ld(&bar[LB_CNT(vg)]) < want, bar);
        __builtin_amdgcn_fence(__ATOMIC_ACQUIRE, "agent");
        asm volatile("s_waitcnt vmcnt(0)" ::: "memory");
    }
    __syncthreads();
}

struct Args { const float* in[16]; float* out; unsigned char* ws; int ph_lo, ph_hi; };

typedef const Args __attribute__((address_space(4))) CArgs;
template <int ph> __device__ __forceinline__ void run_phase(CArgs* ap0, const int wave0, unsigned char* lds) {
    LAS unsigned char* L = (LAS unsigned char*)lds;
        int zz = 0; asm volatile("" : "+v"(zz));
        const int lane = __builtin_amdgcn_mbcnt_hi(~0u, __builtin_amdgcn_mbcnt_lo(~0u, zz)), wave = wave0;
        const int tid = wave * 64 + lane;
        int bx = blockIdx.x; asm volatile("" : "+s"(bx));
        const int G = gridDim.x; const int vcu = (G % 8 == 0) ? (bx % 8) * (G / 8) + bx / 8 : bx;
        const int gw = vcu * NWAVES + wave, NGW = G * NWAVES;
        CArgs* ap = ap0; asm volatile("" : "+s"(ap));
        unsigned char* ws = ap->ws;
        float* ADA = (float*)(ws + WS_ADA); float* TABB = (float*)(ws + WS_TABB); float* TABA = (float*)(ws + WS_TABA);
        bf16* XN = (bf16*)(ws + WS_XN); bf16* P = (bf16*)(ws + WS_P); bf16* HB = (bf16*)(ws + WS_P);
        const float* x_in = ap->in[0]; float* out = ap->out;
        if (ph == 0) {
            {
                LAS float* cact = (LAS float*)L;
                LAS float* red = (LAS float*)(L + 32768);
                for (int i = tid; i < BATCH * DM; i += NWAVES * 64) { const float v = ap->in[1][i]; cact[i] = v * __builtin_amdgcn_rcpf(1.0f + __expf(-v)); }
                __syncthreads();
                for (int it = bx; it < DEPTH * 96; it += G) {
                    const int l = it / 96, n0 = (it % 96) * 64;
                    gemv8_block(ap->in[2] + (size_t)l * DM * 6 * DM, 6 * DM, n0, cact, red, ADA + (size_t)l * BATCH * 6 * DM, 6 * DM, ap->in[3] + (size_t)l * 6 * DM, wave, lane);
                }
            }
            {
                for (int e = bx * NWAVES * 64 + tid; e < SEQ * 32 + 64 * 16; e += G * NWAVES * 64) {
                    int pos, i; float fr; float* dst;
                    if (e < SEQ * 32) { pos = e >> 5; i = e & 31; fr = (float)i * (1.0f / 32.0f); dst = TABB + 2 * (size_t)e; }
                    else { const int e2 = e - SEQ * 32; pos = e2 >> 4; i = e2 & 15; fr = (float)i * (1.0f / 16.0f); dst = TABA + 2 * (size_t)e2; }
                    const float inv = exp2f(-fr * 13.287712379549449f);
                    const float ang = (float)pos * inv;
                    const double turns = (double)ang * 0.15915494309189535;
                    const float fpart = (float)(turns - rint(turns));
#if TAB_DOUBLE
                    dst[0] = (float)cos((double)ang); dst[1] = (float)sin((double)ang);
#else
                    dst[0] = __builtin_amdgcn_cosf(fpart); dst[1] = __builtin_amdgcn_sinf(fpart);
#endif
                }
            }
            {
                LAS float* scr = (LAS float*)(L + wave * 16384);
                constexpr int I_IN = (DM / 64) * (NIN / 32), I_A = (512 / 64) * (DM / 32), I_B = (256 / 64) * (DM / 32), I_O = (DM / 64) * (DM / 32), I_1 = (DM / 64) * (FF / 32), I_2 = (FF / 64) * (DM / 32);
                constexpr int I_L = I_IN + I_A + I_B + I_O + I_1 + I_2;
                __syncthreads();
                for (int it = gw; it < DEPTH * I_L; it += NGW) {
                    const int l = it / I_L; int r = it - l * I_L;
                    if (r < I_IN) { p0_transpose_item(ap->in[6] + (size_t)l * DM * NIN, DM, NIN, (bf16*)(ws + WS_WIN) + (size_t)l * NIN * DM, true, scr, r, lane); continue; } r -= I_IN;
                    if (r < I_A) { p0_transpose_item(ap->in[11] + (size_t)l * 512 * DM, 512, DM, (bf16*)(ws + WS_WA) + (size_t)l * DM * 512, false, scr, r, lane); continue; } r -= I_A;
                    if (r < I_B) { p0_transpose_item(ap->in[12] + (size_t)l * 256 * DM, 256, DM, (bf16*)(ws + WS_WB) + (size_t)l * DM * 256, false, scr, r, lane); continue; } r -= I_B;
                    if (r < I_O) { p0_transpose_item(ap->in[13] + (size_t)l * DM * DM, DM, DM, (bf16*)(ws + WS_WO) + (size_t)l * DM * DM, false, scr, r, lane); continue; } r -= I_O;
                    if (r < I_1) { p0_transpose_item(ap->in[14] + (size_t)l * DM * FF, DM, FF, (bf16*)(ws + WS_W1) + (size_t)l * FF * DM, false, scr, r, lane); continue; } r -= I_1;
                    p0_transpose_item(ap->in[15] + (size_t)l * FF * DM, FF, DM, (bf16*)(ws + WS_W2) + (size_t)l * DM * FF, false, scr, r, lane);
                }
                __syncthreads();
            }
        } else {
            const int l = (ph - 2) / 6, sub6 = (ph - 2) % 6;
            const int sub = (ph == 1) ? 0 : (sub6 == 0 ? 1 : sub6 == 1 ? 2 : sub6 == 2 ? 3 : sub6 == 3 ? 4 : sub6 == 4 ? 6 : 7);
            const float* ada_l = ADA + (size_t)l * BATCH * 6 * DM;
            float* RSS = (float*)(ws + WS_RSS); float* GSV = (float*)(ws + WS_GS); float* BIASA = (float*)(ws + WS_BIASA); float* BIASF = (float*)(ws + WS_BIASF); bf16* XSB = P + C_GB;
            if (sub == 0) {
                { LAS float* shv = (LAS float*)L;
                  LAS float* red = (LAS float*)(L + 32768);
                  for (int it = bx; it < DEPTH * 144; it += G) {
                      const int ll = it / 144, r = it % 144; const bool isA = r < 80; const int n0 = (isA ? r : r - 80) * 64, N = isA ? NIN : FF;
                      const float* W = (isA ? ap->in[6] + (size_t)ll * DM * NIN : ap->in[14] + (size_t)ll * DM * FF);
                      const float* adl = ADA + (size_t)ll * BATCH * 6 * DM + (isA ? 0 : 3 * DM);
                      for (int i = tid; i < BATCH * DM; i += NWAVES * 64) shv[i] = adl[(size_t)(i >> 10) * 6 * DM + (i & 1023)];
                      __syncthreads();
                      gemv8_block(W, N, n0, shv, red, isA ? BIASA + (size_t)ll * BATCH * NIN : BIASF + (size_t)ll * BATCH * FF, N, nullptr, wave, lane);
                  } }
                for (int e = bx * NWAVES * 64 + tid; e < 2 * DEPTH * BATCH * DM; e += G * NWAVES * 64) {
                    const int which = e >> 15, ll = (e >> 13) & 3, b = (e >> 10) & 7, c = e & 1023;
                    GSV[e] = (which ? ap->in[5] : ap->in[4])[ll * DM + c] * (1.0f + ADA[((size_t)ll * BATCH + b) * 6 * DM + (which ? 4 : 1) * DM + c]);
                }
                { f32x4 gg[4];
#pragma unroll
                  for (int j = 0; j < 4; ++j) gg[j] = *(const f32x4*)(ap->in[4] + 256 * j + 4 * lane);
                  for (int m = gw; m < MTOK; m += NGW) {
                    const int b = m >> 12; const f32x4* xr = (const f32x4*)(x_in + (size_t)m * DM) + lane;
                    f32x4 v[4]; float s = 0.f;
#pragma unroll
                    for (int j = 0; j < 4; ++j) { v[j] = xr[64 * j]; s += (v[j][0] * v[j][0] + v[j][1] * v[j][1]) + (v[j][2] * v[j][2] + v[j][3] * v[j][3]); }
                    s = wave_sum(s);
                    if (lane < 16) RSS[(size_t)m * 16 + lane] = (lane == 0) ? s : 0.f;
                    const float* ab = ADA + (size_t)b * 6 * DM + DM;
                    unsigned long long* o8 = (unsigned long long*)(XN + (size_t)m * DM) + lane;
#pragma unroll
                    for (int j = 0; j < 4; ++j) { const f32x4 sc = *(const f32x4*)(ab + 256 * j + 4 * lane);
                        const f32x4 y = v[j] * gg[j] * (sc + 1.0f);
                        o8[64 * j] = (unsigned long long)pk2(y[0], y[1]) | ((unsigned long long)pk2(y[2], y[3]) << 32); }
                  } }
            } else if (sub == 1) {
                pg8::Gemm g{XN, (const bf16*)(ws + WS_WIN) + (size_t)l * NIN * DM, MTOK, NIN, DM, DM}; pg8::StaticOrder S; S.init(MTOK, NIN, G, bx);
                pg8::EpiIn E{P, ap->in[7] + l * 64, ap->in[8] + l * 64, ap->in[9] + l * 192, ap->in[10] + l * 192, TABA, TABB, RSS, BIASA + (size_t)l * BATCH * NIN};
#if NAIVE_GIN
                for (int w = gw; w < MTOK * 80; w += NGW) naive::gin_task(w, lane, XN, P, ap->in[6] + (size_t)l * DM * NIN, ap->in[7] + l * 64, ap->in[8] + l * 64, ap->in[9] + l * 192, ap->in[10] + l * 192);
#else
#ifndef NO_GIN
                pg8::gemm_phase<pg8::EpiIn, pg8::StaticOrder, true, true, DM, DM>(tid, L, g, S, E);
#if DBG_GEMM2 & 1
                pg8::gemm_phase<pg8::EpiIn, pg8::StaticOrder, true, true, DM, DM>(tid, L, g, S, E);
#endif
#endif
#if DBG_SKIP
                for (int w = gw; w < MTOK * 80; w += NGW) naive::gin_task(w, lane, XN, P, ap->in[6] + (size_t)l * DM * NIN, ap->in[7] + l * 64, ap->in[8] + l * 64, ap->in[9] + l * 192, ap->in[10] + l * 192);
#endif
#endif
            } else if (sub == 2) {
                for (int u = vcu; u < BATCH * 8 * 16; u += G) {
                    const int i = u / G, gsz = G >> 3, loc = (vcu % gsz) + gsz * i;
                    const int b = vcu / gsz, h = (loc >> 4) & 7, qb = loc & 15;
                    if (loc >= 128) continue;
#if !defined(NO_ATT) && !NAIVE_ATT
                    attn_body::attn_unit<8>(b, h, qb, (const attn_body::bf16*)P + C_QA, (const attn_body::bf16*)P + C_KA, (const attn_body::bf16*)P + C_VA, (attn_body::bf16*)P + C_QA, (char*)lds, tid);
#endif
                }
                __syncthreads();
#if NAIVE_ATT
                for (int w = gw; w < MTOK * 8; w += NGW) naive::dense_task(P, w, (LAS float*)(L + wave * 256), lane);
                __syncthreads();
#endif
#if NAIVE_DIL
                for (int w = gw; w < MTOK * 4; w += NGW) naive::dil_task(P, w, (LAS float*)(L + wave * 256), lane);
#elif !defined(NO_DIL)
                { float* SO = (float*)(ws + WS_XN); float* SM = (float*)(ws + WS_XN + 4 * MiB); float* SL = (float*)(ws + WS_XN + 4 * MiB + 65536);
                  for (int grp = vcu; grp < BATCH * 4 * 8; grp += G) {
#pragma unroll 1
                    for (int k2 = 0; k2 < 2; ++k2) dil::dil_pass1(P, grp, wave + 8 * k2, L + wave * dil::WAVE_LDS, lane, SO, SM, SL);
                    asm volatile("s_waitcnt vmcnt(0)" ::: "memory"); __syncthreads();
#pragma unroll 1
                    for (int k2 = 0; k2 < 2; ++k2) dil::dil_pass2(P, grp, wave + 8 * k2, L + wave * dil::WAVE_LDS, lane, SO, SM, SL);
                    __syncthreads();
                  } }
#endif
                __syncthreads();
            } else if (sub == 3) {
                { pg8::Gemm g{P + C_QA, (const bf16*)(ws + WS_WA) + (size_t)l * DM * 512, MTOK, DM, 512, PP}; pg8::StaticOrder S; S.init(MTOK, DM, G, bx);

#if NAIVE_BR
                for (int w = gw; w < MTOK * 16; w += NGW) { const int m = w >> 4, c = 64 * (w & 15) + lane;
                    const float za = naive::dotcol(P + (size_t)m * PP + C_QA, ap->in[11] + (size_t)l * 512 * DM, 512, DM, c), zb = naive::dotcol(P + (size_t)m * PP + C_OB, ap->in[12] + (size_t)l * 256 * DM, 256, DM, c);
                    const float ga = naive::bf2f(P[(size_t)m * PP + C_GA + c]), gb = naive::bf2f(P[(size_t)m * PP + C_GB + c]);
                    XN[(size_t)m * DM + c] = naive::f2b(ga * za + gb * zb); }
#else
#ifndef NO_BR0
pg8::EpiBr<0> E{XN, P, C_GA}; pg8::gemm_phase<pg8::EpiBr<0>, pg8::StaticOrder, true, true, 512, PP>(tid, L, g, S, E);
#endif
#endif
 }
                { pg8::Gemm g{P + C_OB, (const bf16*)(ws + WS_WB) + (size_t)l * DM * 256, MTOK, DM, 256, PP}; pg8::StaticOrder S; S.init(MTOK, DM, G, bx);

#if NAIVE_BR

#else
#ifndef NO_BR1
pg8::EpiBr<1> E{XN, P, C_GB}; pg8::gemm_phase<pg8::EpiBr<1>, pg8::StaticOrder, true, true, 256, PP>(tid, L, g, S, E);
#endif
#endif
 }
            } else if (sub == 4) {
                pg8::Gemm g{XN, (const bf16*)(ws + WS_WO) + (size_t)l * DM * DM, MTOK, DM, DM, DM}; pg8::StaticOrder S; S.init(MTOK, DM, G, bx);
                pg8::EpiRes E{l == 0 ? x_in : out, out, ada_l + 2 * DM, XSB, GSV + (size_t)(DEPTH + l) * BATCH * DM, RSS, PP};
#if NAIVE_OUT
                for (int w = gw; w < MTOK * 16; w += NGW) { const int m = w >> 4, c = 64 * (w & 15) + lane;
                    const float z = naive::dotcol(XN + (size_t)m * DM, ap->in[13] + (size_t)l * DM * DM, DM, DM, c);
                    out[(size_t)m * DM + c] = (l == 0 ? x_in : out)[(size_t)m * DM + c] + ada_l[(size_t)(m >> 12) * 6 * DM + 2 * DM + c] * z; }
#else
#ifndef NO_RES
pg8::gemm_phase<pg8::EpiRes, pg8::StaticOrder, true, true, DM, DM>(tid, L, g, S, E);
#endif
#endif

            } else if (sub == 6) {
                pg8::Gemm g{XSB, (const bf16*)(ws + WS_W1) + (size_t)l * FF * DM, MTOK, FF, DM, PP}; pg8::StaticOrder S; S.init(MTOK, FF, G, bx);
                pg8::EpiRelu2 E{HB, RSS, BIASF + (size_t)l * BATCH * FF};
#if NAIVE_F1
                for (int w = gw; w < MTOK * 64; w += NGW) { const int m = w >> 6, c = 64 * (w & 63) + lane;
                    const float z = fmaxf(naive::dotcol(XN + (size_t)m * DM, ap->in[14] + (size_t)l * DM * FF, DM, FF, c), 0.f);
                    HB[(size_t)m * FF + c] = naive::f2b(z * z); }
#else
#ifndef NO_F1
pg8::gemm_phase<pg8::EpiRelu2, pg8::StaticOrder, true, true, DM, PP>(tid, L, g, S, E);
#if DBG_GEMM2 & 4
pg8::gemm_phase<pg8::EpiRelu2, pg8::StaticOrder, true, true, DM, PP>(tid, L, g, S, E);
#endif
#endif
#endif

            } else {
                pg8::Gemm g{HB, (const bf16*)(ws + WS_W2) + (size_t)l * DM * FF, MTOK, DM, FF, PP}; pg8::StaticOrder S; S.init(MTOK, DM, G, bx);
                pg8::EpiRes E{out, out, ada_l + 5 * DM, (l + 1 < DEPTH) ? XN : (bf16*)nullptr, GSV + (size_t)((l + 1 < DEPTH) ? (l + 1) : 0) * BATCH * DM, RSS, DM};
#if NAIVE_F2
                for (int w = gw; w < MTOK * 16; w += NGW) { const int m = w >> 4, c = 64 * (w & 15) + lane;
                    const float z = naive::dotcol(HB + (size_t)m * FF, ap->in[15] + (size_t)l * FF * DM, FF, DM, c);
                    out[(size_t)m * DM + c] = out[(size_t)m * DM + c] + ada_l[(size_t)(m >> 12) * 6 * DM + 5 * DM + c] * z; }
#else
#ifndef NO_RES
pg8::gemm_phase<pg8::EpiRes, pg8::StaticOrder, true, true, FF, PP>(tid, L, g, S, E);
#endif
#endif

            }
        }
}

__global__ void __launch_bounds__(NWAVES * 64, 2) mk_fwd(Args args) {
    extern __shared__ __attribute__((aligned(16))) unsigned char lds[];
    CArgs* ap0 = (CArgs*)__builtin_amdgcn_kernarg_segment_ptr();
    const int ph_lo = ap0->ph_lo, ph_hi = ap0->ph_hi;
    const int wave0 = __builtin_amdgcn_readfirstlane(threadIdx.x >> 6);
    volatile LAS unsigned* bst = (volatile LAS unsigned*)((LAS unsigned char*)lds + RING_BYTES + 64);
    if (threadIdx.x == 0) { bst[0] = 0u; bst[1] = 0u; }
    __syncthreads();
    unsigned* barw = (unsigned*)ap0->ws;
    const unsigned xbx = xcd_barrier_post(barw, bst, threadIdx.x == 0).x;
    if (threadIdx.x == 0) { const int vg0 = blockIdx.x & 7; atomicMax(&barw[LB_XMAX(vg0)], xbx + 1u); atomicMax(&barw[LB_XMIN(vg0)], 16u - xbx); bst[2] = 0u; }
#define RUN(PH) if (ph_lo <= (PH) && (PH) < ph_hi) { const bool spin_ = (DBG_SPIN_SUB >= 0) && (PH) >= 2 && (((PH) - 2) % 6 == DBG_SPIN_SUB); unsigned long long t0_ = 0; if (spin_) t0_ = __builtin_amdgcn_s_memrealtime(); run_phase<(PH)>(ap0, wave0, lds); if (spin_) { __syncthreads(); const unsigned long long t1_ = __builtin_amdgcn_s_memrealtime(); while (__builtin_amdgcn_s_memrealtime() - t1_ < t1_ - t0_) __builtin_amdgcn_s_sleep(8); } if (DBG_P02 && (PH) <= 1) { __syncthreads(); run_phase<((PH) <= 1 ? (PH) : 0)>(ap0, wave0, lds); } if ((PH) + 1 < ph_hi) { if ((PH) == 0) cg::this_grid().sync(); else { int z_ = 0; asm volatile("" : "+v"(z_)); const bool ld_ = (wave0 == 0) && (__builtin_amdgcn_mbcnt_hi(~0u, __builtin_amdgcn_mbcnt_lo(~0u, z_)) == 0); XcdBarrier xb_; xb_.bar = barw; xb_.x = xbx; xb_.st = bst; if ((PH) == 1) { xcd_barrier(xb_, ld_); if (ld_) { unsigned ok_ = (gridDim.x == 256u) ? 1u : 0u;     for (int g_ = 0; g_ < 8; ++g_) ok_ &= (xb_ld(&barw[LB_XMAX(g_)]) + xb_ld(&barw[LB_XMIN(g_)]) == 17u) ? 1u : 0u; bst[2] = (LOCAL_SEAMS ? ok_ : 0u); } __syncthreads(); if (DBG_CENSUS && !bst[2]) { const unsigned long long tc_ = __builtin_amdgcn_s_memrealtime(); while (__builtin_amdgcn_s_memrealtime() - tc_ < 200000ull) __builtin_amdgcn_s_sleep(8); } } else { unsigned long long tb0_ = 0; if (DBG_SPIN_BAR) tb0_ = __builtin_amdgcn_s_memrealtime(); if (bst[2]) grp_barrier(barw, (int)(blockIdx.x & 7), gridDim.x / 8u, ld_); else for (int xs_ = 0; xs_ <= DBG_SYNCX; ++xs_) xcd_barrier(xb_, ld_); if (DBG_SPIN_BAR) { const unsigned long long tb1_ = __builtin_amdgcn_s_memrealtime(); while (__builtin_amdgcn_s_memrealtime() - tb1_ < tb1_ - tb0_) __builtin_amdgcn_s_sleep(8); } } } } }
#define RUN8(B) RUN(B) RUN(B + 1) RUN(B + 2) RUN(B + 3) RUN(B + 4) RUN(B + 5) RUN(B + 6) RUN(B + 7)
    RUN(0) RUN(1) RUN8(2) RUN8(10) RUN8(18)
#undef RUN8
#undef RUN
}

extern "C" void kernel_launch(void* const* d_in, const int* in_sizes, int n_in, void* d_out, int out_size, void* d_ws, size_t ws_size, hipStream_t stream) {
    static int grid = 0;
    if (grid == 0) {
        if (n_in != 16 || out_size != MTOK * DM || ws_size < WS_END) { fprintf(stderr, "kernel_launch: unexpected shapes (n_in %d out %d ws %zu)\n", n_in, out_size, ws_size); grid = -1; return; }
        int dev = 0, cus = 0, per_cu = 0;
        if (hipGetDevice(&dev) != hipSuccess || hipDeviceGetAttribute(&cus, hipDeviceAttributeMultiprocessorCount, dev) != hipSuccess) { grid = -1; return; }
        if (hipFuncSetAttribute((const void*)mk_fwd, hipFuncAttributeMaxDynamicSharedMemorySize, LDS_BYTES) != hipSuccess) { fprintf(stderr, "kernel_launch: hipFuncSetAttribute failed\n"); grid = -1; return; }
        if (hipOccupancyMaxActiveBlocksPerMultiprocessor(&per_cu, (const void*)mk_fwd, NWAVES * 64, LDS_BYTES) != hipSuccess || per_cu < 1) per_cu = 1;
        (void)hipGetLastError();
        grid = cus * 1;
        fprintf(stderr, "kernel_launch: grid %d (occupancy query %d per CU)\n", grid, per_cu);
    }
    if (grid < 0) return;
    if (hipMemsetAsync(d_ws, 0, 16384, stream) != hipSuccess) { fprintf(stderr, "kernel_launch: memset failed\n"); return; }
    Args a{};
    for (int i = 0; i < 16; ++i) a.in[i] = (const float*)d_in[i];
    a.out = (float*)d_out; a.ws = (unsigned char*)d_ws;
#if MK_PER_PHASE
    for (int ph = 0; ph < NPHASE; ++ph) { a.ph_lo = ph; a.ph_hi = ph + 1; hipLaunchKernelGGL(mk_fwd, dim3(grid), dim3(NWAVES * 64), LDS_BYTES, stream, a); }
#else
    a.ph_lo = 0; a.ph_hi = NPHASE;
    void* kargs[] = {&a};
    hipError_t e = hipLaunchCooperativeKernel((void*)mk_fwd, dim3(grid), dim3(NWAVES * 64), kargs, LDS_BYTES, stream);
    if (e != hipSuccess) fprintf(stderr, "cooperative launch failed: %s (grid %d)\n", hipGetErrorString(e), grid);
#endif
}
```

```cpp
#include <hip/hip_runtime.h>
#include <hip/hip_bf16.h>
#include <hip/hip_cooperative_groups.h>
#include <cstdio>
#include <cstdint>
#include <cmath>
namespace cg = cooperative_groups;

#ifndef MK_PER_PHASE
#define MK_PER_PHASE 0
#endif

#ifndef NAIVE_ATT
#define NAIVE_ATT 0
#endif
#ifndef NAIVE_DIL
#define NAIVE_DIL 0
#endif

#ifndef NAIVE_GEMM
#define NAIVE_GEMM 0
#endif

#ifndef NAIVE_GIN
#define NAIVE_GIN NAIVE_GEMM
#endif
#ifndef NAIVE_BR
#define NAIVE_BR NAIVE_GEMM
#endif
#ifndef NAIVE_OUT
#define NAIVE_OUT NAIVE_GEMM
#endif
#ifndef NAIVE_F1
#define NAIVE_F1 NAIVE_GEMM
#endif
#ifndef NAIVE_F2
#define NAIVE_F2 NAIVE_GEMM
#endif

#ifndef TAB_DOUBLE
#define TAB_DOUBLE 1
#endif

#ifndef DBG_SKIP
#define DBG_SKIP 0u
#endif

#ifndef DBG_SYNCX
#define DBG_SYNCX 0
#endif
#ifndef DBG_DIL2
#define DBG_DIL2 0
#endif
#ifndef DBG_GEMM2
#define DBG_GEMM2 0
#endif

#ifndef DBG_P02
#define DBG_P02 0
#endif

#ifndef DBG_SPIN_SUB
#define DBG_SPIN_SUB (-1)
#endif

#ifndef DBG_SPIN_BAR
#define DBG_SPIN_BAR 0
#endif

#ifndef LOCAL_SEAMS
#define LOCAL_SEAMS 1
#endif

#ifndef DBG_CENSUS
#define DBG_CENSUS 0
#endif

constexpr int BATCH = 8, SEQ = 4096, DM = 1024, DEPTH = 4, FF = 4096, NIN = 5120;
constexpr int MTOK = BATCH * SEQ;
constexpr int PP = 5120;
constexpr int C_QA = 0, C_KA = 512, C_VA = 640, C_B0 = 768, C_GA = 3072, C_GB = 4096, C_OB = 768;
constexpr float QK_C2 = 0.125f * 1.4426950408889634f;
constexpr float EPS = 1e-6f;

namespace pg8 {
#define PG8_LAS __attribute__((address_space(3)))
typedef unsigned short bf16_t;
typedef short bf16x8 __attribute__((ext_vector_type(8)));
typedef float f32x4 __attribute__((ext_vector_type(4)));
typedef unsigned u32x4 __attribute__((ext_vector_type(4)));
constexpr int BM = 256, BK = 64, HALF = 128, HTB = HALF * BK * 2  , STAGE_BYTES = 8 * HTB, NXCD = 8, WGM = 8;

__host__ __device__ __forceinline__ int lds_byte(int r, int c) { const int st = (r >> 4) * 2 + (c >> 5), rr = r & 15, cc = c & 31, ob = rr * 64 + cc * 2; return st * 1024 + (ob ^ (((ob >> 9) & 1) << 5)); }
__host__ __device__ __forceinline__ void stage_rc(int b, int& R, int& C) { const int st = b / 1024, sb = b % 1024, swz = sb ^ (((sb >> 9) & 1) << 5); R = (st >> 1) * 16 + swz / 64; C = (st & 1) * 32 + (swz % 64) / 2; }
__host__ __device__ __forceinline__ int perm32(int rho) { const int n = rho >> 4, i = rho & 15; return 8 * (i >> 2) + 4 * n + (i & 3); }

struct Unit { int pm, pn; };
struct Gemm { const bf16_t* A; const bf16_t* Bt; int M, N, K, lda; };

struct StaticOrder {
    int nM, nN, nwg, G, c;
    __host__ __device__ void init(int M, int N, int G_, int c_) { nM = M / BM; nN = N / BM; nwg = nM * nN; G = G_; c = c_; }
    __host__ __device__ bool next(int i, Unit& u) const {
        const long L = (long)i * G + c; if (L >= nwg) return false;
        int wgid = (int)L; { const int q = nwg / NXCD, r = nwg % NXCD, xcd = wgid % NXCD, off = wgid / NXCD; wgid = (xcd < r ? xcd * (q + 1) : r * (q + 1) + (xcd - r) * q) + off; }
        const int nig = WGM * nN, gid = wgid / nig, fm = gid * WGM, gsz = (nM - fm) < WGM ? (nM - fm) : WGM;
        u.pm = fm + ((wgid % nig) % gsz); u.pn = (wgid % nig) / gsz; return true;
    }
    __device__ __forceinline__ void a_ready(const Unit&) const {}
    __device__ __forceinline__ void done(const Unit&) const {}
};

typedef float f32x2c __attribute__((ext_vector_type(2))); typedef __bf16 bf16x2c __attribute__((ext_vector_type(2)));
__device__ __forceinline__ unsigned cvt_pk_bf16(float lo, float hi) { const f32x2c v = {lo, hi}; const bf16x2c b = __builtin_convertvector(v, bf16x2c); return __builtin_bit_cast(unsigned, b); }
typedef float f32x2 __attribute__((ext_vector_type(2)));
typedef unsigned u32x2 __attribute__((ext_vector_type(2)));
__device__ __forceinline__ float bf_lo(unsigned w) { return __uint_as_float(w << 16); }
__device__ __forceinline__ float bf_hi(unsigned w) { return __uint_as_float(w & 0xffff0000u); }
__device__ __forceinline__ float sigm(float v) { return __builtin_amdgcn_rcpf(1.0f + __builtin_amdgcn_exp2f(-1.4426950408889634f * v)); }
__device__ __forceinline__ u32x4 pack8(const f32x4 a, const f32x4 b) { u32x4 w; w.x = cvt_pk_bf16(a[0], a[1]); w.y = cvt_pk_bf16(a[2], a[3]); w.z = cvt_pk_bf16(b[0], b[1]); w.w = cvt_pk_bf16(b[2], b[3]); return w; }

__device__ __forceinline__ float row_rstd(const float* rss, int row) {
    const f32x4* p = (const f32x4*)(rss + (size_t)row * 16); const f32x4 a = p[0], b = p[1], c = p[2], d = p[3];
    const float s = ((a[0] + a[1]) + (a[2] + a[3])) + ((b[0] + b[1]) + (b[2] + b[3])) + ((c[0] + c[1]) + (c[2] + c[3])) + ((d[0] + d[1]) + (d[2] + d[3]));
    return __builtin_amdgcn_rsqf(s * (1.0f / DM) + EPS);
}
__device__ __forceinline__ void rows_rstd(const float* rss, int row0, int fq, float (&rs)[2][4]) {
    f32x4 q[2][4];
#pragma unroll
    for (int ai = 0; ai < 2; ++ai)
#pragma unroll
        for (int m = 0; m < 4; ++m) q[ai][m] = *(const f32x4*)(rss + (size_t)(row0 + ai * HALF + m * 16) * 16 + 4 * fq);
#pragma unroll
    for (int ai = 0; ai < 2; ++ai)
#pragma unroll
        for (int m = 0; m < 4; ++m) { float s = (q[ai][m][0] + q[ai][m][1]) + (q[ai][m][2] + q[ai][m][3]); s += __shfl_xor(s, 16); s += __shfl_xor(s, 32);
            rs[ai][m] = __builtin_amdgcn_rsqf(s * (1.0f / DM) + EPS); }
}
struct EpiIn {
    static constexpr bool PERM = true, AFTER_DRAIN = false;
    bf16_t* P; const float* qna; const float* kna; const float* qnb; const float* knb; const float* tabA; const float* tabB; const float* rss; const float* bias;
    __device__ __forceinline__ void operator()(const f32x4 (&acc)[2][2][4][2], const Unit& u, int wr, int wc, int fr, int fq) const {
        const int pn = u.pn; const int row0 = u.pm * BM + wr * 64 + fr; const int bb = (u.pm * BM) / SEQ;
        if ((DBG_SKIP >> pn) & 1u) return;
        float rs[2][4]; rows_rstd(rss, row0, fq, rs);
        if (pn >= 12) {
            const int col0 = pn * 256 + wc * 32 + 8 * fq;
            f32x4 bv[2][2];
#pragma unroll
            for (int bj = 0; bj < 2; ++bj)
#pragma unroll
                for (int n = 0; n < 2; ++n) bv[bj][n] = *(const f32x4*)(bias + (size_t)bb * NIN + col0 + bj * HALF + 4 * n);
#pragma unroll
            for (int ai = 0; ai < 2; ++ai)
#pragma unroll
                for (int m = 0; m < 4; ++m) { const int row = row0 + ai * HALF + m * 16; bf16_t* rowp = P + (size_t)row * PP + col0; const float rstd = rs[ai][m];
#pragma unroll
                    for (int bj = 0; bj < 2; ++bj) { f32x4 v0 = acc[ai][bj][m][0] * rstd + bv[bj][0], v1 = acc[ai][bj][m][1] * rstd + bv[bj][1];
#pragma unroll
                        for (int j = 0; j < 4; ++j) { v0[j] = sigm(v0[j]); v1[j] = sigm(v1[j]); }
                        *(u32x4*)(rowp + bj * HALF) = pack8(v0, v1); } }
            return;
        }
        int mode, colbase; const float* gn = qna; float scale = 1.f;
        if (pn <= 1) { mode = 0; colbase = (4 * pn + wc) * 64; gn = qna; scale = QK_C2; }
        else if (pn == 2) { colbase = 512 + 64 * wc; if (wc < 2) { mode = 0; gn = kna; } else mode = 2; }
        else { const int g = (pn - 3) / 3, kind = (pn - 3) - 3 * g; colbase = 256 * pn + 64 * wc;
               if (kind == 2) mode = 2; else { mode = 1; gn = (kind == 0 ? qnb : knb) + 64 * g; scale = (kind == 0) ? QK_C2 : 1.f; } }
        const int d0 = (mode == 0) ? (32 * (fq >> 1) + 8 * (fq & 1)) : 8 * fq; const int bjs = (mode == 0) ? 16 : 32;
        f32x4 bz[2][2];
#pragma unroll
        for (int bj = 0; bj < 2; ++bj)
#pragma unroll
            for (int n = 0; n < 2; ++n) bz[bj][n] = *(const f32x4*)(bias + (size_t)bb * NIN + colbase + d0 + bj * bjs + 4 * n);
        if (mode == 2) {
#pragma unroll
            for (int ai = 0; ai < 2; ++ai)
#pragma unroll
                for (int m = 0; m < 4; ++m) { const int row = row0 + ai * HALF + m * 16; bf16_t* rowp = P + (size_t)row * PP + colbase + d0; const float rstd = rs[ai][m];
#pragma unroll
                    for (int bj = 0; bj < 2; ++bj) *(u32x4*)(rowp + bj * bjs) = pack8(acc[ai][bj][m][0] * rstd + bz[bj][0], acc[ai][bj][m][1] * rstd + bz[bj][1]); }
            return;
        }
        f32x4 gw[2][2];
#pragma unroll
        for (int bj = 0; bj < 2; ++bj)
#pragma unroll
            for (int n = 0; n < 2; ++n) gw[bj][n] = *(const f32x4*)(gn + d0 + bj * bjs + 4 * n);
#pragma unroll
        for (int ai = 0; ai < 2; ++ai)
#pragma unroll
            for (int m = 0; m < 4; ++m) {
                const int row = row0 + ai * HALF + m * 16, t = row & (SEQ - 1);
                const float rs0 = rs[ai][m];
                f32x4 zz[2][2];
#pragma unroll
                for (int bj = 0; bj < 2; ++bj)
#pragma unroll
                    for (int n = 0; n < 2; ++n) zz[bj][n] = acc[ai][bj][m][n] * rs0 + bz[bj][n];
                float ss = 0.f;
#pragma unroll
                for (int bj = 0; bj < 2; ++bj)
#pragma unroll
                    for (int n = 0; n < 2; ++n) { const f32x4 x = zz[bj][n]; ss += (x[0] * x[0] + x[1] * x[1]) + (x[2] * x[2] + x[3] * x[3]); }
                ss += __shfl_xor(ss, 16); ss += __shfl_xor(ss, 32);
                const float rstd = __builtin_amdgcn_rsqf(ss * (1.0f / 64.0f) + EPS) ;
                const float* tb = (mode == 0) ? tabA + ((((fq >> 1) ? (t & 63) : (t >> 6)) * 16 + 8 * (fq & 1)) * 2) : tabB + ((t * 32 + 8 * fq) * 2);
                f32x4 cs[4];
#pragma unroll
                for (int i = 0; i < 4; ++i) cs[i] = *(const f32x4*)(tb + 4 * i);
                f32x4 o1[2], o2[2];
#pragma unroll
                for (int n = 0; n < 2; ++n) { const f32x4 y0 = zz[0][n] * rstd * gw[0][n], y1 = zz[1][n] * rstd * gw[1][n];
#pragma unroll
                    for (int j = 0; j < 4; ++j) { const float c = cs[2 * n + (j >> 1)][(j & 1) * 2], s = cs[2 * n + (j >> 1)][(j & 1) * 2 + 1];
                        o1[n][j] = (y0[j] * c - y1[j] * s) * scale; o2[n][j] = (y1[j] * c + y0[j] * s) * scale; } }
                bf16_t* rowp = P + (size_t)row * PP + colbase + d0;
                *(u32x4*)(rowp) = pack8(o1[0], o1[1]); *(u32x4*)(rowp + bjs) = pack8(o2[0], o2[1]);
                if (m & 1) asm volatile("" ::: "memory");
            }
    }
};
template <int PASS> struct EpiBr {
    static constexpr bool PERM = true, AFTER_DRAIN = false;
    bf16_t* MX; const bf16_t* P; int gcol;
    __device__ __forceinline__ void operator()(const f32x4 (&acc)[2][2][4][2], const Unit& u, int wr, int wc, int fr, int fq) const {
        const int row0 = u.pm * BM + wr * 64 + fr, col0 = u.pn * 256 + wc * 32 + 8 * fq;
#pragma unroll
        for (int ai = 0; ai < 2; ++ai)
#pragma unroll
            for (int m = 0; m < 4; ++m) { const size_t row = (size_t)(row0 + ai * HALF + m * 16);
#pragma unroll
                for (int bj = 0; bj < 2; ++bj) { const int c = col0 + bj * HALF;
                    const u32x4 gv = *(const u32x4*)(P + row * PP + gcol + c);
                    f32x4 v0 = acc[ai][bj][m][0], v1 = acc[ai][bj][m][1];
                    v0[0] *= bf_lo(gv.x); v0[1] *= bf_hi(gv.x); v0[2] *= bf_lo(gv.y); v0[3] *= bf_hi(gv.y);
                    v1[0] *= bf_lo(gv.z); v1[1] *= bf_hi(gv.z); v1[2] *= bf_lo(gv.w); v1[3] *= bf_hi(gv.w);
                    if (PASS == 1) { const u32x4 pv = *(const u32x4*)(MX + row * DM + c);
                        v0[0] += bf_lo(pv.x); v0[1] += bf_hi(pv.x); v0[2] += bf_lo(pv.y); v0[3] += bf_hi(pv.y);
                        v1[0] += bf_lo(pv.z); v1[1] += bf_hi(pv.z); v1[2] += bf_lo(pv.w); v1[3] += bf_hi(pv.w); }
                    *(u32x4*)(MX + row * DM + c) = pack8(v0, v1); }
                if (m & 1) asm volatile("" ::: "memory"); }
    }
};
struct EpiRes {
    static constexpr bool PERM = false, AFTER_DRAIN = false;
    const float* base; float* out; const float* gt;
    bf16_t* XS; const float* gs; float* rss; int xpitch;
    __device__ __forceinline__ void operator()(const f32x4 (&acc)[2][2][4][2], const Unit& u, int wr, int wc, int fr, int fq) const {
        const int row0 = u.pm * BM + wr * 64 + fr, col0 = u.pn * 256 + wc * 32 + 4 * fq; const int b = (u.pm * BM) / SEQ;
        f32x4 gv[2][2], gsv[2][2];
#pragma unroll
        for (int bj = 0; bj < 2; ++bj)
#pragma unroll
            for (int n = 0; n < 2; ++n) { gv[bj][n] = *(const f32x4*)(gt + (size_t)b * 6 * DM + col0 + bj * HALF + n * 16);
                gsv[bj][n] = XS ? *(const f32x4*)(gs + (size_t)b * DM + col0 + bj * HALF + n * 16) : (f32x4){0.f, 0.f, 0.f, 0.f}; }
#pragma unroll
        for (int ai = 0; ai < 2; ++ai)
#pragma unroll
            for (int m = 0; m < 4; ++m) { const int row = row0 + ai * HALF + m * 16; const size_t off = (size_t)row * DM + col0; float ss = 0.f;
#pragma unroll
                for (int bj = 0; bj < 2; ++bj)
#pragma unroll
                    for (int n = 0; n < 2; ++n) { const f32x4 bs = *(const f32x4*)(base + off + bj * HALF + n * 16);
                        const f32x4 o = bs + gv[bj][n] * acc[ai][bj][m][n];
                        *(f32x4*)(out + off + bj * HALF + n * 16) = o;
                        if (XS) { ss += (o[0] * o[0] + o[1] * o[1]) + (o[2] * o[2] + o[3] * o[3]); const f32x4 xs = o * gsv[bj][n];
                            u32x2 w; w.x = cvt_pk_bf16(xs[0], xs[1]); w.y = cvt_pk_bf16(xs[2], xs[3]); *(u32x2*)(XS + (size_t)row * xpitch + col0 + bj * HALF + n * 16) = w; } }
                if (XS) { ss += __shfl_xor(ss, 16); ss += __shfl_xor(ss, 32); if (fq == 0) rss[(size_t)row * 16 + u.pn * 4 + wc] = ss; }
                if (m & 1) asm volatile("" ::: "memory"); }
    }
};
struct EpiRelu2 {
    static constexpr bool PERM = true, AFTER_DRAIN = false;
    bf16_t* H; const float* rss; const float* bias;
    __device__ __forceinline__ void operator()(const f32x4 (&acc)[2][2][4][2], const Unit& u, int wr, int wc, int fr, int fq) const {
        const int row0 = u.pm * BM + wr * 64 + fr, col0 = u.pn * 256 + wc * 32 + 8 * fq; const int b = (u.pm * BM) / SEQ;
        float rs[2][4]; rows_rstd(rss, row0, fq, rs);
        f32x4 bv[2][2];
#pragma unroll
        for (int bj = 0; bj < 2; ++bj)
#pragma unroll
            for (int n = 0; n < 2; ++n) bv[bj][n] = *(const f32x4*)(bias + (size_t)b * FF + col0 + bj * HALF + 4 * n);
#pragma unroll
        for (int ai = 0; ai < 2; ++ai)
#pragma unroll
            for (int m = 0; m < 4; ++m) { const int row = row0 + ai * HALF + m * 16; bf16_t* rowp = H + (size_t)row * PP + col0; const float rstd = rs[ai][m];
#pragma unroll
                for (int bj = 0; bj < 2; ++bj) { f32x4 v0 = acc[ai][bj][m][0] * rstd + bv[bj][0], v1 = acc[ai][bj][m][1] * rstd + bv[bj][1];
#pragma unroll
                    for (int j = 0; j < 4; ++j) { const float a = fmaxf(v0[j], 0.f), b = fmaxf(v1[j], 0.f); v0[j] = a * a; v1[j] = b * b; }
                    *(u32x4*)(rowp + bj * HALF) = pack8(v0, v1); } }
    }
};

template <class Epi, class Sched, bool ALIGN_EPI, bool SP2, int KC, int LDA>
__device__ __forceinline__ void gemm_phase(const int tid, PG8_LAS unsigned char* lds, const Gemm g, const Sched& S, const Epi& E) {
    const int wid = __builtin_amdgcn_readfirstlane(tid >> 6), lane = tid & 63, wr = wid >> 2, wc = wid & 3, fr = lane & 15, fq = lane >> 4;
    constexpr int K = KC, nt = K / BK;
    unsigned voffA[2], voffB[2];
#pragma unroll
    for (int i = 0; i < 2; ++i) { int R, C; stage_rc(tid * 16 + i * 8192, R, C); const int Rb = Epi::PERM ? ((R & ~31) + perm32(R & 31)) : R;
        voffA[i] = (unsigned)(R * LDA + C) * 2u; voffB[i] = (unsigned)(Rb * K + C) * 2u; }
    constexpr size_t kstep = (size_t)(BK * 2);
    constexpr size_t hstep = (size_t)HALF * K * 2, hstepA = (size_t)HALF * LDA * 2;
    constexpr size_t tstep = 2 * hstep, tstepA = 2 * hstepA;
    const unsigned ldsw = (unsigned)wid * 1024u;
    const int aoff = lds_byte(wr * 64 + fr, fq * 8), boff = lds_byte(wc * 32 + fr, fq * 8);
#define PG8_SA(b, h) (((b) * 2 + (h)) * HTB)
#define PG8_SB(b, h) ((4 + (b) * 2 + (h)) * HTB)
#define PG8_STAGE(bufoff, gbase, voff) do { _Pragma("unroll") for (int _i = 0; _i < 2; ++_i) \
        __builtin_amdgcn_global_load_lds((const unsigned*)((const char*)(gbase) + (voff)[_i]), (PG8_LAS unsigned*)(lds + (bufoff) + ldsw + _i * 8192), 16, 0, 0); } while (0)
#define PG8_LDA(dst, b, h) do { _Pragma("unroll") for (int m = 0; m < 4; ++m) _Pragma("unroll") for (int k = 0; k < 2; ++k) dst[m][k] = *(const PG8_LAS bf16x8*)(lds + PG8_SA(b, h) + aoff + m * 2048 + k * 1024); } while (0)
#define PG8_LDB(dst, b, h) do { _Pragma("unroll") for (int n = 0; n < 2; ++n) _Pragma("unroll") for (int k = 0; k < 2; ++k) dst[n][k] = *(const PG8_LAS bf16x8*)(lds + PG8_SB(b, h) + boff + n * 2048 + k * 1024); } while (0)
#define PG8_MMA(ai, bj, At, Bt) do { __builtin_amdgcn_s_setprio(1); _Pragma("unroll") for (int m = 0; m < 4; ++m) _Pragma("unroll") for (int n = 0; n < 2; ++n) _Pragma("unroll") for (int k = 0; k < 2; ++k) \
        acc[ai][bj][m][n] = __builtin_amdgcn_mfma_f32_16x16x32_bf16(Bt[n][k], At[m][k], acc[ai][bj][m][n], 0, 0, 0); __builtin_amdgcn_s_setprio(0); } while (0)
#define PG8_WAIT_V(n) asm volatile("s_waitcnt vmcnt(" #n ")" ::: "memory")
#define PG8_WAIT_L(n) asm volatile("s_waitcnt lgkmcnt(" #n ")" ::: "memory")
#define PG8_BAR __builtin_amdgcn_s_barrier()
#define PG8_SCHED __builtin_amdgcn_sched_barrier(0)
    Unit cur, nxt; int ui = 0;
    if (!S.next(0, cur)) return;
    f32x4 acc[2][2][4][2];
#pragma unroll
    for (int a = 0; a < 2; ++a)
#pragma unroll
        for (int b = 0; b < 2; ++b)
#pragma unroll
            for (int m = 0; m < 4; ++m)
#pragma unroll
                for (int n = 0; n < 2; ++n) acc[a][b][m][n] = (f32x4){0.f, 0.f, 0.f, 0.f};
    bf16x8 At[4][2], B0[2][2], B1[2][2];
    const char* cA = (const char*)g.A + (size_t)cur.pm * tstepA; const char* cB = (const char*)g.Bt + (size_t)cur.pn * tstep;
    S.a_ready(cur);
    if constexpr (SP2) {
        PG8_STAGE(PG8_SB(0, 0), cB, voffB); PG8_STAGE(PG8_SB(0, 1), cB + hstep, voffB); PG8_STAGE(PG8_SA(0, 0), cA, voffA); PG8_STAGE(PG8_SA(0, 1), cA + hstepA, voffA);
        if (wr == 1) PG8_BAR;
        PG8_WAIT_V(2); PG8_BAR;
        PG8_STAGE(PG8_SB(1, 0), cB + kstep, voffB); PG8_STAGE(PG8_SA(1, 0), cA + kstep, voffA); PG8_STAGE(PG8_SB(1, 1), cB + hstep + kstep, voffB);
        PG8_WAIT_V(6); PG8_BAR;
    } else {
        PG8_STAGE(PG8_SB(0, 0), cB, voffB); PG8_STAGE(PG8_SA(0, 0), cA, voffA); PG8_STAGE(PG8_SB(0, 1), cB + hstep, voffB); PG8_STAGE(PG8_SA(0, 1), cA + hstepA, voffA);
        if (wr == 1) PG8_BAR;
        PG8_WAIT_V(4); PG8_BAR;
        PG8_STAGE(PG8_SB(1, 0), cB + kstep, voffB); PG8_STAGE(PG8_SA(1, 0), cA + kstep, voffA); PG8_STAGE(PG8_SB(1, 1), cB + hstep + kstep, voffB);
        PG8_WAIT_V(6); PG8_BAR;
    }
    for (;;) {
        const bool has_next = S.next(ui + 1, nxt);
        const char* nA = has_next ? (const char*)g.A + (size_t)nxt.pm * tstepA : cA; const char* nB = has_next ? (const char*)g.Bt + (size_t)nxt.pn * tstep : cB;
#pragma unroll 1
        for (int t = 0; t < nt; t += 2) {
            const bool last = (t == nt - 2);
            const char* a1 = cA + (size_t)(t + 1) * kstep;
            const char* a2 = last ? nA : cA + (size_t)(t + 2) * kstep; const char* b2 = last ? nB : cB + (size_t)(t + 2) * kstep;
            const char* a3 = a2 + kstep; const char* b3 = b2 + kstep;
            if (last && has_next) S.a_ready(nxt);
            if constexpr (SP2) {
            PG8_LDB(B0, 0, 0); PG8_LDB(B1, 0, 1); PG8_SCHED; PG8_LDA(At, 0, 0); PG8_STAGE(PG8_SA(1, 1), a1 + hstepA, voffA);
            PG8_WAIT_V(8); PG8_WAIT_L(0); PG8_BAR; PG8_MMA(0, 0, At, B0); PG8_MMA(0, 1, At, B1); PG8_BAR; PG8_SCHED;
            PG8_LDA(At, 0, 1); PG8_STAGE(PG8_SB(0, 0), b2, voffB); PG8_STAGE(PG8_SB(0, 1), b2 + hstep, voffB); PG8_STAGE(PG8_SA(0, 0), a2, voffA);
            PG8_WAIT_V(8); PG8_WAIT_L(0); PG8_BAR; PG8_MMA(1, 0, At, B0); PG8_MMA(1, 1, At, B1); PG8_BAR; PG8_SCHED;
            PG8_LDB(B0, 1, 0); PG8_LDB(B1, 1, 1); PG8_SCHED; PG8_LDA(At, 1, 0); PG8_STAGE(PG8_SA(0, 1), a2 + hstepA, voffA);
            PG8_WAIT_V(8); PG8_WAIT_L(0); PG8_BAR; PG8_MMA(0, 0, At, B0); PG8_MMA(0, 1, At, B1); PG8_BAR; PG8_SCHED;
            PG8_LDA(At, 1, 1); PG8_STAGE(PG8_SB(1, 0), b3, voffB); PG8_STAGE(PG8_SB(1, 1), b3 + hstep, voffB); PG8_STAGE(PG8_SA(1, 0), a3, voffA);
            PG8_WAIT_V(8); PG8_WAIT_L(0); PG8_BAR; PG8_MMA(1, 0, At, B0); PG8_MMA(1, 1, At, B1); PG8_BAR; PG8_SCHED;
            } else {
            PG8_LDB(B0, 0, 0); PG8_SCHED; PG8_LDA(At, 0, 0); PG8_STAGE(PG8_SA(1, 1), a1 + hstepA, voffA);
            PG8_WAIT_L(8); PG8_BAR; PG8_WAIT_L(0); PG8_MMA(0, 0, At, B0); PG8_BAR; PG8_SCHED;
            PG8_LDB(B1, 0, 1); PG8_STAGE(PG8_SB(0, 0), b2, voffB);
            PG8_BAR; PG8_WAIT_L(0); PG8_MMA(0, 1, At, B1); PG8_BAR;
            PG8_LDA(At, 0, 1); PG8_STAGE(PG8_SA(0, 0), a2, voffA);
            PG8_BAR; PG8_WAIT_L(0); PG8_MMA(1, 0, At, B0); PG8_BAR; PG8_SCHED;
            PG8_STAGE(PG8_SB(0, 1), b2 + hstep, voffB);
            PG8_WAIT_V(6); PG8_BAR; PG8_MMA(1, 1, At, B1); PG8_BAR;
            PG8_LDB(B0, 1, 0); PG8_SCHED; PG8_LDA(At, 1, 0); PG8_STAGE(PG8_SA(0, 1), a2 + hstepA, voffA);
            PG8_WAIT_L(8); PG8_BAR; PG8_WAIT_L(0); PG8_MMA(0, 0, At, B0); PG8_BAR; PG8_SCHED;
            PG8_LDB(B1, 1, 1); PG8_STAGE(PG8_SB(1, 0), b3, voffB);
            PG8_BAR; PG8_WAIT_L(0); PG8_MMA(0, 1, At, B1); PG8_BAR;
            PG8_LDA(At, 1, 1); PG8_STAGE(PG8_SA(1, 0), a3, voffA);
            PG8_BAR; PG8_WAIT_L(0); PG8_MMA(1, 0, At, B0); PG8_BAR; PG8_SCHED;
            PG8_STAGE(PG8_SB(1, 1), b3 + hstep, voffB);
            PG8_WAIT_V(6); PG8_BAR; PG8_MMA(1, 1, At, B1); PG8_BAR;
            }
        }
        if constexpr (ALIGN_EPI) { if (wr == 0) PG8_BAR; }
        if constexpr (!Epi::AFTER_DRAIN) { E(acc, cur, wr, wc, fr, fq); S.done(cur); }
        if (!has_next) break;
#pragma unroll
        for (int a = 0; a < 2; ++a)
#pragma unroll
            for (int b = 0; b < 2; ++b)
#pragma unroll
                for (int m = 0; m < 4; ++m)
#pragma unroll
                    for (int n = 0; n < 2; ++n) acc[a][b][m][n] = (f32x4){0.f, 0.f, 0.f, 0.f};
        cur = nxt; cA = nA; cB = nB; ++ui;
        if constexpr (ALIGN_EPI) { if (wr == 1) PG8_BAR; }
    }
    PG8_WAIT_V(0);
    if constexpr (!ALIGN_EPI) { if (wr == 0) PG8_BAR; }
    PG8_BAR;
    if constexpr (Epi::AFTER_DRAIN) { E.fused(acc, cur, wr, wc, fr, fq, lds, wid, lane); S.done(cur); }
#undef PG8_SA
#undef PG8_SB
#undef PG8_STAGE
#undef PG8_LDA
#undef PG8_LDB
#undef PG8_MMA
#undef PG8_WAIT_V
#undef PG8_WAIT_L
#undef PG8_BAR
#undef PG8_SCHED
}
}
namespace attn_body {
using bf16=__hip_bfloat16;
using bf16x8=__attribute__((ext_vector_type(8)))short;
using s16x4=__attribute__((ext_vector_type(4)))short;
using f32x16=__attribute__((ext_vector_type(16)))float;
using u32x4=__attribute__((ext_vector_type(4)))unsigned;
constexpr int BATCH=8,NHEAD=8,SEQ=4096,D=64,DM=5120;
constexpr int NW=8,QBLK=32,QB=QBLK*NW,KVBLK=64,NQB=SEQ/QB;
constexpr int ATTN_PITCH=DM, ATTN_UNIT_ROWS=QB;
__device__ __forceinline__ int crow(int r,int hi){return (r&3)+8*(r>>2)+4*hi;}
#define SBAR() __builtin_amdgcn_sched_barrier(0)
__device__ __forceinline__ void cmask(f32x16&p0,f32x16&p1,int jb,int qrel,int hi){
  const float NEG=-INFINITY; int kb=64*jb+4*hi;
  #pragma unroll
  for(int r=0;r<16;++r){int kv=kb+(r&3)+8*(r>>2); if(kv>qrel)p0[r]=NEG; if(kv+32>qrel)p1[r]=NEG;}
}

constexpr int NSLOT=3, SLOTB=8192;
constexpr int LDS_K=0, LDS_V=NSLOT*SLOTB, LDS_WS=2*NSLOT*SLOTB, LDS_OST=LDS_WS+NW*64*4, LDS_BYTES=LDS_OST+NW*4096;
constexpr float C2=0.125f*1.4426950408889634f;
__device__ __forceinline__ void glds16(const void*gsrc,unsigned lds_dst){unsigned keep;
  asm volatile("s_mov_b32 %0, m0\n\ts_mov_b32 m0, %2\n\ts_nop 0\n\tglobal_load_lds_dwordx4 %1, off\n\ts_mov_b32 m0, %0":"=&s"(keep):"v"(gsrc),"s"(lds_dst):"memory");}
__device__ __forceinline__ float max3f(float a,float b,float c){float r;asm("v_max3_f32 %0, %1, %2, %3":"=v"(r):"v"(a),"v"(b),"v"(c));return r;}
__device__ __forceinline__ float max2f(float a,float b){float r;asm("v_max_f32_e32 %0, %1, %2":"=v"(r):"v"(a),"v"(b));return r;}
__device__ __forceinline__ float fadd_s(float a,float b){float r;asm("v_add_f32_e32 %0, %1, %2":"=v"(r):"v"(a),"v"(b));return r;}
__device__ __forceinline__ float fsub_s(float a,float b){float r;asm("v_sub_f32_e32 %0, %1, %2":"=v"(r):"v"(a),"v"(b));return r;}
typedef float f32x2_t __attribute__((ext_vector_type(2))); typedef __bf16 bf16x2_t __attribute__((ext_vector_type(2)));
__device__ __forceinline__ unsigned cvtpk_s(float lo,float hi){f32x2_t v={lo,hi};bf16x2_t b=__builtin_convertvector(v,bf16x2_t);return __builtin_bit_cast(unsigned,b);}
#define WAIT_BAR(N) asm volatile("s_waitcnt vmcnt(" #N ") lgkmcnt(0)\n\ts_barrier":::"memory")

__device__ __forceinline__ void qkt(f32x16&p0,f32x16&p1,const char*Kslot,const bf16x8*qr,const f32x16&negm,int r32,int hi){
  const char*kb=Kslot+hi*1024+r32*16;
  #pragma unroll
  for(int d0=0;d0<4;++d0){
    const bf16x8 b0=*reinterpret_cast<const bf16x8*>(kb+d0*2048);
    const bf16x8 b1=*reinterpret_cast<const bf16x8*>(kb+d0*2048+512);
    if(d0==0){p0=__builtin_amdgcn_mfma_f32_32x32x16_bf16(b0,qr[0],negm,0,0,0);p1=__builtin_amdgcn_mfma_f32_32x32x16_bf16(b1,qr[0],negm,0,0,0);}
    else{p0=__builtin_amdgcn_mfma_f32_32x32x16_bf16(b0,qr[d0],p0,0,0,0);p1=__builtin_amdgcn_mfma_f32_32x32x16_bf16(b1,qr[d0],p1,0,0,0);}}
}
typedef __attribute__((address_space(3))) const char* lds_cptr;
typedef short v4i16_t __attribute__((ext_vector_type(4)));
__device__ __forceinline__ void kload8(bf16x8*kf,lds_cptr kp){
  kf[0]=*(const __attribute__((address_space(3))) bf16x8*)(kp);      kf[1]=*(const __attribute__((address_space(3))) bf16x8*)(kp+512);
  kf[2]=*(const __attribute__((address_space(3))) bf16x8*)(kp+2048); kf[3]=*(const __attribute__((address_space(3))) bf16x8*)(kp+2560);
  kf[4]=*(const __attribute__((address_space(3))) bf16x8*)(kp+4096); kf[5]=*(const __attribute__((address_space(3))) bf16x8*)(kp+4608);
  kf[6]=*(const __attribute__((address_space(3))) bf16x8*)(kp+6144); kf[7]=*(const __attribute__((address_space(3))) bf16x8*)(kp+6656);
}
__device__ __forceinline__ void kload2(bf16x8*kf,lds_cptr kp,int j){ kf[2*j]=*(const __attribute__((address_space(3))) bf16x8*)(kp+j*2048); kf[2*j+1]=*(const __attribute__((address_space(3))) bf16x8*)(kp+j*2048+512); }
__device__ __forceinline__ s16x4 vtr(lds_cptr p){ return __builtin_bit_cast(s16x4,__builtin_amdgcn_ds_read_tr16_b64_v4i16((__attribute__((address_space(3))) v4i16_t*)p)); }
__device__ __forceinline__ float rowmax(const f32x16&p0,const f32x16&p1){
  float a=max3f(p0[0],p0[1],p1[0]),b=max3f(p0[2],p0[3],p1[1]);a=max3f(a,p1[2],p1[3]);
  #pragma unroll
  for(int r=4;r<16;r+=4){a=max3f(a,p0[r],p0[r+1]);b=max3f(b,p0[r+2],p0[r+3]);a=max3f(a,p1[r],p1[r+1]);b=max3f(b,p1[r+2],p1[r+3]);}
  const float m=max2f(a,b);
  auto rr=__builtin_amdgcn_permlane32_swap(__float_as_uint(m),__float_as_uint(m),false,false);
  return max2f(__uint_as_float(rr[0]),__uint_as_float(rr[1]));
}
__device__ __forceinline__ void pv(f32x16*o,int vb,bf16x8 pa0,bf16x8 pa1,bf16x8 pa2,bf16x8 pa3){
  #pragma unroll
  for(int d0=0;d0<2;++d0){s16x4 lo[4],hi[4];
    #pragma unroll
    for(int ks=0;ks<4;++ks){
      asm volatile("ds_read_b64_tr_b16 %0,%1 offset:%c2":"=&v"(lo[ks]):"v"(vb),"i"(d0*4096+ks*1024):"memory");
      asm volatile("ds_read_b64_tr_b16 %0,%1 offset:%c2":"=&v"(hi[ks]):"v"(vb),"i"(d0*4096+ks*1024+512):"memory");}
    asm volatile("s_waitcnt lgkmcnt(0)":::"memory");SBAR();
    #define PK(k) (bf16x8){lo[k][0],lo[k][1],lo[k][2],lo[k][3],hi[k][0],hi[k][1],hi[k][2],hi[k][3]}
    o[d0]=__builtin_amdgcn_mfma_f32_32x32x16_bf16(pa0,PK(0),o[d0],0,0,0);
    o[d0]=__builtin_amdgcn_mfma_f32_32x32x16_bf16(pa1,PK(1),o[d0],0,0,0);
    o[d0]=__builtin_amdgcn_mfma_f32_32x32x16_bf16(pa2,PK(2),o[d0],0,0,0);
    o[d0]=__builtin_amdgcn_mfma_f32_32x32x16_bf16(pa3,PK(3),o[d0],0,0,0);
    #undef PK
  }
}

#ifndef ATTN_STORE16
#define ATTN_STORE16(p,v) (*(u32x4*)(p)=(v))
#endif
template<int THRL> __device__ __forceinline__ void attn_unit(int b,int h,int qb,const bf16*Q,const bf16*__restrict__ K,const bf16*__restrict__ V,bf16*O,char*shm,const int tid){
  const int lane=tid&63,r32=lane&31,hi=lane>>5; const int wid=__builtin_amdgcn_readfirstlane(tid>>6);
  const long rowbase=(long)b*SEQ; const int q0=qb*QB;
  const bf16*Qw=Q+(rowbase+q0+wid*QBLK)*DM+h*D;
  const bf16*Kh=K+rowbase*DM+(h>>2)*D,*Vh=V+rowbase*DM+(h>>2)*D;
  const unsigned lds0=(unsigned)(uintptr_t)shm;
  float*wsf=(float*)(shm+LDS_WS)+wid*64;
  const bf16*ksrc=Kh+(long)lane*DM+wid*8;
  const bf16*vsrc=Vh+(long)(16*(wid&3)+(lane>>2))*DM+(wid>>2)*32+(lane&3)*8;
  const unsigned kdst=lds0+LDS_K+wid*1024, vdst=lds0+LDS_V+wid*1024;
  #define DMA_K(t,slot) glds16(ksrc+(long)(t)*KVBLK*DM,(unsigned)__builtin_amdgcn_readfirstlane(kdst+(slot)))
  #define DMA_V(t,slot) glds16(vsrc+(long)(t)*KVBLK*DM,(unsigned)__builtin_amdgcn_readfirstlane(vdst+(slot)))
  const int vb0=(int)(lds0+LDS_V)+((lane>>4)&1)*32+(lane&3)*8+(4*hi+((lane&15)>>2))*64;
  const char*Kbase=shm+LDS_K; bf16x8 kf[8];
  const lds_cptr shm3=(lds_cptr)shm; const lds_cptr kp0=shm3+LDS_K+hi*1024+r32*16; const lds_cptr vp0=shm3+LDS_V+((lane>>4)&1)*32+(lane&3)*8+(4*hi+((lane&15)>>2))*64;
  const int NT=SEQ/KVBLK;
  DMA_K(0,0);DMA_V(0,0);DMA_K(1,SLOTB);
  bf16x8 qr[4];
  #pragma unroll
  for(int d0=0;d0<4;++d0)qr[d0]=*reinterpret_cast<const bf16x8*>(&Qw[(long)r32*DM+d0*16+hi*8]);
  float mhat=0.f,l_reg=0.f;f32x16 o[2];o[0]=f32x16{};o[1]=f32x16{};f32x16 negm=f32x16{};asm volatile("":"+v"(negm));
  const int qrel=wid*QBLK+r32;
  #define CMASK(P0,P1,t) do{}while(0)
  bool resc=false;
  #define START(P0,P1) do{ const float rm=rowmax(P0,P1); resc=false; \
    { const float dl=rm; mhat=fadd_s(mhat,dl); \
      _Pragma("unroll") for(int r=0;r<16;++r){P0[r]=fsub_s(P0[r],dl);P1[r]=fsub_s(P1[r],dl);} \
      _Pragma("unroll") for(int r=0;r<16;++r)negm[r]=-mhat; asm volatile("":"+v"(negm)); } \
    _Pragma("unroll") for(int r=0;r<16;++r)P0[r]=__builtin_amdgcn_exp2f(P0[r]); }while(0)
  #define RESC() do{ if(resc){ asm volatile("s_waitcnt lgkmcnt(0)":::"memory"); \
      _Pragma("unroll") for(int d_=0;d_<2;++d_) _Pragma("unroll") for(int r=0;r<16;++r)o[d_][r]*=wsf[crow(r,hi)]; } }while(0)
  f32x16 pA0,pA1,pB0,pB1;
  int sl_prev=0,sl_cur=0,sl_next=SLOTB;
  #define ROT() do{sl_prev=sl_cur;sl_cur=sl_next;sl_next=(sl_next==(NSLOT-1)*SLOTB)?0:sl_next+SLOTB;}while(0)
  DMA_K(2,2*SLOTB);
  WAIT_BAR(3);
  qkt(pA0,pA1,Kbase,qr,negm,r32,hi);asm volatile("s_nop 15\n\ts_nop 7":"+v"(pA0),"+v"(pA1));CMASK(pA0,pA1,0);
  START(pA0,pA1);
  _Pragma("unroll") for(int r=0;r<16;++r)pA1[r]=__builtin_amdgcn_exp2f(pA1[r]);
  WAIT_BAR(0);
  DMA_K(3,0);DMA_V(1,SLOTB);
  ROT();
  kload8(kf,kp0+sl_cur);
  WAIT_BAR(2);
  s16x4 vlo[8],vhi[8]; u32x4 pw0,pw1,pw2,pw3;
  #define PKW(P,B) cvtpk_s(P[B],P[B+1])
  #define PAF(k) __builtin_bit_cast(bf16x8,pw##k)
  #define VFR(i) (bf16x8){vlo[i][0],vlo[i][1],vlo[i][2],vlo[i][3],vhi[i][0],vhi[i][1],vhi[i][2],vhi[i][3]}
  #define PIN(x) asm volatile("":"+v"(x))
  #define MX3(a,b,c) __builtin_fmaxf(__builtin_fmaxf((a),(b)),(c))
  #define GAPA(MF,A0,A1,A2,A3,W0,W1,PW) do{ MF; sacc+=A0; sacc+=A1; sacc+=A2; sacc+=A3; PIN(sacc); W0; W1; PIN(PW); SBAR(); }while(0)
  #define EX(v) __builtin_amdgcn_exp2f(v)
  #define GAPB(MF,X,B) do{ MF; X[B]=EX(X[B]); X[B+1]=EX(X[B+1]); X[B+2]=EX(X[B+2]); X[B+3]=EX(X[B+3]); PIN(X); SBAR(); }while(0)
  #define VRD(i) do{ vlo[i]=vtr(vp_+(((i)>>2)*4096+((i)&3)*1024)); vhi[i]=vtr(vp_+(((i)>>2)*4096+((i)&3)*1024+512)); }while(0)
  #define KRD(G,j) do{ if(G){ kload2(kf,kp0+sl_next,j); SBAR(); } }while(0)
  #define STEP(C0,C1,P0,P1,t,GK,GV,GL) do{ SBAR(); \
    const lds_cptr vp_=vp0+sl_prev; \
    VRD(0); SBAR(); float sacc=(P0[0]+P0[1]); \
    GAPA(C0=__builtin_amdgcn_mfma_f32_32x32x16_bf16(kf[0],qr[0],negm,0,0,0), P0[2],P0[3],P0[4],P0[5],     pw0[0]=PKW(P0,0), pw0[1]=PKW(P0,2), pw0); \
    VRD(4); SBAR(); GAPA(C1=__builtin_amdgcn_mfma_f32_32x32x16_bf16(kf[1],qr[0],negm,0,0,0), P0[6],P0[7],P0[8],P0[9],     pw0[2]=PKW(P0,4), pw0[3]=PKW(P0,6), pw0); \
    VRD(1); SBAR(); GAPA(C0=__builtin_amdgcn_mfma_f32_32x32x16_bf16(kf[2],qr[1],C0,0,0,0),   P0[10],P0[11],P0[12],P0[13], pw1[0]=PKW(P0,8), pw1[1]=PKW(P0,10), pw1); \
    VRD(5); SBAR(); GAPA(C1=__builtin_amdgcn_mfma_f32_32x32x16_bf16(kf[3],qr[1],C1,0,0,0),   P0[14],P0[15],P1[0],P1[1],   pw1[2]=PKW(P0,12),pw1[3]=PKW(P0,14), pw1); \
    VRD(2); SBAR(); GAPA(C0=__builtin_amdgcn_mfma_f32_32x32x16_bf16(kf[4],qr[2],C0,0,0,0),   P1[2],P1[3],P1[4],P1[5],     pw2[0]=PKW(P1,0), pw2[1]=PKW(P1,2), pw2); \
    VRD(6); SBAR(); GAPA(C1=__builtin_amdgcn_mfma_f32_32x32x16_bf16(kf[5],qr[2],C1,0,0,0),   P1[6],P1[7],P1[8],P1[9],     pw2[2]=PKW(P1,4), pw2[3]=PKW(P1,6), pw2); \
    VRD(3); SBAR(); GAPA(C0=__builtin_amdgcn_mfma_f32_32x32x16_bf16(kf[6],qr[3],C0,0,0,0),   P1[10],P1[11],P1[12],P1[13], pw3[0]=PKW(P1,8), pw3[1]=PKW(P1,10), pw3); \
    VRD(7); SBAR(); GAPA(C1=__builtin_amdgcn_mfma_f32_32x32x16_bf16(kf[7],qr[3],C1,0,0,0),   P1[14],P1[15],0.f,0.f,       pw3[2]=PKW(P1,12),pw3[3]=PKW(P1,14), pw3); \
    l_reg+=sacc; \
    if(GK){DMA_K((t)+3,sl_cur);} if(GV){DMA_V((t)+1,sl_next);} \
    CMASK(C0,C1,t); \
    { float a=MX3(C0[0],C0[1],C1[0]),b=MX3(C0[2],C0[3],C1[1]); a=MX3(a,C1[2],C1[3]); \
      _Pragma("unroll") for(int r=4;r<16;r+=4){a=MX3(a,C0[r],C0[r+1]);b=MX3(b,C0[r+2],C0[r+3]);a=MX3(a,C1[r],C1[r+1]);b=MX3(b,C1[r+2],C1[r+3]);} \
      float rm=__builtin_fmaxf(a,b); { auto rr=__builtin_amdgcn_permlane32_swap(__float_as_uint(rm),__float_as_uint(rm),false,false); rm=__builtin_fmaxf(__uint_as_float(rr[0]),__uint_as_float(rr[1])); } \
      resc=false; \
      if(__builtin_expect(__any(rm>(float)THRL),0)){ const float dl=__builtin_fmaxf(rm,0.f); mhat+=dl; \
        _Pragma("unroll") for(int r=0;r<16;++r){C0[r]-=dl;C1[r]-=dl;} \
        _Pragma("unroll") for(int r=0;r<16;++r)negm[r]=-mhat; asm volatile("":"+v"(negm)); \
        const float f=__builtin_amdgcn_exp2f(-dl); l_reg*=f; if(hi==0)wsf[r32]=f; resc=true; } } \
    SBAR(); \
    GAPB(o[0]=__builtin_amdgcn_mfma_f32_32x32x16_bf16(PAF(0),VFR(0),o[0],0,0,0), C0,0); \
    GAPB(o[1]=__builtin_amdgcn_mfma_f32_32x32x16_bf16(PAF(0),VFR(4),o[1],0,0,0), C0,4); \
    KRD(GL,0); GAPB(o[0]=__builtin_amdgcn_mfma_f32_32x32x16_bf16(PAF(1),VFR(1),o[0],0,0,0), C0,8); \
    KRD(GL,1); GAPB(o[1]=__builtin_amdgcn_mfma_f32_32x32x16_bf16(PAF(1),VFR(5),o[1],0,0,0), C0,12); \
    KRD(GL,2); GAPB(o[0]=__builtin_amdgcn_mfma_f32_32x32x16_bf16(PAF(2),VFR(2),o[0],0,0,0), C1,0); \
    KRD(GL,3); GAPB(o[1]=__builtin_amdgcn_mfma_f32_32x32x16_bf16(PAF(2),VFR(6),o[1],0,0,0), C1,4); \
    GAPB(o[0]=__builtin_amdgcn_mfma_f32_32x32x16_bf16(PAF(3),VFR(3),o[0],0,0,0), C1,8); \
    GAPB(o[1]=__builtin_amdgcn_mfma_f32_32x32x16_bf16(PAF(3),VFR(7),o[1],0,0,0), C1,12); \
    }while(0)
  int t=1;
  #undef CMASK
  #define CMASK(P0,P1,t) do{}while(0)
  for(;t+5<NT;t+=2){
    STEP(pB0,pB1,pA0,pA1,t,true,true,true);     WAIT_BAR(2); RESC(); ROT();
    STEP(pA0,pA1,pB0,pB1,t+1,true,true,true);   WAIT_BAR(2); RESC(); ROT();
  }
  #undef CMASK
  #define CMASK(P0,P1,t) do{}while(0)
  #define ENDW(tt) do{ if((tt)+3<NT){WAIT_BAR(2);} else if((tt)+2<NT){WAIT_BAR(1);} else {WAIT_BAR(0);} }while(0)
  for(;t+1<NT;t+=2){
    STEP(pB0,pB1,pA0,pA1,t,(t+3<NT),(t+1<NT),(t+1<NT));       ENDW(t);   RESC(); ROT();
    STEP(pA0,pA1,pB0,pB1,t+1,(t+4<NT),(t+2<NT),(t+2<NT));     ENDW(t+1); RESC(); ROT();
  }
  STEP(pB0,pB1,pA0,pA1,NT-1,false,false,false); RESC();
  { float sacc=pB0[0]+pB0[1]; _Pragma("unroll") for(int r=2;r<16;++r)sacc+=pB0[r]; _Pragma("unroll") for(int r=0;r<16;++r)sacc+=pB1[r]; l_reg+=sacc;
    pw0=(u32x4){PKW(pB0,0),PKW(pB0,2),PKW(pB0,4),PKW(pB0,6)};pw1=(u32x4){PKW(pB0,8),PKW(pB0,10),PKW(pB0,12),PKW(pB0,14)};pw2=(u32x4){PKW(pB1,0),PKW(pB1,2),PKW(pB1,4),PKW(pB1,6)};pw3=(u32x4){PKW(pB1,8),PKW(pB1,10),PKW(pB1,12),PKW(pB1,14)};
    SBAR(); pv(o,vb0+sl_cur,PAF(0),PAF(1),PAF(2),PAF(3)); }
  #undef PKW
  #undef PAF
  #undef VFR
  #undef PIN
  #undef MX3
  #undef GAPA
  #undef GAPB
  #undef EX
  #undef VRD
  #undef KRD
  #undef STEP
  #undef ENDW
  {auto rr=__builtin_amdgcn_permlane32_swap(__float_as_uint(l_reg),__float_as_uint(l_reg),false,false);l_reg=__uint_as_float(rr[0])+__uint_as_float(rr[1]);}
  if(hi==0)wsf[32+r32]=l_reg;asm volatile("s_waitcnt lgkmcnt(0)":::"memory");
  float rli[16];
  #pragma unroll
  for(int r=0;r<16;++r)rli[r]=__builtin_amdgcn_rcpf(wsf[32+crow(r,hi)]);
  bf16*Ow=O+(rowbase+q0+wid*QBLK)*DM+h*D;
  { bf16*stg=(bf16*)(shm+LDS_OST)+wid*2048;
    #pragma unroll
    for(int r=0;r<16;++r){const int orow=crow(r,hi);
      #pragma unroll
      for(int d0=0;d0<2;++d0)stg[orow*64+d0*32+r32]=__float2bfloat16(o[d0][r]*rli[r]);}
    asm volatile("s_waitcnt lgkmcnt(0)":::"memory");
    #pragma unroll
    for(int i=0;i<4;++i){const int row=i*8+(lane>>3),ch=lane&7; const u32x4 v=*(const u32x4*)(stg+row*64+ch*8); ATTN_STORE16(Ow+(long)row*DM+ch*8,v);} }
  asm volatile("s_waitcnt lgkmcnt(0)\n\ts_barrier":::"memory");
  #undef DMA_K
  #undef DMA_V
  #undef CMASK
  #undef START
  #undef RESC
  #undef ROT
}
constexpr int ATTN_LDS_BYTES=LDS_BYTES;
#undef SBAR
#undef WAIT_BAR
}
namespace dil {
#define DLAS __attribute__((address_space(3)))
typedef unsigned short bf16_t;
typedef short bf16x8 __attribute__((ext_vector_type(8)));
typedef short s16x4 __attribute__((ext_vector_type(4)));
typedef float f32x16 __attribute__((ext_vector_type(16)));
typedef unsigned u32x4 __attribute__((ext_vector_type(4)));
constexpr int ROWB = 144;
constexpr int WAVE_LDS = 32 * ROWB + 256;
__device__ __forceinline__ int crow(int r, int hi) { return (r & 3) + 8 * (r >> 2) + 4 * hi; }
typedef float f32x2d __attribute__((ext_vector_type(2))); typedef __bf16 bf16x2d __attribute__((ext_vector_type(2)));
__device__ __forceinline__ unsigned cvtpk(float lo, float hi) { const f32x2d v = {lo, hi}; const bf16x2d b = __builtin_convertvector(v, bf16x2d); return __builtin_bit_cast(unsigned, b); }
__device__ __forceinline__ int clampi(int v) { return v < 0 ? 0 : (v > SEQ - 1 ? SEQ - 1 : v); }

__device__ __forceinline__ void load_tile(const bf16_t* Pb, int base, int dg, int m0, int kcol, int vcol, int lane, bf16x8 (&kf)[4], u32x4 (&vr)[4], bool doK, bool doV) {
    const int r32 = lane & 31, hi = lane >> 5;
    const int tk = clampi(base + dg * (m0 + r32));
    const bf16_t* kp = Pb + (size_t)tk * PP + kcol + 8 * hi;
    if (doK) {
#pragma unroll
    for (int d0 = 0; d0 < 4; ++d0) kf[d0] = *(const bf16x8*)(kp + 16 * d0); }
    if (doV)
#pragma unroll
    for (int c = 0; c < 4; ++c) { const int tv = clampi(base + dg * (m0 + 8 * c + (lane >> 3)));
        vr[c] = *(const u32x4*)(Pb + (size_t)tv * PP + vcol + 8 * (lane & 7)); }
}

__device__ __forceinline__ void dil_group(const bf16_t* Pb, int base, int qstride, int dg, int rho, int ntile, int qcol, DLAS unsigned char* wl, DLAS float* sc, int lane, int vaddr,
                                          float& m_run, float& l_run, f32x16& o0, f32x16& o1) {
    const int r32 = lane & 31, hi = lane >> 5; const int kcol = qcol + 256, vcol = qcol + 512;
    bf16x8 qf[4];
    { const bf16_t* qp = Pb + (size_t)(base + qstride * r32) * PP + qcol + 8 * hi;
#pragma unroll
      for (int d0 = 0; d0 < 4; ++d0) qf[d0] = *(const bf16x8*)(qp + 16 * d0); }
    bf16x8 kf[4], kn[4]; u32x4 vr[4];
    load_tile(Pb, base, dg, -64, kcol, vcol, lane, kf, vr, true, false);
    for (int T = 0; T < ntile; ++T) {
        const int m0 = -64 + 32 * T;
        load_tile(Pb, base, dg, m0, kcol, vcol, lane, kn, vr, false, true);
        if (T + 1 < ntile) load_tile(Pb, base, dg, m0 + 32, kcol, vcol, lane, kn, vr, true, false);
        f32x16 p = {};
#pragma unroll
        for (int d0 = 0; d0 < 4; ++d0) p = __builtin_amdgcn_mfma_f32_32x32x16_bf16(kf[d0], qf[d0], p, 0, 0, 0);
#pragma unroll
        for (int c = 0; c < 4; ++c) *(DLAS u32x4*)(wl + (8 * c + (lane >> 3)) * ROWB + (lane & 7) * 16) = vr[c];
        float mx = -1e30f;
        const int dmh = m0 + 64 - rho * r32 + 4 * hi;
        const int tokh = base + dg * (m0 + 4 * hi);
#pragma unroll
        for (int r = 0; r < 16; ++r) { const int cr = (r & 3) + 8 * (r >> 2);
            p[r] = (((unsigned)(dmh + cr) <= 128u) && ((unsigned)(tokh + dg * cr) < (unsigned)SEQ)) ? p[r] : -1e30f; mx = fmaxf(mx, p[r]); }
        mx = fmaxf(mx, __shfl_xor(mx, 32));
        const float m_new = fmaxf(m_run, mx), alpha = __builtin_amdgcn_exp2f(m_run - m_new); m_run = m_new;
        float psum = 0.f;
#pragma unroll
        for (int r = 0; r < 16; ++r) { const float e = (p[r] > -1e29f) ? __builtin_amdgcn_exp2f(p[r] - m_new) : 0.f; p[r] = e; psum += e; }
        l_run = l_run * alpha + psum;
        if (!__all(alpha == 1.0f)) {
            if (hi == 0) sc[r32] = alpha;
#pragma unroll
            for (int r = 0; r < 16; ++r) { const float a = sc[crow(r, hi)]; o0[r] *= a; o1[r] *= a; }
        }
        u32x4 pk0, pk1;
        pk0.x = cvtpk(p[0], p[1]); pk0.y = cvtpk(p[2], p[3]); pk0.z = cvtpk(p[4], p[5]); pk0.w = cvtpk(p[6], p[7]);
        pk1.x = cvtpk(p[8], p[9]); pk1.y = cvtpk(p[10], p[11]); pk1.z = cvtpk(p[12], p[13]); pk1.w = cvtpk(p[14], p[15]);
        const bf16x8 pa0 = __builtin_bit_cast(bf16x8, pk0), pa1 = __builtin_bit_cast(bf16x8, pk1);
#pragma unroll
        for (int s = 0; s < 2; ++s) {
#pragma unroll
            for (int d0 = 0; d0 < 2; ++d0) {
                DLAS unsigned char* va = wl + vaddr + (16 * s + 4 * hi) * ROWB + d0 * 64;
                const s16x4 lo = __builtin_bit_cast(s16x4, __builtin_amdgcn_ds_read_tr16_b64_v4i16((DLAS s16x4*)va));
                const s16x4 hh = __builtin_bit_cast(s16x4, __builtin_amdgcn_ds_read_tr16_b64_v4i16((DLAS s16x4*)(va + 8 * ROWB)));
                const bf16x8 vf = (bf16x8){lo[0], lo[1], lo[2], lo[3], hh[0], hh[1], hh[2], hh[3]};
                if (d0 == 0) o0 = __builtin_amdgcn_mfma_f32_32x32x16_bf16(s == 0 ? pa0 : pa1, vf, o0, 0, 0, 0);
                else         o1 = __builtin_amdgcn_mfma_f32_32x32x16_bf16(s == 0 ? pa0 : pa1, vf, o1, 0, 0, 0);
            }
        }
#pragma unroll
        for (int i = 0; i < 4; ++i) kf[i] = kn[i];
    }
}
__device__ __forceinline__ void dil_pass1(bf16_t* P, int grp, int j, DLAS unsigned char* wl, int lane, float* SO, float* SM, float* SL) {
    const int r32 = lane & 31, hi = lane >> 5; const int b = grp >> 5, h = (grp >> 3) & 3, blk = grp & 7; const int base = 512 * blk + 32 * j;
    const bf16_t* Pb = P + (size_t)b * SEQ * PP; DLAS float* sc = (DLAS float*)(wl + 32 * ROWB);
    const int vaddr = ((lane & 15) >> 2) * ROWB + (((lane >> 4) & 1) * 16 + (lane & 3) * 4) * 2;
    float m_run = -1e30f, l_run = 0.f; f32x16 o0 = {}, o1 = {};
    dil_group(Pb, base, 1, 1, 1, 5, C_B0 + 64 * h, wl, sc, lane, vaddr, m_run, l_run, o0, o1);
    l_run += __shfl_xor(l_run, 32);
    const size_t srow = (size_t)h * SEQ + base; SO += (size_t)b * 2097152; SM += (size_t)b * 2097152; SL += (size_t)b * 2097152;
    if (hi == 0) { SM[srow + r32] = m_run; SL[srow + r32] = l_run; }
#pragma unroll
    for (int r = 0; r < 16; ++r) { float* so = SO + (srow + crow(r, hi)) * 64 + r32; so[0] = o0[r]; so[32] = o1[r]; }
}
__device__ __forceinline__ void dil_pass2(bf16_t* P, int grp, int rr, DLAS unsigned char* wl, int lane, const float* SO, const float* SM, const float* SL) {
    const int r32 = lane & 31, hi = lane >> 5; const int b = grp >> 5, h = (grp >> 3) & 3, blk = grp & 7; const int base = 512 * blk + rr;
    bf16_t* Pb = P + (size_t)b * SEQ * PP; DLAS float* sc = (DLAS float*)(wl + 32 * ROWB);
    const int vaddr = ((lane & 15) >> 2) * ROWB + (((lane >> 4) & 1) * 16 + (lane & 3) * 4) * 2;
    const size_t srow = (size_t)h * SEQ + base; SO += (size_t)b * 2097152; SM += (size_t)b * 2097152; SL += (size_t)b * 2097152;
    float m_run = SM[srow + 16 * r32], l_run = (hi == 0) ? SL[srow + 16 * r32] : 0.f; f32x16 o0, o1;
#pragma unroll
    for (int r = 0; r < 16; ++r) { const float* so = SO + (srow + 16 * crow(r, hi)) * 64 + r32; o0[r] = so[0]; o1[r] = so[32]; }
#pragma unroll 1
    for (int g = 1; g <= 2; ++g) dil_group(Pb, base, 16, 1 << (2 * g), 16 >> (2 * g), g == 1 ? 8 : 5, C_B0 + 768 * g + 64 * h, wl, sc, lane, vaddr, m_run, l_run, o0, o1);
    l_run += __shfl_xor(l_run, 32);
    if (hi == 0) sc[32 + r32] = __builtin_amdgcn_rcpf(l_run);
    bf16_t* op = Pb + (size_t)base * PP + C_OB + 64 * h + r32;
#pragma unroll
    for (int r = 0; r < 16; ++r) { const int q = crow(r, hi); const float inv = sc[32 + q];
        const __hip_bfloat16 a = __float2bfloat16(o0[r] * inv), c = __float2bfloat16(o1[r] * inv);
        op[(size_t)(16 * q) * PP] = __builtin_bit_cast(unsigned short, a); op[(size_t)(16 * q) * PP + 32] = __builtin_bit_cast(unsigned short, c); }
}
}


namespace naive {
__device__ __forceinline__ float bf2f(unsigned short v) { return __uint_as_float((unsigned)v << 16); }
__device__ __forceinline__ float wmax(float v) {
#pragma unroll
    for (int o = 1; o < 64; o <<= 1) v = fmaxf(v, __shfl_xor(v, o));
    return v;
}
__device__ __forceinline__ float wsum(float v) {
#pragma unroll
    for (int o = 1; o < 64; o <<= 1) v += __shfl_xor(v, o);
    return v;
}
__device__ __forceinline__ void dense_task(unsigned short* P, int task, __attribute__((address_space(3))) float* qs, int lane) {
    const int m = task >> 3, hq = task & 7, b = m >> 12;
    unsigned short* prow = P + (size_t)m * PP + C_QA + 64 * hq;
    qs[lane] = bf2f(prow[lane]);
    const unsigned short* kb = P + (size_t)b * SEQ * PP + C_KA + 64 * (hq >> 2);
    const unsigned short* vb = P + (size_t)b * SEQ * PP + C_VA + 64 * (hq >> 2);
    float m_run = -1e30f, l = 0.f, o = 0.f;
    for (int kc = 0; kc < SEQ / 64; ++kc) {
        const unsigned short* kr = kb + (size_t)(kc * 64 + lane) * PP;
        float s = 0.f;
#pragma unroll 8
        for (int d = 0; d < 64; ++d) s += qs[d] * bf2f(kr[d]);
        const float m_new = fmaxf(m_run, wmax(s)), alpha = __builtin_amdgcn_exp2f(m_run - m_new), p = __builtin_amdgcn_exp2f(s - m_new);
        m_run = m_new; l = l * alpha + wsum(p); o *= alpha;
        for (int j = 0; j < 64; ++j) o += __shfl(p, j) * bf2f(vb[(size_t)(kc * 64 + j) * PP + lane]);
    }
    const __hip_bfloat16 r = __float2bfloat16(o / l);
    prow[lane] = __builtin_bit_cast(unsigned short, r);
}
__device__ __forceinline__ void dil_task(unsigned short* P, int task, __attribute__((address_space(3))) float* qs, int lane) {
    const int m = task >> 2, h = task & 3, b = m >> 12, t = m & (SEQ - 1);
    const unsigned short* Pb = P + (size_t)b * SEQ * PP;
    float m_run = -1e30f, l = 0.f, o = 0.f;
    for (int g = 0; g < 3; ++g) {
        const int dg = 1 << (2 * g); const int qcol = C_B0 + 768 * g + 64 * h, kcol = qcol + 256, vcol = qcol + 512;
        qs[lane] = bf2f(Pb[(size_t)t * PP + qcol + lane]);
        for (int c = 0; c < 3; ++c) {
            const int j = -64 + 64 * c + lane, tok = t + dg * j; const bool valid = (j <= 64) && (tok >= 0) && (tok < SEQ);
            const unsigned short* kr = Pb + (size_t)(valid ? tok : t) * PP + kcol;
            float s = 0.f;
#pragma unroll 8
            for (int d = 0; d < 64; ++d) s += qs[d] * bf2f(kr[d]);
            s = valid ? s : -1e30f;
            const float m_new = fmaxf(m_run, wmax(s)), alpha = __builtin_amdgcn_exp2f(m_run - m_new), p = valid ? __builtin_amdgcn_exp2f(s - m_new) : 0.f;
            m_run = m_new; l = l * alpha + wsum(p); o *= alpha;
            for (int jj = 0; jj < 64; ++jj) { int tk = t + dg * (-64 + 64 * c + jj); tk = tk < 0 ? 0 : (tk > SEQ - 1 ? SEQ - 1 : tk);
                o += __shfl(p, jj) * bf2f(Pb[(size_t)tk * PP + vcol + lane]); }
        }
    }
    const __hip_bfloat16 r = __float2bfloat16(o / l);
    P[(size_t)m * PP + C_OB + 64 * h + lane] = __builtin_bit_cast(unsigned short, r);
}
}


namespace naive {
__device__ __forceinline__ float blo(unsigned w) { return __uint_as_float(w << 16); }
__device__ __forceinline__ float bhi(unsigned w) { return __uint_as_float(w & 0xffff0000u); }
__device__ __forceinline__ unsigned short f2b(float v) { const __hip_bfloat16 r = __float2bfloat16(v); return __builtin_bit_cast(unsigned short, r); }
__device__ __forceinline__ float dotcol(const unsigned short* arow, const float* W, int K, int N, int c) {
    float s = 0.f;
    for (int k = 0; k < K; k += 2) { const unsigned w2 = *(const unsigned*)(arow + k); s += blo(w2) * W[(size_t)k * N + c]; s += bhi(w2) * W[(size_t)(k + 1) * N + c]; }
    return s;
}
__device__ __forceinline__ void gin_task(int w, int lane, const unsigned short* XN, unsigned short* P, const float* win, const float* qna, const float* kna, const float* qnb, const float* knb) {
    const int m = w / 80, cg = w % 80, c = 64 * cg + lane, t = m & (SEQ - 1);
    if (!NAIVE_GIN && !((DBG_SKIP >> (cg >> 2)) & 1u)) return;
    const float z = dotcol(XN + (size_t)m * DM, win, DM, NIN, c);
    float o;
    if (cg >= 48) o = 1.0f / (1.0f + expf(-z));
    else {
        int mode; const float* gn = qna; float scale = 1.f;
        if (cg < 8) { mode = 0; gn = qna; scale = QK_C2; }
        else if (cg < 10) { mode = 0; gn = kna; }
        else if (cg < 12) mode = 2;
        else { const int g = (cg - 12) / 12, rem = (cg - 12) % 12; if (rem < 4) { mode = 1; gn = qnb + 64 * g; scale = QK_C2; } else if (rem < 8) { mode = 1; gn = knb + 64 * g; } else mode = 2; }
        if (mode == 2) o = z;
        else {
            const float ss = wsum(z * z), y = z * (1.0f / sqrtf(ss * (1.0f / 64.0f) + EPS)) * gn[lane];
            float ang; bool first; float partner;
            if (mode == 0) { const int dd = lane & 31, i = dd & 15, pos = (lane >> 5) ? (t & 63) : (t >> 6); ang = (float)pos * powf(10000.0f, -(float)i / 16.0f); first = dd < 16; partner = __shfl_xor(y, 16); }
            else { const int i = lane & 31; ang = (float)t * powf(10000.0f, -(float)i / 32.0f); first = lane < 32; partner = __shfl_xor(y, 32); }
            const double a = (double)ang; const float cs = (float)cos(a), sn = (float)sin(a);
            o = (first ? (y * cs - partner * sn) : (y * cs + partner * sn)) * scale;
        }
    }
    P[(size_t)m * PP + c] = f2b(o);
}
}

#define LAS __attribute__((address_space(3)))
typedef unsigned short bf16;
typedef unsigned v4u __attribute__((ext_vector_type(4)));
typedef float f32x4 __attribute__((ext_vector_type(4)));
constexpr int NWAVES = 8;
constexpr size_t MiB = 1u << 20;
constexpr size_t WS_ADA = 1 * MiB, WS_TABB = 2 * MiB, WS_TABA = 3 * MiB;
constexpr size_t WS_WIN = 4 * MiB, WS_WA = 44 * MiB, WS_WB = 48 * MiB, WS_WO = 50 * MiB, WS_W1 = 58 * MiB, WS_W2 = 90 * MiB;
constexpr size_t WS_XN = 122 * MiB, WS_P = 186 * MiB, WS_XSB = 442 * MiB, WS_RSS = 506 * MiB, WS_END = 508 * MiB;
constexpr size_t WS_BIASA = 64 * 1024, WS_GS = 704 * 1024, WS_BIASF = 3 * MiB + 64 * 1024;
constexpr int RING_BYTES = 131072, LDS_BYTES = 147456;
constexpr int NPHASE = 2 + 6 * DEPTH;

__device__ __forceinline__ unsigned f2bf(float f) { unsigned u = __builtin_bit_cast(unsigned, f); return (u + 0x7fffu + ((u >> 16) & 1u)) >> 16; }
__device__ __forceinline__ unsigned pk2(float lo, float hi) { return f2bf(lo) | (f2bf(hi) << 16); }
#define LDS_WAIT() asm volatile("s_waitcnt lgkmcnt(0)" ::: "memory")
__device__ __forceinline__ float wave_sum(float v) {
#pragma unroll
    for (int o = 1; o < 64; o <<= 1) v += __shfl_xor(v, o);
    return v;
}
__device__ __forceinline__ int win_dst_row(int n) {
    const int pn = n >> 8, u = n & 255, wc = u >> 6, d = u & 63, e = d & 7;
    if (pn >= 12) return n;
    int bj, fq;
    if (pn <= 1 || (pn == 2 && wc < 2)) { bj = (d >> 4) & 1; fq = 2 * (d >> 5) + ((d >> 3) & 1); }
    else { bj = d >> 5; fq = (d >> 3) & 3; }
    return (pn << 8) + 128 * bj + 32 * wc + 8 * fq + e;
}
__device__ __forceinline__ void p0_transpose_item(const float* W, int K, int N, bf16* WT, bool perm, LAS float* scr, int item, int lane) {
    const int nblk = N / 32, kb = item / nblk, nb = item % nblk, k0 = 64 * kb, n0 = 32 * nb;
#pragma unroll
    for (int i = 0; i < 8; ++i) { const int kk = 8 * i + (lane >> 3), ch = lane & 7;
        const f32x4 v = *(const f32x4*)(W + (size_t)(k0 + kk) * N + n0 + 4 * ch);
        LAS float* d = scr + kk * 33 + 4 * ch; d[0] = v[0]; d[1] = v[1]; d[2] = v[2]; d[3] = v[3]; }
    LDS_WAIT(); asm volatile("" ::: "memory");
    const int c = lane & 7;
#pragma unroll
    for (int j = 0; j < 4; ++j) { const int n = (lane >> 3) + 8 * j; const LAS float* s = scr + (8 * c) * 33 + n;
        v4u o; o.x = pk2(s[0 * 33], s[1 * 33]); o.y = pk2(s[2 * 33], s[3 * 33]); o.z = pk2(s[4 * 33], s[5 * 33]); o.w = pk2(s[6 * 33], s[7 * 33]);
        const int row = perm ? win_dst_row(n0 + n) : (n0 + n);
        *(v4u*)(WT + (size_t)row * K + k0 + 8 * c) = o; }
    LDS_WAIT(); asm volatile("" ::: "memory");
}

__device__ __forceinline__ void gemv8_block(const float* W, int N, int n0, const LAS float* vec, LAS float* red, float* dst, int dstride, const float* addv, int wave, int lane) {
    const int cg = lane & 15, rg = lane >> 4;
    f32x4 a[8];
#pragma unroll
    for (int b = 0; b < 8; ++b) a[b] = (f32x4){0.f, 0.f, 0.f, 0.f};
    const float* wp = W + (size_t)(wave * 128 + rg) * N + n0 + 4 * cg;
#pragma unroll 8
    for (int i = 0; i < 32; ++i) { const f32x4 wv = *(const f32x4*)(wp + (size_t)(4 * i) * N); const int kk = wave * 128 + 4 * i + rg;
#pragma unroll
        for (int b = 0; b < 8; ++b) a[b] += wv * vec[b * DM + kk]; }
#pragma unroll
    for (int b = 0; b < 8; ++b)
#pragma unroll
        for (int j = 0; j < 4; ++j) { float v = a[b][j]; v += __shfl_xor(v, 16); v += __shfl_xor(v, 32); a[b][j] = v; }
    if (rg == 0) {
#pragma unroll
        for (int b = 0; b < 8; ++b) *(LAS f32x4*)(red + (wave * 8 + b) * 64 + 4 * cg) = a[b];
    }
    __syncthreads();
    { float s = addv ? addv[n0 + lane] : 0.f;
#pragma unroll
      for (int w2 = 0; w2 < 8; ++w2) s += red[(w2 * 8 + wave) * 64 + lane];
      dst[(size_t)wave * dstride + n0 + lane] = s; }
    __syncthreads();
}

#define XB_TMO      128
#define XB_XCNT(j)  (256  + 64 * (j))
#define XB_XSUB(j)  (1280 + 64 * (j))
#define XB_XGEN(j)  (2304 + 64 * (j))
#define XB_TOP      3328
#define XB_TOPGEN   3392
#define XCD_BAR_WORDS 3456
#define XB_SPIN_CAP (1u << 18)

__device__ __forceinline__ unsigned xb_ld(unsigned* p)              { return __hip_atomic_load(p, __ATOMIC_RELAXED, __HIP_MEMORY_SCOPE_AGENT); }
__device__ __forceinline__ unsigned xb_add(unsigned* p, unsigned v) { return __hip_atomic_fetch_add(p, v, __ATOMIC_RELAXED, __HIP_MEMORY_SCOPE_AGENT); }
__device__ __forceinline__ unsigned xb_xcc_id() { return (unsigned)__builtin_amdgcn_s_getreg((3 << 11) | 20) & 0xFu; }
#define XB_SPIN(cond, bar) do { unsigned _sp = 0; while (cond) { __builtin_amdgcn_s_sleep(1); \
    if ((++_sp & 255u) == 0u) { if (xb_ld(&(bar)[XB_TMO])) break; if (_sp > XB_SPIN_CAP) { atomicAdd(&(bar)[XB_TMO], 1u); break; } } } } while (0)

struct XcdBarrier {
    unsigned* bar; unsigned x;
    volatile LAS unsigned* st;
};

__device__ __forceinline__ XcdBarrier xcd_barrier_post(unsigned* bar, volatile LAS unsigned* st, bool leader) {
    XcdBarrier b; b.bar = bar; b.x = xb_xcc_id(); b.st = st;
    if (leader) (void)xb_add(&bar[XB_XCNT(b.x)], 1u);
    return b;
}
__device__ __forceinline__ void xcd_barrier_complete(unsigned* bar, unsigned x, unsigned& nloc, unsigned& nx) {
    const unsigned G = gridDim.x * gridDim.y * gridDim.z;
    unsigned sum, cnt, mine, sp = 0u;
    for (;;) {
        sum = 0u; cnt = 0u; mine = 0u;
#pragma unroll
        for (unsigned j = 0; j < 16; ++j) { const unsigned c = xb_ld(&bar[XB_XCNT(j)]); sum += c; cnt += (c > 0u) ? 1u : 0u; mine = (j == x) ? c : mine; }
        if (sum == G) break;
        __builtin_amdgcn_s_sleep(1);
        if ((++sp & 255u) == 0u) { if (xb_ld(&bar[XB_TMO])) break; if (sp > XB_SPIN_CAP) { atomicAdd(&bar[XB_TMO], 1u); break; } }
    }
    nloc = mine > 0u ? mine : 1u; nx = cnt > 0u ? cnt : 1u;
}

__device__ __forceinline__ void xcd_barrier(const XcdBarrier& b, bool leader) {
    asm volatile("s_waitcnt vmcnt(0)" ::: "memory");
    __syncthreads();
    if (leader) {
        unsigned* bar = b.bar;
        __builtin_amdgcn_s_waitcnt(0);
        unsigned nloc = b.st[0], nx = b.st[1];
        if (nloc == 0u) { xcd_barrier_complete(bar, b.x, nloc, nx); b.st[0] = nloc; b.st[1] = nx; }
        const unsigned old = xb_add(&bar[XB_XSUB(b.x)], 1u);
        const unsigned gen = old / nloc;
        if (old + 1u == (gen + 1u) * nloc) {
            __builtin_amdgcn_fence(__ATOMIC_RELEASE, "agent");
            asm volatile("s_waitcnt vmcnt(0)" ::: "memory");
            const unsigned og = xb_add(&bar[XB_TOP], 1u);
            const unsigned tg = og / nx;
            if (og + 1u == (tg + 1u) * nx) xb_add(&bar[XB_TOPGEN], 1u);
            else XB_SPIN(xb_ld(&bar[XB_TOPGEN]) == tg, bar);
            __builtin_amdgcn_fence(__ATOMIC_ACQUIRE, "agent");
            xb_add(&bar[XB_XGEN(b.x)], 1u);
            asm volatile("s_waitcnt vmcnt(0)" ::: "memory");
        } else {
            XB_SPIN(xb_ld(&bar[XB_XGEN(b.x)]) == gen, bar);
            __builtin_amdgcn_fence(__ATOMIC_ACQUIRE, "agent");
            asm volatile("s_waitcnt vmcnt(0)" ::: "memory");
        }
    }
    __syncthreads();
}

#define LB_CNT(g)   (3584 + 64 * (g))
#define LB_XMAX(g)  (3456 + (g))
#define LB_XMIN(g)  (3464 + (g))
__device__ __forceinline__ void grp_barrier(unsigned* bar, int vg, unsigned nloc, bool leader) {
    asm volatile("s_waitcnt vmcnt(0)" ::: "memory");
    __syncthreads();
    if (leader) {
        __builtin_amdgcn_s_waitcnt(0);
        const unsigned old = xb_add(&bar[LB_CNT(vg)], 1u), want = (old / nloc + 1u) * nloc;
        XB_SPIN(xb_ld(&bar[LB_CNT(vg)]) < want, bar);
        __builtin_amdgcn_fence(__ATOMIC_ACQUIRE, "agent");
        asm volatile("s_waitcnt vmcnt(0)" ::: "memory");
    }
    __syncthreads();
}

struct Args { const float* in[16]; float* out; unsigned char* ws; int ph_lo, ph_hi; };

typedef const Args __attribute__((address_space(4))) CArgs;
template <int ph> __device__ __forceinline__ void run_phase(CArgs* ap0, const int wave0, unsigned char* lds) {
    LAS unsigned char* L = (LAS unsigned char*)lds;
        int zz = 0; asm volatile("" : "+v"(zz));
        const int lane = __builtin_amdgcn_mbcnt_hi(~0u, __builtin_amdgcn_mbcnt_lo(~0u, zz)), wave = wave0;
        const int tid = wave * 64 + lane;
        int bx = blockIdx.x; asm volatile("" : "+s"(bx));
        const int G = gridDim.x; const int vcu = (G % 8 == 0) ? (bx % 8) * (G / 8) + bx / 8 : bx;
        const int gw = vcu * NWAVES + wave, NGW = G * NWAVES;
        CArgs* ap = ap0; asm volatile("" : "+s"(ap));
        unsigned char* ws = ap->ws;
        float* ADA = (float*)(ws + WS_ADA); float* TABB = (float*)(ws + WS_TABB); float* TABA = (float*)(ws + WS_TABA);
        bf16* XN = (bf16*)(ws + WS_XN); bf16* P = (bf16*)(ws + WS_P); bf16* HB = (bf16*)(ws + WS_P);
        const float* x_in = ap->in[0]; float* out = ap->out;
        if (ph == 0) {
            {
                LAS float* cact = (LAS float*)L;
                LAS float* red = (LAS float*)(L + 32768);
                for (int i = tid; i < BATCH * DM; i += NWAVES * 64) { const float v = ap->in[1][i]; cact[i] = v * __builtin_amdgcn_rcpf(1.0f + __expf(-v)); }
                __syncthreads();
                for (int it = bx; it < DEPTH * 96; it += G) {
                    const int l = it / 96, n0 = (it % 96) * 64;
                    gemv8_block(ap->in[2] + (size_t)l * DM * 6 * DM, 6 * DM, n0, cact, red, ADA + (size_t)l * BATCH * 6 * DM, 6 * DM, ap->in[3] + (size_t)l * 6 * DM, wave, lane);
                }
            }
            {
                for (int e = bx * NWAVES * 64 + tid; e < SEQ * 32 + 64 * 16; e += G * NWAVES * 64) {
                    int pos, i; float fr; float* dst;
                    if (e < SEQ * 32) { pos = e >> 5; i = e & 31; fr = (float)i * (1.0f / 32.0f); dst = TABB + 2 * (size_t)e; }
                    else { const int e2 = e - SEQ * 32; pos = e2 >> 4; i = e2 & 15; fr = (float)i * (1.0f / 16.0f); dst = TABA + 2 * (size_t)e2; }
                    const float inv = exp2f(-fr * 13.287712379549449f);
                    const float ang = (float)pos * inv;
                    const double turns = (double)ang * 0.15915494309189535;
                    const float fpart = (float)(turns - rint(turns));
#if TAB_DOUBLE
                    dst[0] = (float)cos((double)ang); dst[1] = (float)sin((double)ang);
#else
                    dst[0] = __builtin_amdgcn_cosf(fpart); dst[1] = __builtin_amdgcn_sinf(fpart);
#endif
                }
            }
            {
                LAS float* scr = (LAS float*)(L + wave * 16384);
                constexpr int I_IN = (DM / 64) * (NIN / 32), I_A = (512 / 64) * (DM / 32), I_B = (256 / 64) * (DM / 32), I_O = (DM / 64) * (DM / 32), I_1 = (DM / 64) * (FF / 32), I_2 = (FF / 64) * (DM / 32);
                constexpr int I_L = I_IN + I_A + I_B + I_O + I_1 + I_2;
                __syncthreads();
                for (int it = gw; it < DEPTH * I_L; it += NGW) {
                    const int l = it / I_L; int r = it - l * I_L;
                    if (r < I_IN) { p0_transpose_item(ap->in[6] + (size_t)l * DM * NIN, DM, NIN, (bf16*)(ws + WS_WIN) + (size_t)l * NIN * DM, true, scr, r, lane); continue; } r -= I_IN;
                    if (r < I_A) { p0_transpose_item(ap->in[11] + (size_t)l * 512 * DM, 512, DM, (bf16*)(ws + WS_WA) + (size_t)l * DM * 512, false, scr, r, lane); continue; } r -= I_A;
                    if (r < I_B) { p0_transpose_item(ap->in[12] + (size_t)l * 256 * DM, 256, DM, (bf16*)(ws + WS_WB) + (size_t)l * DM * 256, false, scr, r, lane); continue; } r -= I_B;
                    if (r < I_O) { p0_transpose_item(ap->in[13] + (size_t)l * DM * DM, DM, DM, (bf16*)(ws + WS_WO) + (size_t)l * DM * DM, false, scr, r, lane); continue; } r -= I_O;
                    if (r < I_1) { p0_transpose_item(ap->in[14] + (size_t)l * DM * FF, DM, FF, (bf16*)(ws + WS_W1) + (size_t)l * FF * DM, false, scr, r, lane); continue; } r -= I_1;
                    p0_transpose_item(ap->in[15] + (size_t)l * FF * DM, FF, DM, (bf16*)(ws + WS_W2) + (size_t)l * DM * FF, false, scr, r, lane);
                }
                __syncthreads();
            }
        } else {
            const int l = (ph - 2) / 6, sub6 = (ph - 2) % 6;
            const int sub = (ph == 1) ? 0 : (sub6 == 0 ? 1 : sub6 == 1 ? 2 : sub6 == 2 ? 3 : sub6 == 3 ? 4 : sub6 == 4 ? 6 : 7);
            const float* ada_l = ADA + (size_t)l * BATCH * 6 * DM;
            float* RSS = (float*)(ws + WS_RSS); float* GSV = (float*)(ws + WS_GS); float* BIASA = (float*)(ws + WS_BIASA); float* BIASF = (float*)(ws + WS_BIASF); bf16* XSB = P + C_GB;
            if (sub == 0) {
                { LAS float* shv = (LAS float*)L;
                  LAS float* red = (LAS float*)(L + 32768);
                  for (int it = bx; it < DEPTH * 144; it += G) {
                      const int ll = it / 144, r = it % 144; const bool isA = r < 80; const int n0 = (isA ? r : r - 80) * 64, N = isA ? NIN : FF;
                      const float* W = (isA ? ap->in[6] + (size_t)ll * DM * NIN : ap->in[14] + (size_t)ll * DM * FF);
                      const float* adl = ADA + (size_t)ll * BATCH * 6 * DM + (isA ? 0 : 3 * DM);
                      for (int i = tid; i < BATCH * DM; i += NWAVES * 64) shv[i] = adl[(size_t)(i >> 10) * 6 * DM + (i & 1023)];
                      __syncthreads();
                      gemv8_block(W, N, n0, shv, red, isA ? BIASA + (size_t)ll * BATCH * NIN : BIASF + (size_t)ll * BATCH * FF, N, nullptr, wave, lane);
                  } }
                for (int e = bx * NWAVES * 64 + tid; e < 2 * DEPTH * BATCH * DM; e += G * NWAVES * 64) {
                    const int which = e >> 15, ll = (e >> 13) & 3, b = (e >> 10) & 7, c = e & 1023;
                    GSV[e] = (which ? ap->in[5] : ap->in[4])[ll * DM + c] * (1.0f + ADA[((size_t)ll * BATCH + b) * 6 * DM + (which ? 4 : 1) * DM + c]);
                }
                { f32x4 gg[4];
#pragma unroll
                  for (int j = 0; j < 4; ++j) gg[j] = *(const f32x4*)(ap->in[4] + 256 * j + 4 * lane);
                  for (int m = gw; m < MTOK; m += NGW) {
                    const int b = m >> 12; const f32x4* xr = (const f32x4*)(x_in + (size_t)m * DM) + lane;
                    f32x4 v[4]; float s = 0.f;
#pragma unroll
                    for (int j = 0; j < 4; ++j) { v[j] = xr[64 * j]; s += (v[j][0] * v[j][0] + v[j][1] * v[j][1]) + (v[j][2] * v[j][2] + v[j][3] * v[j][3]); }
                    s = wave_sum(s);
                    if (lane < 16) RSS[(size_t)m * 16 + lane] = (lane == 0) ? s : 0.f;
                    const float* ab = ADA + (size_t)b * 6 * DM + DM;
                    unsigned long long* o8 = (unsigned long long*)(XN + (size_t)m * DM) + lane;
#pragma unroll
                    for (int j = 0; j < 4; ++j) { const f32x4 sc = *(const f32x4*)(ab + 256 * j + 4 * lane);
                        const f32x4 y = v[j] * gg[j] * (sc + 1.0f);
                        o8[64 * j] = (unsigned long long)pk2(y[0], y[1]) | ((unsigned long long)pk2(y[2], y[3]) << 32); }
                  } }
            } else if (sub == 1) {
                pg8::Gemm g{XN, (const bf16*)(ws + WS_WIN) + (size_t)l * NIN * DM, MTOK, NIN, DM, DM}; pg8::StaticOrder S; S.init(MTOK, NIN, G, bx);
                pg8::EpiIn E{P, ap->in[7] + l * 64, ap->in[8] + l * 64, ap->in[9] + l * 192, ap->in[10] + l * 192, TABA, TABB, RSS, BIASA + (size_t)l * BATCH * NIN};
#if NAIVE_GIN
                for (int w = gw; w < MTOK * 80; w += NGW) naive::gin_task(w, lane, XN, P, ap->in[6] + (size_t)l * DM * NIN, ap->in[7] + l * 64, ap->in[8] + l * 64, ap->in[9] + l * 192, ap->in[10] + l * 192);
#else
#ifndef NO_GIN
                pg8::gemm_phase<pg8::EpiIn, pg8::StaticOrder, true, true, DM, DM>(tid, L, g, S, E);
#if DBG_GEMM2 & 1
                pg8::gemm_phase<pg8::EpiIn, pg8::StaticOrder, true, true, DM, DM>(tid, L, g, S, E);
#endif
#endif
#if DBG_SKIP
                for (int w = gw; w < MTOK * 80; w += NGW) naive::gin_task(w, lane, XN, P, ap->in[6] + (size_t)l * DM * NIN, ap->in[7] + l * 64, ap->in[8] + l * 64, ap->in[9] + l * 192, ap->in[10] + l * 192);
#endif
#endif
            } else if (sub == 2) {
                for (int u = vcu; u < BATCH * 8 * 16; u += G) {
                    const int i = u / G, gsz = G >> 3, loc = (vcu % gsz) + gsz * i;
                    const int b = vcu / gsz, h = (loc >> 4) & 7, qb = loc & 15;
                    if (loc >= 128) continue;
#if !defined(NO_ATT) && !NAIVE_ATT
                    attn_body::attn_unit<8>(b, h, qb, (const attn_body::bf16*)P + C_QA, (const attn_body::bf16*)P + C_KA, (const attn_body::bf16*)P + C_VA, (attn_body::bf16*)P + C_QA, (char*)lds, tid);
#endif
                }
                __syncthreads();
#if NAIVE_ATT
                for (int w = gw; w < MTOK * 8; w += NGW) naive::dense_task(P, w, (LAS float*)(L + wave * 256), lane);
                __syncthreads();
#endif
#if NAIVE_DIL
                for (int w = gw; w < MTOK * 4; w += NGW) naive::dil_task(P, w, (LAS float*)(L + wave * 256), lane);
#elif !defined(NO_DIL)
                { float* SO = (float*)(ws + WS_XN); float* SM = (float*)(ws + WS_XN + 4 * MiB); float* SL = (float*)(ws + WS_XN + 4 * MiB + 65536);
                  for (int grp = vcu; grp < BATCH * 4 * 8; grp += G) {
#pragma unroll 1
                    for (int k2 = 0; k2 < 2; ++k2) dil::dil_pass1(P, grp, wave + 8 * k2, L + wave * dil::WAVE_LDS, lane, SO, SM, SL);
                    asm volatile("s_waitcnt vmcnt(0)" ::: "memory"); __syncthreads();
#pragma unroll 1
                    for (int k2 = 0; k2 < 2; ++k2) dil::dil_pass2(P, grp, wave + 8 * k2, L + wave * dil::WAVE_LDS, lane, SO, SM, SL);
                    __syncthreads();
                  } }
#endif
                __syncthreads();
            } else if (sub == 3) {
                { pg8::Gemm g{P + C_QA, (const bf16*)(ws + WS_WA) + (size_t)l * DM * 512, MTOK, DM, 512, PP}; pg8::StaticOrder S; S.init(MTOK, DM, G, bx);

#if NAIVE_BR
                for (int w = gw; w < MTOK * 16; w += NGW) { const int m = w >> 4, c = 64 * (w & 15) + lane;
                    const float za = naive::dotcol(P + (size_t)m * PP + C_QA, ap->in[11] + (size_t)l * 512 * DM, 512, DM, c), zb = naive::dotcol(P + (size_t)m * PP + C_OB, ap->in[12] + (size_t)l * 256 * DM, 256, DM, c);
                    const float ga = naive::bf2f(P[(size_t)m * PP + C_GA + c]), gb = naive::bf2f(P[(size_t)m * PP + C_GB + c]);
                    XN[(size_t)m * DM + c] = naive::f2b(ga * za + gb * zb); }
#else
#ifndef NO_BR0
pg8::EpiBr<0> E{XN, P, C_GA}; pg8::gemm_phase<pg8::EpiBr<0>, pg8::StaticOrder, true, true, 512, PP>(tid, L, g, S, E);
#endif
#endif
 }
                { pg8::Gemm g{P + C_OB, (const bf16*)(ws + WS_WB) + (size_t)l * DM * 256, MTOK, DM, 256, PP}; pg8::StaticOrder S; S.init(MTOK, DM, G, bx);

#if NAIVE_BR

#else
#ifndef NO_BR1
pg8::EpiBr<1> E{XN, P, C_GB}; pg8::gemm_phase<pg8::EpiBr<1>, pg8::StaticOrder, true, true, 256, PP>(tid, L, g, S, E);
#endif
#endif
 }
            } else if (sub == 4) {
                pg8::Gemm g{XN, (const bf16*)(ws + WS_WO) + (size_t)l * DM * DM, MTOK, DM, DM, DM}; pg8::StaticOrder S; S.init(MTOK, DM, G, bx);
                pg8::EpiRes E{l == 0 ? x_in : out, out, ada_l + 2 * DM, XSB, GSV + (size_t)(DEPTH + l) * BATCH * DM, RSS, PP};
#if NAIVE_OUT
                for (int w = gw; w < MTOK * 16; w += NGW) { const int m = w >> 4, c = 64 * (w & 15) + lane;
                    const float z = naive::dotcol(XN + (size_t)m * DM, ap->in[13] + (size_t)l * DM * DM, DM, DM, c);
                    out[(size_t)m * DM + c] = (l == 0 ? x_in : out)[(size_t)m * DM + c] + ada_l[(size_t)(m >> 12) * 6 * DM + 2 * DM + c] * z; }
#else
#ifndef NO_RES
pg8::gemm_phase<pg8::EpiRes, pg8::StaticOrder, true, true, DM, DM>(tid, L, g, S, E);
#endif
#endif

            } else if (sub == 6) {
                pg8::Gemm g{XSB, (const bf16*)(ws + WS_W1) + (size_t)l * FF * DM, MTOK, FF, DM, PP}; pg8::StaticOrder S; S.init(MTOK, FF, G, bx);
                pg8::EpiRelu2 E{HB, RSS, BIASF + (size_t)l * BATCH * FF};
#if NAIVE_F1
                for (int w = gw; w < MTOK * 64; w += NGW) { const int m = w >> 6, c = 64 * (w & 63) + lane;
                    const float z = fmaxf(naive::dotcol(XN + (size_t)m * DM, ap->in[14] + (size_t)l * DM * FF, DM, FF, c), 0.f);
                    HB[(size_t)m * FF + c] = naive::f2b(z * z); }
#else
#ifndef NO_F1
pg8::gemm_phase<pg8::EpiRelu2, pg8::StaticOrder, true, true, DM, PP>(tid, L, g, S, E);
#if DBG_GEMM2 & 4
pg8::gemm_phase<pg8::EpiRelu2, pg8::StaticOrder, true, true, DM, PP>(tid, L, g, S, E);
#endif
#endif
#endif

            } else {
                pg8::Gemm g{HB, (const bf16*)(ws + WS_W2) + (size_t)l * DM * FF, MTOK, DM, FF, PP}; pg8::StaticOrder S; S.init(MTOK, DM, G, bx);
                pg8::EpiRes E{out, out, ada_l + 5 * DM, (l + 1 < DEPTH) ? XN : (bf16*)nullptr, GSV + (size_t)((l + 1 < DEPTH) ? (l + 1) : 0) * BATCH * DM, RSS, DM};
#if NAIVE_F2
                for (int w = gw; w < MTOK * 16; w += NGW) { const int m = w >> 4, c = 64 * (w & 15) + lane;
                    const float z = naive::dotcol(HB + (size_t)m * FF, ap->in[15] + (size_t)l * FF * DM, FF, DM, c);
                    out[(size_t)m * DM + c] = out[(size_t)m * DM + c] + ada_l[(size_t)(m >> 12) * 6 * DM + 5 * DM + c] * z; }
#else
#ifndef NO_RES
pg8::gemm_phase<pg8::EpiRes, pg8::StaticOrder, true, true, FF, PP>(tid, L, g, S, E);
#endif
#endif

            }
        }
}

__global__ void __launch_bounds__(NWAVES * 64, 2) mk_fwd(Args args) {
    extern __shared__ __attribute__((aligned(16))) unsigned char lds[];
    CArgs* ap0 = (CArgs*)__builtin_amdgcn_kernarg_segment_ptr();
    const int ph_lo = ap0->ph_lo, ph_hi = ap0->ph_hi;
    const int wave0 = __builtin_amdgcn_readfirstlane(threadIdx.x >> 6);
    volatile LAS unsigned* bst = (volatile LAS unsigned*)((LAS unsigned char*)lds + RING_BYTES + 64);
    if (threadIdx.x == 0) { bst[0] = 0u; bst[1] = 0u; }
    __syncthreads();
    unsigned* barw = (unsigned*)ap0->ws;
    const unsigned xbx = xcd_barrier_post(barw, bst, threadIdx.x == 0).x;
    if (threadIdx.x == 0) { const int vg0 = blockIdx.x & 7; atomicMax(&barw[LB_XMAX(vg0)], xbx + 1u); atomicMax(&barw[LB_XMIN(vg0)], 16u - xbx); bst[2] = 0u; }
#define RUN(PH) if (ph_lo <= (PH) && (PH) < ph_hi) { const bool spin_ = (DBG_SPIN_SUB >= 0) && (PH) >= 2 && (((PH) - 2) % 6 == DBG_SPIN_SUB); unsigned long long t0_ = 0; if (spin_) t0_ = __builtin_amdgcn_s_memrealtime(); run_phase<(PH)>(ap0, wave0, lds); if (spin_) { __syncthreads(); const unsigned long long t1_ = __builtin_amdgcn_s_memrealtime(); while (__builtin_amdgcn_s_memrealtime() - t1_ < t1_ - t0_) __builtin_amdgcn_s_sleep(8); } if (DBG_P02 && (PH) <= 1) { __syncthreads(); run_phase<((PH) <= 1 ? (PH) : 0)>(ap0, wave0, lds); } if ((PH) + 1 < ph_hi) { if ((PH) == 0) cg::this_grid().sync(); else { int z_ = 0; asm volatile("" : "+v"(z_)); const bool ld_ = (wave0 == 0) && (__builtin_amdgcn_mbcnt_hi(~0u, __builtin_amdgcn_mbcnt_lo(~0u, z_)) == 0); XcdBarrier xb_; xb_.bar = barw; xb_.x = xbx; xb_.st = bst; if ((PH) == 1) { xcd_barrier(xb_, ld_); if (ld_) { unsigned ok_ = (gridDim.x == 256u) ? 1u : 0u;     for (int g_ = 0; g_ < 8; ++g_) ok_ &= (xb_ld(&barw[LB_XMAX(g_)]) + xb_ld(&barw[LB_XMIN(g_)]) == 17u) ? 1u : 0u; bst[2] = (LOCAL_SEAMS ? ok_ : 0u); } __syncthreads(); if (DBG_CENSUS && !bst[2]) { const unsigned long long tc_ = __builtin_amdgcn_s_memrealtime(); while (__builtin_amdgcn_s_memrealtime() - tc_ < 200000ull) __builtin_amdgcn_s_sleep(8); } } else { unsigned long long tb0_ = 0; if (DBG_SPIN_BAR) tb0_ = __builtin_amdgcn_s_memrealtime(); if (bst[2]) grp_barrier(barw, (int)(blockIdx.x & 7), gridDim.x / 8u, ld_); else for (int xs_ = 0; xs_ <= DBG_SYNCX; ++xs_) xcd_barrier(xb_, ld_); if (DBG_SPIN_BAR) { const unsigned long long tb1_ = __builtin_amdgcn_s_memrealtime(); while (__builtin_amdgcn_s_memrealtime() - tb1_ < tb1_ - tb0_) __builtin_amdgcn_s_sleep(8); } } } } }
#define RUN8(B) RUN(B) RUN(B + 1) RUN(B + 2) RUN(B + 3) RUN(B + 4) RUN(B + 5) RUN(B + 6) RUN(B + 7)
    RUN(0) RUN(1) RUN8(2) RUN8(10) RUN8(18)
#undef RUN8
#undef RUN
}

extern "C" void kernel_launch(void* const* d_in, const int* in_sizes, int n_in, void* d_out, int out_size, void* d_ws, size_t ws_size, hipStream_t stream) {
    static int grid = 0;
    if (grid == 0) {
        if (n_in != 16 || out_size != MTOK * DM || ws_size < WS_END) { fprintf(stderr, "kernel_launch: unexpected shapes (n_in %d out %d ws %zu)\n", n_in, out_size, ws_size); grid = -1; return; }
        int dev = 0, cus = 0, per_cu = 0;
        if (hipGetDevice(&dev) != hipSuccess || hipDeviceGetAttribute(&cus, hipDeviceAttributeMultiprocessorCount, dev) != hipSuccess) { grid = -1; return; }
        if (hipFuncSetAttribute((const void*)mk_fwd, hipFuncAttributeMaxDynamicSharedMemorySize, LDS_BYTES) != hipSuccess) { fprintf(stderr, "kernel_launch: hipFuncSetAttribute failed\n"); grid = -1; return; }
        if (hipOccupancyMaxActiveBlocksPerMultiprocessor(&per_cu, (const void*)mk_fwd, NWAVES * 64, LDS_BYTES) != hipSuccess || per_cu < 1) per_cu = 1;
        (void)hipGetLastError();
        grid = cus * 1;
        fprintf(stderr, "kernel_launch: grid %d (occupancy query %d per CU)\n", grid, per_cu);
    }
    if (grid < 0) return;
    if (hipMemsetAsync(d_ws, 0, 16384, stream) != hipSuccess) { fprintf(stderr, "kernel_launch: memset failed\n"); return; }
    Args a{};
    for (int i = 0; i < 16; ++i) a.in[i] = (const float*)d_in[i];
    a.out = (float*)d_out; a.ws = (unsigned char*)d_ws;
#if MK_PER_PHASE
    for (int ph = 0; ph < NPHASE; ++ph) { a.ph_lo = ph; a.ph_hi = ph + 1; hipLaunchKernelGGL(mk_fwd, dim3(grid), dim3(NWAVES * 64), LDS_BYTES, stream, a); }
#else
    a.ph_lo = 0; a.ph_hi = NPHASE;
    void* kargs[] = {&a};
    hipError_t e = hipLaunchCooperativeKernel((void*)mk_fwd, dim3(grid), dim3(NWAVES * 64), kargs, LDS_BYTES, stream);
    if (e != hipSuccess) fprintf(stderr, "cooperative launch failed: %s (grid %d)\n", hipGetErrorString(e), grid);
#endif
}
```

```cpp
#include <hip/hip_runtime.h>
#include <hip/hip_bf16.h>
#include <hip/hip_cooperative_groups.h>
#include <cstdio>
#include <cstdint>
#include <cmath>
namespace cg = cooperative_groups;

#ifndef MK_PER_PHASE
#define MK_PER_PHASE 0
#endif

#ifndef NAIVE_ATT
#define NAIVE_ATT 0
#endif
#ifndef NAIVE_DIL
#define NAIVE_DIL 0
#endif

#ifndef NAIVE_GEMM
#define NAIVE_GEMM 0
#endif

#ifndef NAIVE_GIN
#define NAIVE_GIN NAIVE_GEMM
#endif
#ifndef NAIVE_BR
#define NAIVE_BR NAIVE_GEMM
#endif
#ifndef NAIVE_OUT
#define NAIVE_OUT NAIVE_GEMM
#endif
#ifndef NAIVE_F1
#define NAIVE_F1 NAIVE_GEMM
#endif
#ifndef NAIVE_F2
#define NAIVE_F2 NAIVE_GEMM
#endif

#ifndef TAB_DOUBLE
#define TAB_DOUBLE 1
#endif

#ifndef DBG_SKIP
#define DBG_SKIP 0u
#endif

#ifndef DBG_SYNCX
#define DBG_SYNCX 0
#endif
#ifndef DBG_DIL2
#define DBG_DIL2 0
#endif
#ifndef DBG_GEMM2
#define DBG_GEMM2 0
#endif

#ifndef DBG_P02
#define DBG_P02 0
#endif

#ifndef DBG_SPIN_SUB
#define DBG_SPIN_SUB (-1)
#endif

#ifndef DBG_SPIN_BAR
#define DBG_SPIN_BAR 0
#endif

#ifndef LOCAL_SEAMS
#define LOCAL_SEAMS 1
#endif

#ifndef DBG_CENSUS
#define DBG_CENSUS 0
#endif

#ifndef EPI_FENCE_IN
#define EPI_FENCE_IN 2
#endif
#ifndef EPI_FENCE_BR
#define EPI_FENCE_BR 0
#endif
#ifndef EPI_FENCE_RES
#define EPI_FENCE_RES 0
#endif
#ifndef EPI_FENCE
#define EPI_FENCE 0
#endif

constexpr int BATCH = 8, SEQ = 4096, DM = 1024, DEPTH = 4, FF = 4096, NIN = 5120;
constexpr int MTOK = BATCH * SEQ;
constexpr int PP = 5120;
constexpr int C_QA = 0, C_KA = 512, C_VA = 640, C_B0 = 768, C_GA = 3072, C_GB = 4096, C_OB = 768;
constexpr float QK_C2 = 0.125f * 1.4426950408889634f;
constexpr float EPS = 1e-6f;

namespace pg8 {
#define PG8_LAS __attribute__((address_space(3)))
typedef unsigned short bf16_t;
typedef short bf16x8 __attribute__((ext_vector_type(8)));
typedef float f32x4 __attribute__((ext_vector_type(4)));
typedef unsigned u32x4 __attribute__((ext_vector_type(4)));
constexpr int BM = 256, BK = 64, HALF = 128, HTB = HALF * BK * 2  , STAGE_BYTES = 8 * HTB, NXCD = 8, WGM = 8;

__host__ __device__ __forceinline__ int lds_byte(int r, int c) { const int st = (r >> 4) * 2 + (c >> 5), rr = r & 15, cc = c & 31, ob = rr * 64 + cc * 2; return st * 1024 + (ob ^ (((ob >> 9) & 1) << 5)); }
__host__ __device__ __forceinline__ void stage_rc(int b, int& R, int& C) { const int st = b / 1024, sb = b % 1024, swz = sb ^ (((sb >> 9) & 1) << 5); R = (st >> 1) * 16 + swz / 64; C = (st & 1) * 32 + (swz % 64) / 2; }
__host__ __device__ __forceinline__ int perm32(int rho) { const int n = rho >> 4, i = rho & 15; return 8 * (i >> 2) + 4 * n + (i & 3); }

struct Unit { int pm, pn; };
struct Gemm { const bf16_t* A; const bf16_t* Bt; int M, N, K, lda; };

struct StaticOrder {
    int nM, nN, nwg, G, c;
    __host__ __device__ void init(int M, int N, int G_, int c_) { nM = M / BM; nN = N / BM; nwg = nM * nN; G = G_; c = c_; }
    __host__ __device__ bool next(int i, Unit& u) const {
        const long L = (long)i * G + c; if (L >= nwg) return false;
        int wgid = (int)L; { const int q = nwg / NXCD, r = nwg % NXCD, xcd = wgid % NXCD, off = wgid / NXCD; wgid = (xcd < r ? xcd * (q + 1) : r * (q + 1) + (xcd - r) * q) + off; }
        const int nig = WGM * nN, gid = wgid / nig, fm = gid * WGM, gsz = (nM - fm) < WGM ? (nM - fm) : WGM;
        u.pm = fm + ((wgid % nig) % gsz); u.pn = (wgid % nig) / gsz; return true;
    }
    __device__ __forceinline__ void a_ready(const Unit&) const {}
    __device__ __forceinline__ void done(const Unit&) const {}
};

typedef float f32x2c __attribute__((ext_vector_type(2))); typedef __bf16 bf16x2c __attribute__((ext_vector_type(2)));
__device__ __forceinline__ unsigned cvt_pk_bf16(float lo, float hi) { const f32x2c v = {lo, hi}; const bf16x2c b = __builtin_convertvector(v, bf16x2c); return __builtin_bit_cast(unsigned, b); }
typedef float f32x2 __attribute__((ext_vector_type(2)));
typedef unsigned u32x2 __attribute__((ext_vector_type(2)));
__device__ __forceinline__ float bf_lo(unsigned w) { return __uint_as_float(w << 16); }
__device__ __forceinline__ float bf_hi(unsigned w) { return __uint_as_float(w & 0xffff0000u); }
__device__ __forceinline__ float sigm(float v) { return __builtin_amdgcn_rcpf(1.0f + __builtin_amdgcn_exp2f(-1.4426950408889634f * v)); }
__device__ __forceinline__ u32x4 pack8(const f32x4 a, const f32x4 b) { u32x4 w; w.x = cvt_pk_bf16(a[0], a[1]); w.y = cvt_pk_bf16(a[2], a[3]); w.z = cvt_pk_bf16(b[0], b[1]); w.w = cvt_pk_bf16(b[2], b[3]); return w; }

__device__ __forceinline__ float row_rstd(const float* rss, int row) {
    const f32x4* p = (const f32x4*)(rss + (size_t)row * 16); const f32x4 a = p[0], b = p[1], c = p[2], d = p[3];
    const float s = ((a[0] + a[1]) + (a[2] + a[3])) + ((b[0] + b[1]) + (b[2] + b[3])) + ((c[0] + c[1]) + (c[2] + c[3])) + ((d[0] + d[1]) + (d[2] + d[3]));
    return __builtin_amdgcn_rsqf(s * (1.0f / DM) + EPS);
}
__device__ __forceinline__ void rows_rstd(const float* rss, int row0, int fq, float (&rs)[2][4]) {
    f32x4 q[2][4];
#pragma unroll
    for (int ai = 0; ai < 2; ++ai)
#pragma unroll
        for (int m = 0; m < 4; ++m) q[ai][m] = *(const f32x4*)(rss + (size_t)(row0 + ai * HALF + m * 16) * 16 + 4 * fq);
#pragma unroll
    for (int ai = 0; ai < 2; ++ai)
#pragma unroll
        for (int m = 0; m < 4; ++m) { float s = (q[ai][m][0] + q[ai][m][1]) + (q[ai][m][2] + q[ai][m][3]); s += __shfl_xor(s, 16); s += __shfl_xor(s, 32);
            rs[ai][m] = __builtin_amdgcn_rsqf(s * (1.0f / DM) + EPS); }
}
struct EpiIn {
    static constexpr bool PERM = true, AFTER_DRAIN = false;
    bf16_t* P; const float* qna; const float* kna; const float* qnb; const float* knb; const float* tabA; const float* tabB; const float* rss; const float* bias;
    __device__ __forceinline__ void operator()(const f32x4 (&acc)[2][2][4][2], const Unit& u, int wr, int wc, int fr, int fq) const {
        const int pn = u.pn; const int row0 = u.pm * BM + wr * 64 + fr; const int bb = (u.pm * BM) / SEQ;
        if ((DBG_SKIP >> pn) & 1u) return;
        float rs[2][4]; rows_rstd(rss, row0, fq, rs);
        if (pn >= 12) {
            const int col0 = pn * 256 + wc * 32 + 8 * fq;
            f32x4 bv[2][2];
#pragma unroll
            for (int bj = 0; bj < 2; ++bj)
#pragma unroll
                for (int n = 0; n < 2; ++n) bv[bj][n] = *(const f32x4*)(bias + (size_t)bb * NIN + col0 + bj * HALF + 4 * n);
#pragma unroll
            for (int ai = 0; ai < 2; ++ai)
#pragma unroll
                for (int m = 0; m < 4; ++m) { const int row = row0 + ai * HALF + m * 16; bf16_t* rowp = P + (size_t)row * PP + col0; const float rstd = rs[ai][m];
#pragma unroll
                    for (int bj = 0; bj < 2; ++bj) { f32x4 v0 = acc[ai][bj][m][0] * rstd + bv[bj][0], v1 = acc[ai][bj][m][1] * rstd + bv[bj][1];
#pragma unroll
                        for (int j = 0; j < 4; ++j) { v0[j] = sigm(v0[j]); v1[j] = sigm(v1[j]); }
                        *(u32x4*)(rowp + bj * HALF) = pack8(v0, v1); } }
            return;
        }
        int mode, colbase; const float* gn = qna; float scale = 1.f;
        if (pn <= 1) { mode = 0; colbase = (4 * pn + wc) * 64; gn = qna; scale = QK_C2; }
        else if (pn == 2) { colbase = 512 + 64 * wc; if (wc < 2) { mode = 0; gn = kna; } else mode = 2; }
        else { const int g = (pn - 3) / 3, kind = (pn - 3) - 3 * g; colbase = 256 * pn + 64 * wc;
               if (kind == 2) mode = 2; else { mode = 1; gn = (kind == 0 ? qnb : knb) + 64 * g; scale = (kind == 0) ? QK_C2 : 1.f; } }
        const int d0 = (mode == 0) ? (32 * (fq >> 1) + 8 * (fq & 1)) : 8 * fq; const int bjs = (mode == 0) ? 16 : 32;
        f32x4 bz[2][2];
#pragma unroll
        for (int bj = 0; bj < 2; ++bj)
#pragma unroll
            for (int n = 0; n < 2; ++n) bz[bj][n] = *(const f32x4*)(bias + (size_t)bb * NIN + colbase + d0 + bj * bjs + 4 * n);
        if (mode == 2) {
#pragma unroll
            for (int ai = 0; ai < 2; ++ai)
#pragma unroll
                for (int m = 0; m < 4; ++m) { const int row = row0 + ai * HALF + m * 16; bf16_t* rowp = P + (size_t)row * PP + colbase + d0; const float rstd = rs[ai][m];
#pragma unroll
                    for (int bj = 0; bj < 2; ++bj) *(u32x4*)(rowp + bj * bjs) = pack8(acc[ai][bj][m][0] * rstd + bz[bj][0], acc[ai][bj][m][1] * rstd + bz[bj][1]); }
            return;
        }
        f32x4 gw[2][2];
#pragma unroll
        for (int bj = 0; bj < 2; ++bj)
#pragma unroll
            for (int n = 0; n < 2; ++n) gw[bj][n] = *(const f32x4*)(gn + d0 + bj * bjs + 4 * n);
#pragma unroll
        for (int ai = 0; ai < 2; ++ai)
#pragma unroll
            for (int m = 0; m < 4; ++m) {
                const int row = row0 + ai * HALF + m * 16, t = row & (SEQ - 1);
                const float rs0 = rs[ai][m];
                f32x4 zz[2][2];
#pragma unroll
                for (int bj = 0; bj < 2; ++bj)
#pragma unroll
                    for (int n = 0; n < 2; ++n) zz[bj][n] = acc[ai][bj][m][n] * rs0 + bz[bj][n];
                float ss = 0.f;
#pragma unroll
                for (int bj = 0; bj < 2; ++bj)
#pragma unroll
                    for (int n = 0; n < 2; ++n) { const f32x4 x = zz[bj][n]; ss += (x[0] * x[0] + x[1] * x[1]) + (x[2] * x[2] + x[3] * x[3]); }
                ss += __shfl_xor(ss, 16); ss += __shfl_xor(ss, 32);
                const float rstd = __builtin_amdgcn_rsqf(ss * (1.0f / 64.0f) + EPS) ;
                const float* tb = (mode == 0) ? tabA + ((((fq >> 1) ? (t & 63) : (t >> 6)) * 16 + 8 * (fq & 1)) * 2) : tabB + ((t * 32 + 8 * fq) * 2);
                f32x4 cs[4];
#pragma unroll
                for (int i = 0; i < 4; ++i) cs[i] = *(const f32x4*)(tb + 4 * i);
                f32x4 o1[2], o2[2];
#pragma unroll
                for (int n = 0; n < 2; ++n) { const f32x4 y0 = zz[0][n] * rstd * gw[0][n], y1 = zz[1][n] * rstd * gw[1][n];
#pragma unroll
                    for (int j = 0; j < 4; ++j) { const float c = cs[2 * n + (j >> 1)][(j & 1) * 2], s = cs[2 * n + (j >> 1)][(j & 1) * 2 + 1];
                        o1[n][j] = (y0[j] * c - y1[j] * s) * scale; o2[n][j] = (y1[j] * c + y0[j] * s) * scale; } }
                bf16_t* rowp = P + (size_t)row * PP + colbase + d0;
                *(u32x4*)(rowp) = pack8(o1[0], o1[1]); *(u32x4*)(rowp + bjs) = pack8(o2[0], o2[1]);
                if ((EPI_FENCE_IN == 1 && (m & 1)) || (EPI_FENCE_IN == 2 && m == 3)) asm volatile("" ::: "memory");
            }
    }
};
template <int PASS> struct EpiBr {
    static constexpr bool PERM = true, AFTER_DRAIN = false;
    bf16_t* MX; const bf16_t* P; int gcol;
    __device__ __forceinline__ void operator()(const f32x4 (&acc)[2][2][4][2], const Unit& u, int wr, int wc, int fr, int fq) const {
        const int row0 = u.pm * BM + wr * 64 + fr, col0 = u.pn * 256 + wc * 32 + 8 * fq;
#pragma unroll
        for (int ai = 0; ai < 2; ++ai)
#pragma unroll
            for (int m = 0; m < 4; ++m) { const size_t row = (size_t)(row0 + ai * HALF + m * 16);
#pragma unroll
                for (int bj = 0; bj < 2; ++bj) { const int c = col0 + bj * HALF;
                    const u32x4 gv = *(const u32x4*)(P + row * PP + gcol + c);
                    f32x4 v0 = acc[ai][bj][m][0], v1 = acc[ai][bj][m][1];
                    v0[0] *= bf_lo(gv.x); v0[1] *= bf_hi(gv.x); v0[2] *= bf_lo(gv.y); v0[3] *= bf_hi(gv.y);
                    v1[0] *= bf_lo(gv.z); v1[1] *= bf_hi(gv.z); v1[2] *= bf_lo(gv.w); v1[3] *= bf_hi(gv.w);
                    if (PASS == 1) { const u32x4 pv = *(const u32x4*)(MX + row * DM + c);
                        v0[0] += bf_lo(pv.x); v0[1] += bf_hi(pv.x); v0[2] += bf_lo(pv.y); v0[3] += bf_hi(pv.y);
                        v1[0] += bf_lo(pv.z); v1[1] += bf_hi(pv.z); v1[2] += bf_lo(pv.w); v1[3] += bf_hi(pv.w); }
                    *(u32x4*)(MX + row * DM + c) = pack8(v0, v1); }
                if (EPI_FENCE_BR && (m & 1)) asm volatile("" ::: "memory"); }
    }
};
struct EpiRes {
    static constexpr bool PERM = false, AFTER_DRAIN = false;
    const float* base; float* out; const float* gt;
    bf16_t* XS; const float* gs; float* rss; int xpitch;
    __device__ __forceinline__ void operator()(const f32x4 (&acc)[2][2][4][2], const Unit& u, int wr, int wc, int fr, int fq) const {
        const int row0 = u.pm * BM + wr * 64 + fr, col0 = u.pn * 256 + wc * 32 + 4 * fq; const int b = (u.pm * BM) / SEQ;
        f32x4 gv[2][2], gsv[2][2];
#pragma unroll
        for (int bj = 0; bj < 2; ++bj)
#pragma unroll
            for (int n = 0; n < 2; ++n) { gv[bj][n] = *(const f32x4*)(gt + (size_t)b * 6 * DM + col0 + bj * HALF + n * 16);
                gsv[bj][n] = XS ? *(const f32x4*)(gs + (size_t)b * DM + col0 + bj * HALF + n * 16) : (f32x4){0.f, 0.f, 0.f, 0.f}; }
#pragma unroll
        for (int ai = 0; ai < 2; ++ai)
#pragma unroll
            for (int m = 0; m < 4; ++m) { const int row = row0 + ai * HALF + m * 16; const size_t off = (size_t)row * DM + col0; float ss = 0.f;
#pragma unroll
                for (int bj = 0; bj < 2; ++bj)
#pragma unroll
                    for (int n = 0; n < 2; ++n) { const f32x4 bs = *(const f32x4*)(base + off + bj * HALF + n * 16);
                        const f32x4 o = bs + gv[bj][n] * acc[ai][bj][m][n];
                        *(f32x4*)(out + off + bj * HALF + n * 16) = o;
                        if (XS) { ss += (o[0] * o[0] + o[1] * o[1]) + (o[2] * o[2] + o[3] * o[3]); const f32x4 xs = o * gsv[bj][n];
                            u32x2 w; w.x = cvt_pk_bf16(xs[0], xs[1]); w.y = cvt_pk_bf16(xs[2], xs[3]); *(u32x2*)(XS + (size_t)row * xpitch + col0 + bj * HALF + n * 16) = w; } }
                if (XS) { ss += __shfl_xor(ss, 16); ss += __shfl_xor(ss, 32); if (fq == 0) rss[(size_t)row * 16 + u.pn * 4 + wc] = ss; }
                if (EPI_FENCE_RES && (m & 1)) asm volatile("" ::: "memory"); }
    }
};
struct EpiRelu2 {
    static constexpr bool PERM = true, AFTER_DRAIN = false;
    bf16_t* H; const float* rss; const float* bias;
    __device__ __forceinline__ void operator()(const f32x4 (&acc)[2][2][4][2], const Unit& u, int wr, int wc, int fr, int fq) const {
        const int row0 = u.pm * BM + wr * 64 + fr, col0 = u.pn * 256 + wc * 32 + 8 * fq; const int b = (u.pm * BM) / SEQ;
        float rs[2][4]; rows_rstd(rss, row0, fq, rs);
        f32x4 bv[2][2];
#pragma unroll
        for (int bj = 0; bj < 2; ++bj)
#pragma unroll
            for (int n = 0; n < 2; ++n) bv[bj][n] = *(const f32x4*)(bias + (size_t)b * FF + col0 + bj * HALF + 4 * n);
#pragma unroll
        for (int ai = 0; ai < 2; ++ai)
#pragma unroll
            for (int m = 0; m < 4; ++m) { const int row = row0 + ai * HALF + m * 16; bf16_t* rowp = H + (size_t)row * PP + col0; const float rstd = rs[ai][m];
#pragma unroll
                for (int bj = 0; bj < 2; ++bj) { f32x4 v0 = acc[ai][bj][m][0] * rstd + bv[bj][0], v1 = acc[ai][bj][m][1] * rstd + bv[bj][1];
#pragma unroll
                    for (int j = 0; j < 4; ++j) { const float a = fmaxf(v0[j], 0.f), b = fmaxf(v1[j], 0.f); v0[j] = a * a; v1[j] = b * b; }
                    *(u32x4*)(rowp + bj * HALF) = pack8(v0, v1); } }
    }
};

template <class Epi, class Sched, bool ALIGN_EPI, bool SP2, int KC, int LDA>
__device__ __forceinline__ void gemm_phase(const int tid, PG8_LAS unsigned char* lds, const Gemm g, const Sched& S, const Epi& E) {
    const int wid = __builtin_amdgcn_readfirstlane(tid >> 6), lane = tid & 63, wr = wid >> 2, wc = wid & 3, fr = lane & 15, fq = lane >> 4;
    constexpr int K = KC, nt = K / BK;
    unsigned voffA[2], voffB[2];
#pragma unroll
    for (int i = 0; i < 2; ++i) { int R, C; stage_rc(tid * 16 + i * 8192, R, C); const int Rb = Epi::PERM ? ((R & ~31) + perm32(R & 31)) : R;
        voffA[i] = (unsigned)(R * LDA + C) * 2u; voffB[i] = (unsigned)(Rb * K + C) * 2u; }
    constexpr size_t kstep = (size_t)(BK * 2);
    constexpr size_t hstep = (size_t)HALF * K * 2, hstepA = (size_t)HALF * LDA * 2;
    constexpr size_t tstep = 2 * hstep, tstepA = 2 * hstepA;
    const unsigned ldsw = (unsigned)wid * 1024u;
    const int aoff = lds_byte(wr * 64 + fr, fq * 8), boff = lds_byte(wc * 32 + fr, fq * 8);
#define PG8_SA(b, h) (((b) * 2 + (h)) * HTB)
#define PG8_SB(b, h) ((4 + (b) * 2 + (h)) * HTB)
#define PG8_STAGE(bufoff, gbase, voff) do { _Pragma("unroll") for (int _i = 0; _i < 2; ++_i) \
        __builtin_amdgcn_global_load_lds((const unsigned*)((const char*)(gbase) + (voff)[_i]), (PG8_LAS unsigned*)(lds + (bufoff) + ldsw + _i * 8192), 16, 0, 0); } while (0)
#define PG8_LDA(dst, b, h) do { _Pragma("unroll") for (int m = 0; m < 4; ++m) _Pragma("unroll") for (int k = 0; k < 2; ++k) dst[m][k] = *(const PG8_LAS bf16x8*)(lds + PG8_SA(b, h) + aoff + m * 2048 + k * 1024); } while (0)
#define PG8_LDB(dst, b, h) do { _Pragma("unroll") for (int n = 0; n < 2; ++n) _Pragma("unroll") for (int k = 0; k < 2; ++k) dst[n][k] = *(const PG8_LAS bf16x8*)(lds + PG8_SB(b, h) + boff + n * 2048 + k * 1024); } while (0)
#define PG8_MMA(ai, bj, At, Bt) do { __builtin_amdgcn_s_setprio(1); _Pragma("unroll") for (int m = 0; m < 4; ++m) _Pragma("unroll") for (int n = 0; n < 2; ++n) _Pragma("unroll") for (int k = 0; k < 2; ++k) \
        acc[ai][bj][m][n] = __builtin_amdgcn_mfma_f32_16x16x32_bf16(Bt[n][k], At[m][k], acc[ai][bj][m][n], 0, 0, 0); __builtin_amdgcn_s_setprio(0); } while (0)
#define PG8_WAIT_V(n) asm volatile("s_waitcnt vmcnt(" #n ")" ::: "memory")
#define PG8_WAIT_L(n) asm volatile("s_waitcnt lgkmcnt(" #n ")" ::: "memory")
#define PG8_BAR __builtin_amdgcn_s_barrier()
#define PG8_SCHED __builtin_amdgcn_sched_barrier(0)
    Unit cur, nxt; int ui = 0;
    if (!S.next(0, cur)) return;
    f32x4 acc[2][2][4][2];
#pragma unroll
    for (int a = 0; a < 2; ++a)
#pragma unroll
        for (int b = 0; b < 2; ++b)
#pragma unroll
            for (int m = 0; m < 4; ++m)
#pragma unroll
                for (int n = 0; n < 2; ++n) acc[a][b][m][n] = (f32x4){0.f, 0.f, 0.f, 0.f};
    bf16x8 At[4][2], B0[2][2], B1[2][2];
    const char* cA = (const char*)g.A + (size_t)cur.pm * tstepA; const char* cB = (const char*)g.Bt + (size_t)cur.pn * tstep;
    S.a_ready(cur);
    if constexpr (SP2) {
        PG8_STAGE(PG8_SB(0, 0), cB, voffB); PG8_STAGE(PG8_SB(0, 1), cB + hstep, voffB); PG8_STAGE(PG8_SA(0, 0), cA, voffA); PG8_STAGE(PG8_SA(0, 1), cA + hstepA, voffA);
        if (wr == 1) PG8_BAR;
        PG8_WAIT_V(2); PG8_BAR;
        PG8_STAGE(PG8_SB(1, 0), cB + kstep, voffB); PG8_STAGE(PG8_SA(1, 0), cA + kstep, voffA); PG8_STAGE(PG8_SB(1, 1), cB + hstep + kstep, voffB);
        PG8_WAIT_V(6); PG8_BAR;
    } else {
        PG8_STAGE(PG8_SB(0, 0), cB, voffB); PG8_STAGE(PG8_SA(0, 0), cA, voffA); PG8_STAGE(PG8_SB(0, 1), cB + hstep, voffB); PG8_STAGE(PG8_SA(0, 1), cA + hstepA, voffA);
        if (wr == 1) PG8_BAR;
        PG8_WAIT_V(4); PG8_BAR;
        PG8_STAGE(PG8_SB(1, 0), cB + kstep, voffB); PG8_STAGE(PG8_SA(1, 0), cA + kstep, voffA); PG8_STAGE(PG8_SB(1, 1), cB + hstep + kstep, voffB);
        PG8_WAIT_V(6); PG8_BAR;
    }
    for (;;) {
        const bool has_next = S.next(ui + 1, nxt);
        const char* nA = has_next ? (const char*)g.A + (size_t)nxt.pm * tstepA : cA; const char* nB = has_next ? (const char*)g.Bt + (size_t)nxt.pn * tstep : cB;
#pragma unroll 1
        for (int t = 0; t < nt; t += 2) {
            const bool last = (t == nt - 2);
            const char* a1 = cA + (size_t)(t + 1) * kstep;
            const char* a2 = last ? nA : cA + (size_t)(t + 2) * kstep; const char* b2 = last ? nB : cB + (size_t)(t + 2) * kstep;
            const char* a3 = a2 + kstep; const char* b3 = b2 + kstep;
            if (last && has_next) S.a_ready(nxt);
            if constexpr (SP2) {
            PG8_LDB(B0, 0, 0); PG8_LDB(B1, 0, 1); PG8_SCHED; PG8_LDA(At, 0, 0); PG8_STAGE(PG8_SA(1, 1), a1 + hstepA, voffA);
            PG8_WAIT_V(8); PG8_WAIT_L(0); PG8_BAR; PG8_MMA(0, 0, At, B0); PG8_MMA(0, 1, At, B1); PG8_BAR; PG8_SCHED;
            PG8_LDA(At, 0, 1); PG8_STAGE(PG8_SB(0, 0), b2, voffB); PG8_STAGE(PG8_SB(0, 1), b2 + hstep, voffB); PG8_STAGE(PG8_SA(0, 0), a2, voffA);
            PG8_WAIT_V(8); PG8_WAIT_L(0); PG8_BAR; PG8_MMA(1, 0, At, B0); PG8_MMA(1, 1, At, B1); PG8_BAR; PG8_SCHED;
            PG8_LDB(B0, 1, 0); PG8_LDB(B1, 1, 1); PG8_SCHED; PG8_LDA(At, 1, 0); PG8_STAGE(PG8_SA(0, 1), a2 + hstepA, voffA);
            PG8_WAIT_V(8); PG8_WAIT_L(0); PG8_BAR; PG8_MMA(0, 0, At, B0); PG8_MMA(0, 1, At, B1); PG8_BAR; PG8_SCHED;
            PG8_LDA(At, 1, 1); PG8_STAGE(PG8_SB(1, 0), b3, voffB); PG8_STAGE(PG8_SB(1, 1), b3 + hstep, voffB); PG8_STAGE(PG8_SA(1, 0), a3, voffA);
            PG8_WAIT_V(8); PG8_WAIT_L(0); PG8_BAR; PG8_MMA(1, 0, At, B0); PG8_MMA(1, 1, At, B1); PG8_BAR; PG8_SCHED;
            } else {
            PG8_LDB(B0, 0, 0); PG8_SCHED; PG8_LDA(At, 0, 0); PG8_STAGE(PG8_SA(1, 1), a1 + hstepA, voffA);
            PG8_WAIT_L(8); PG8_BAR; PG8_WAIT_L(0); PG8_MMA(0, 0, At, B0); PG8_BAR; PG8_SCHED;
            PG8_LDB(B1, 0, 1); PG8_STAGE(PG8_SB(0, 0), b2, voffB);
            PG8_BAR; PG8_WAIT_L(0); PG8_MMA(0, 1, At, B1); PG8_BAR;
            PG8_LDA(At, 0, 1); PG8_STAGE(PG8_SA(0, 0), a2, voffA);
            PG8_BAR; PG8_WAIT_L(0); PG8_MMA(1, 0, At, B0); PG8_BAR; PG8_SCHED;
            PG8_STAGE(PG8_SB(0, 1), b2 + hstep, voffB);
            PG8_WAIT_V(6); PG8_BAR; PG8_MMA(1, 1, At, B1); PG8_BAR;
            PG8_LDB(B0, 1, 0); PG8_SCHED; PG8_LDA(At, 1, 0); PG8_STAGE(PG8_SA(0, 1), a2 + hstepA, voffA);
            PG8_WAIT_L(8); PG8_BAR; PG8_WAIT_L(0); PG8_MMA(0, 0, At, B0); PG8_BAR; PG8_SCHED;
            PG8_LDB(B1, 1, 1); PG8_STAGE(PG8_SB(1, 0), b3, voffB);
            PG8_BAR; PG8_WAIT_L(0); PG8_MMA(0, 1, At, B1); PG8_BAR;
            PG8_LDA(At, 1, 1); PG8_STAGE(PG8_SA(1, 0), a3, voffA);
            PG8_BAR; PG8_WAIT_L(0); PG8_MMA(1, 0, At, B0); PG8_BAR; PG8_SCHED;
            PG8_STAGE(PG8_SB(1, 1), b3 + hstep, voffB);
            PG8_WAIT_V(6); PG8_BAR; PG8_MMA(1, 1, At, B1); PG8_BAR;
            }
        }
        if constexpr (ALIGN_EPI) { if (wr == 0) PG8_BAR; }
        if constexpr (!Epi::AFTER_DRAIN) { E(acc, cur, wr, wc, fr, fq); S.done(cur); }
        if (!has_next) break;
#pragma unroll
        for (int a = 0; a < 2; ++a)
#pragma unroll
            for (int b = 0; b < 2; ++b)
#pragma unroll
                for (int m = 0; m < 4; ++m)
#pragma unroll
                    for (int n = 0; n < 2; ++n) acc[a][b][m][n] = (f32x4){0.f, 0.f, 0.f, 0.f};
        cur = nxt; cA = nA; cB = nB; ++ui;
        if constexpr (ALIGN_EPI) { if (wr == 1) PG8_BAR; }
    }
    PG8_WAIT_V(0);
    if constexpr (!ALIGN_EPI) { if (wr == 0) PG8_BAR; }
    PG8_BAR;
    if constexpr (Epi::AFTER_DRAIN) { E.fused(acc, cur, wr, wc, fr, fq, lds, wid, lane); S.done(cur); }
#undef PG8_SA
#undef PG8_SB
#undef PG8_STAGE
#undef PG8_LDA
#undef PG8_LDB
#undef PG8_MMA
#undef PG8_WAIT_V
#undef PG8_WAIT_L
#undef PG8_BAR
#undef PG8_SCHED
}
}
namespace attn_body {
using bf16=__hip_bfloat16;
using bf16x8=__attribute__((ext_vector_type(8)))short;
using s16x4=__attribute__((ext_vector_type(4)))short;
using f32x16=__attribute__((ext_vector_type(16)))float;
using u32x4=__attribute__((ext_vector_type(4)))unsigned;
constexpr int BATCH=8,NHEAD=8,SEQ=4096,D=64,DM=5120;
constexpr int NW=8,QBLK=32,QB=QBLK*NW,KVBLK=64,NQB=SEQ/QB;
constexpr int ATTN_PITCH=DM, ATTN_UNIT_ROWS=QB;
__device__ __forceinline__ int crow(int r,int hi){return (r&3)+8*(r>>2)+4*hi;}
#define SBAR() __builtin_amdgcn_sched_barrier(0)
__device__ __forceinline__ void cmask(f32x16&p0,f32x16&p1,int jb,int qrel,int hi){
  const float NEG=-INFINITY; int kb=64*jb+4*hi;
  #pragma unroll
  for(int r=0;r<16;++r){int kv=kb+(r&3)+8*(r>>2); if(kv>qrel)p0[r]=NEG; if(kv+32>qrel)p1[r]=NEG;}
}

constexpr int NSLOT=3, SLOTB=8192;
constexpr int LDS_K=0, LDS_V=NSLOT*SLOTB, LDS_WS=2*NSLOT*SLOTB, LDS_OST=LDS_WS+NW*64*4, LDS_BYTES=LDS_OST+NW*4096;
constexpr float C2=0.125f*1.4426950408889634f;
__device__ __forceinline__ void glds16(const void*gsrc,unsigned lds_dst){unsigned keep;
  asm volatile("s_mov_b32 %0, m0\n\ts_mov_b32 m0, %2\n\ts_nop 0\n\tglobal_load_lds_dwordx4 %1, off\n\ts_mov_b32 m0, %0":"=&s"(keep):"v"(gsrc),"s"(lds_dst):"memory");}
__device__ __forceinline__ float max3f(float a,float b,float c){float r;asm("v_max3_f32 %0, %1, %2, %3":"=v"(r):"v"(a),"v"(b),"v"(c));return r;}
__device__ __forceinline__ float max2f(float a,float b){float r;asm("v_max_f32_e32 %0, %1, %2":"=v"(r):"v"(a),"v"(b));return r;}
__device__ __forceinline__ float fadd_s(float a,float b){float r;asm("v_add_f32_e32 %0, %1, %2":"=v"(r):"v"(a),"v"(b));return r;}
__device__ __forceinline__ float fsub_s(float a,float b){float r;asm("v_sub_f32_e32 %0, %1, %2":"=v"(r):"v"(a),"v"(b));return r;}
typedef float f32x2_t __attribute__((ext_vector_type(2))); typedef __bf16 bf16x2_t __attribute__((ext_vector_type(2)));
__device__ __forceinline__ unsigned cvtpk_s(float lo,float hi){f32x2_t v={lo,hi};bf16x2_t b=__builtin_convertvector(v,bf16x2_t);return __builtin_bit_cast(unsigned,b);}
#define WAIT_BAR(N) asm volatile("s_waitcnt vmcnt(" #N ") lgkmcnt(0)\n\ts_barrier":::"memory")

__device__ __forceinline__ void qkt(f32x16&p0,f32x16&p1,const char*Kslot,const bf16x8*qr,const f32x16&negm,int r32,int hi){
  const char*kb=Kslot+hi*1024+r32*16;
  #pragma unroll
  for(int d0=0;d0<4;++d0){
    const bf16x8 b0=*reinterpret_cast<const bf16x8*>(kb+d0*2048);
    const bf16x8 b1=*reinterpret_cast<const bf16x8*>(kb+d0*2048+512);
    if(d0==0){p0=__builtin_amdgcn_mfma_f32_32x32x16_bf16(b0,qr[0],negm,0,0,0);p1=__builtin_amdgcn_mfma_f32_32x32x16_bf16(b1,qr[0],negm,0,0,0);}
    else{p0=__builtin_amdgcn_mfma_f32_32x32x16_bf16(b0,qr[d0],p0,0,0,0);p1=__builtin_amdgcn_mfma_f32_32x32x16_bf16(b1,qr[d0],p1,0,0,0);}}
}
typedef __attribute__((address_space(3))) const char* lds_cptr;
typedef short v4i16_t __attribute__((ext_vector_type(4)));
__device__ __forceinline__ void kload8(bf16x8*kf,lds_cptr kp){
  kf[0]=*(const __attribute__((address_space(3))) bf16x8*)(kp);      kf[1]=*(const __attribute__((address_space(3))) bf16x8*)(kp+512);
  kf[2]=*(const __attribute__((address_space(3))) bf16x8*)(kp+2048); kf[3]=*(const __attribute__((address_space(3))) bf16x8*)(kp+2560);
  kf[4]=*(const __attribute__((address_space(3))) bf16x8*)(kp+4096); kf[5]=*(const __attribute__((address_space(3))) bf16x8*)(kp+4608);
  kf[6]=*(const __attribute__((address_space(3))) bf16x8*)(kp+6144); kf[7]=*(const __attribute__((address_space(3))) bf16x8*)(kp+6656);
}
__device__ __forceinline__ void kload2(bf16x8*kf,lds_cptr kp,int j){ kf[2*j]=*(const __attribute__((address_space(3))) bf16x8*)(kp+j*2048); kf[2*j+1]=*(const __attribute__((address_space(3))) bf16x8*)(kp+j*2048+512); }
__device__ __forceinline__ s16x4 vtr(lds_cptr p){ return __builtin_bit_cast(s16x4,__builtin_amdgcn_ds_read_tr16_b64_v4i16((__attribute__((address_space(3))) v4i16_t*)p)); }
__device__ __forceinline__ float rowmax(const f32x16&p0,const f32x16&p1){
  float a=max3f(p0[0],p0[1],p1[0]),b=max3f(p0[2],p0[3],p1[1]);a=max3f(a,p1[2],p1[3]);
  #pragma unroll
  for(int r=4;r<16;r+=4){a=max3f(a,p0[r],p0[r+1]);b=max3f(b,p0[r+2],p0[r+3]);a=max3f(a,p1[r],p1[r+1]);b=max3f(b,p1[r+2],p1[r+3]);}
  const float m=max2f(a,b);
  auto rr=__builtin_amdgcn_permlane32_swap(__float_as_uint(m),__float_as_uint(m),false,false);
  return max2f(__uint_as_float(rr[0]),__uint_as_float(rr[1]));
}
__device__ __forceinline__ void pv(f32x16*o,int vb,bf16x8 pa0,bf16x8 pa1,bf16x8 pa2,bf16x8 pa3){
  #pragma unroll
  for(int d0=0;d0<2;++d0){s16x4 lo[4],hi[4];
    #pragma unroll
    for(int ks=0;ks<4;++ks){
      asm volatile("ds_read_b64_tr_b16 %0,%1 offset:%c2":"=&v"(lo[ks]):"v"(vb),"i"(d0*4096+ks*1024):"memory");
      asm volatile("ds_read_b64_tr_b16 %0,%1 offset:%c2":"=&v"(hi[ks]):"v"(vb),"i"(d0*4096+ks*1024+512):"memory");}
    asm volatile("s_waitcnt lgkmcnt(0)":::"memory");SBAR();
    #define PK(k) (bf16x8){lo[k][0],lo[k][1],lo[k][2],lo[k][3],hi[k][0],hi[k][1],hi[k][2],hi[k][3]}
    o[d0]=__builtin_amdgcn_mfma_f32_32x32x16_bf16(pa0,PK(0),o[d0],0,0,0);
    o[d0]=__builtin_amdgcn_mfma_f32_32x32x16_bf16(pa1,PK(1),o[d0],0,0,0);
    o[d0]=__builtin_amdgcn_mfma_f32_32x32x16_bf16(pa2,PK(2),o[d0],0,0,0);
    o[d0]=__builtin_amdgcn_mfma_f32_32x32x16_bf16(pa3,PK(3),o[d0],0,0,0);
    #undef PK
  }
}

#ifndef ATTN_STORE16
#define ATTN_STORE16(p,v) (*(u32x4*)(p)=(v))
#endif
template<int THRL> __device__ __forceinline__ void attn_unit(int b,int h,int qb,const bf16*Q,const bf16*__restrict__ K,const bf16*__restrict__ V,bf16*O,char*shm,const int tid){
  const int lane=tid&63,r32=lane&31,hi=lane>>5; const int wid=__builtin_amdgcn_readfirstlane(tid>>6);
  const long rowbase=(long)b*SEQ; const int q0=qb*QB;
  const bf16*Qw=Q+(rowbase+q0+wid*QBLK)*DM+h*D;
  const bf16*Kh=K+rowbase*DM+(h>>2)*D,*Vh=V+rowbase*DM+(h>>2)*D;
  const unsigned lds0=(unsigned)(uintptr_t)shm;
  float*wsf=(float*)(shm+LDS_WS)+wid*64;
  const bf16*ksrc=Kh+(long)lane*DM+wid*8;
  const bf16*vsrc=Vh+(long)(16*(wid&3)+(lane>>2))*DM+(wid>>2)*32+(lane&3)*8;
  const unsigned kdst=lds0+LDS_K+wid*1024, vdst=lds0+LDS_V+wid*1024;
  #define DMA_K(t,slot) glds16(ksrc+(long)(t)*KVBLK*DM,(unsigned)__builtin_amdgcn_readfirstlane(kdst+(slot)))
  #define DMA_V(t,slot) glds16(vsrc+(long)(t)*KVBLK*DM,(unsigned)__builtin_amdgcn_readfirstlane(vdst+(slot)))
  const int vb0=(int)(lds0+LDS_V)+((lane>>4)&1)*32+(lane&3)*8+(4*hi+((lane&15)>>2))*64;
  const char*Kbase=shm+LDS_K; bf16x8 kf[8];
  const lds_cptr shm3=(lds_cptr)shm; const lds_cptr kp0=shm3+LDS_K+hi*1024+r32*16; const lds_cptr vp0=shm3+LDS_V+((lane>>4)&1)*32+(lane&3)*8+(4*hi+((lane&15)>>2))*64;
  const int NT=SEQ/KVBLK;
  DMA_K(0,0);DMA_V(0,0);DMA_K(1,SLOTB);
  bf16x8 qr[4];
  #pragma unroll
  for(int d0=0;d0<4;++d0)qr[d0]=*reinterpret_cast<const bf16x8*>(&Qw[(long)r32*DM+d0*16+hi*8]);
  float mhat=0.f,l_reg=0.f;f32x16 o[2];o[0]=f32x16{};o[1]=f32x16{};f32x16 negm=f32x16{};asm volatile("":"+v"(negm));
  const int qrel=wid*QBLK+r32;
  #define CMASK(P0,P1,t) do{}while(0)
  bool resc=false;
  #define START(P0,P1) do{ const float rm=rowmax(P0,P1); resc=false; \
    { const float dl=rm; mhat=fadd_s(mhat,dl); \
      _Pragma("unroll") for(int r=0;r<16;++r){P0[r]=fsub_s(P0[r],dl);P1[r]=fsub_s(P1[r],dl);} \
      _Pragma("unroll") for(int r=0;r<16;++r)negm[r]=-mhat; asm volatile("":"+v"(negm)); } \
    _Pragma("unroll") for(int r=0;r<16;++r)P0[r]=__builtin_amdgcn_exp2f(P0[r]); }while(0)
  #define RESC() do{ if(resc){ asm volatile("s_waitcnt lgkmcnt(0)":::"memory"); \
      _Pragma("unroll") for(int d_=0;d_<2;++d_) _Pragma("unroll") for(int r=0;r<16;++r)o[d_][r]*=wsf[crow(r,hi)]; } }while(0)
  f32x16 pA0,pA1,pB0,pB1;
  int sl_prev=0,sl_cur=0,sl_next=SLOTB;
  #define ROT() do{sl_prev=sl_cur;sl_cur=sl_next;sl_next=(sl_next==(NSLOT-1)*SLOTB)?0:sl_next+SLOTB;}while(0)
  DMA_K(2,2*SLOTB);
  WAIT_BAR(3);
  qkt(pA0,pA1,Kbase,qr,negm,r32,hi);asm volatile("s_nop 15\n\ts_nop 7":"+v"(pA0),"+v"(pA1));CMASK(pA0,pA1,0);
  START(pA0,pA1);
  _Pragma("unroll") for(int r=0;r<16;++r)pA1[r]=__builtin_amdgcn_exp2f(pA1[r]);
  WAIT_BAR(0);
  DMA_K(3,0);DMA_V(1,SLOTB);
  ROT();
  kload8(kf,kp0+sl_cur);
  WAIT_BAR(2);
  s16x4 vlo[8],vhi[8]; u32x4 pw0,pw1,pw2,pw3;
  #define PKW(P,B) cvtpk_s(P[B],P[B+1])
  #define PAF(k) __builtin_bit_cast(bf16x8,pw##k)
  #define VFR(i) (bf16x8){vlo[i][0],vlo[i][1],vlo[i][2],vlo[i][3],vhi[i][0],vhi[i][1],vhi[i][2],vhi[i][3]}
  #define PIN(x) asm volatile("":"+v"(x))
  #define MX3(a,b,c) __builtin_fmaxf(__builtin_fmaxf((a),(b)),(c))
  #define GAPA(MF,A0,A1,A2,A3,W0,W1,PW) do{ MF; sacc+=A0; sacc+=A1; sacc+=A2; sacc+=A3; PIN(sacc); W0; W1; PIN(PW); SBAR(); }while(0)
  #define EX(v) __builtin_amdgcn_exp2f(v)
  #define GAPB(MF,X,B) do{ MF; X[B]=EX(X[B]); X[B+1]=EX(X[B+1]); X[B+2]=EX(X[B+2]); X[B+3]=EX(X[B+3]); PIN(X); SBAR(); }while(0)
  #define VRD(i) do{ vlo[i]=vtr(vp_+(((i)>>2)*4096+((i)&3)*1024)); vhi[i]=vtr(vp_+(((i)>>2)*4096+((i)&3)*1024+512)); }while(0)
  #define KRD(G,j) do{ if(G){ kload2(kf,kp0+sl_next,j); SBAR(); } }while(0)
  #define STEP(C0,C1,P0,P1,t,GK,GV,GL) do{ SBAR(); \
    const lds_cptr vp_=vp0+sl_prev; \
    VRD(0); SBAR(); float sacc=(P0[0]+P0[1]); \
    GAPA(C0=__builtin_amdgcn_mfma_f32_32x32x16_bf16(kf[0],qr[0],negm,0,0,0), P0[2],P0[3],P0[4],P0[5],     pw0[0]=PKW(P0,0), pw0[1]=PKW(P0,2), pw0); \
    VRD(4); SBAR(); GAPA(C1=__builtin_amdgcn_mfma_f32_32x32x16_bf16(kf[1],qr[0],negm,0,0,0), P0[6],P0[7],P0[8],P0[9],     pw0[2]=PKW(P0,4), pw0[3]=PKW(P0,6), pw0); \
    VRD(1); SBAR(); GAPA(C0=__builtin_amdgcn_mfma_f32_32x32x16_bf16(kf[2],qr[1],C0,0,0,0),   P0[10],P0[11],P0[12],P0[13], pw1[0]=PKW(P0,8), pw1[1]=PKW(P0,10), pw1); \
    VRD(5); SBAR(); GAPA(C1=__builtin_amdgcn_mfma_f32_32x32x16_bf16(kf[3],qr[1],C1,0,0,0),   P0[14],P0[15],P1[0],P1[1],   pw1[2]=PKW(P0,12),pw1[3]=PKW(P0,14), pw1); \
    VRD(2); SBAR(); GAPA(C0=__builtin_amdgcn_mfma_f32_32x32x16_bf16(kf[4],qr[2],C0,0,0,0),   P1[2],P1[3],P1[4],P1[5],     pw2[0]=PKW(P1,0), pw2[1]=PKW(P1,2), pw2); \
    VRD(6); SBAR(); GAPA(C1=__builtin_amdgcn_mfma_f32_32x32x16_bf16(kf[5],qr[2],C1,0,0,0),   P1[6],P1[7],P1[8],P1[9],     pw2[2]=PKW(P1,4), pw2[3]=PKW(P1,6), pw2); \
    VRD(3); SBAR(); GAPA(C0=__builtin_amdgcn_mfma_f32_32x32x16_bf16(kf[6],qr[3],C0,0,0,0),   P1[10],P1[11],P1[12],P1[13], pw3[0]=PKW(P1,8), pw3[1]=PKW(P1,10), pw3); \
    VRD(7); SBAR(); GAPA(C1=__builtin_amdgcn_mfma_f32_32x32x16_bf16(kf[7],qr[3],C1,0,0,0),   P1[14],P1[15],0.f,0.f,       pw3[2]=PKW(P1,12),pw3[3]=PKW(P1,14), pw3); \
    l_reg+=sacc; \
    if(GK){DMA_K((t)+3,sl_cur);} if(GV){DMA_V((t)+1,sl_next);} \
    CMASK(C0,C1,t); \
    { float a=MX3(C0[0],C0[1],C1[0]),b=MX3(C0[2],C0[3],C1[1]); a=MX3(a,C1[2],C1[3]); \
      _Pragma("unroll") for(int r=4;r<16;r+=4){a=MX3(a,C0[r],C0[r+1]);b=MX3(b,C0[r+2],C0[r+3]);a=MX3(a,C1[r],C1[r+1]);b=MX3(b,C1[r+2],C1[r+3]);} \
      float rm=__builtin_fmaxf(a,b); { auto rr=__builtin_amdgcn_permlane32_swap(__float_as_uint(rm),__float_as_uint(rm),false,false); rm=__builtin_fmaxf(__uint_as_float(rr[0]),__uint_as_float(rr[1])); } \
      resc=false; \
      if(__builtin_expect(__any(rm>(float)THRL),0)){ const float dl=__builtin_fmaxf(rm,0.f); mhat+=dl; \
        _Pragma("unroll") for(int r=0;r<16;++r){C0[r]-=dl;C1[r]-=dl;} \
        _Pragma("unroll") for(int r=0;r<16;++r)negm[r]=-mhat; asm volatile("":"+v"(negm)); \
        const float f=__builtin_amdgcn_exp2f(-dl); l_reg*=f; if(hi==0)wsf[r32]=f; resc=true; } } \
    SBAR(); \
    GAPB(o[0]=__builtin_amdgcn_mfma_f32_32x32x16_bf16(PAF(0),VFR(0),o[0],0,0,0), C0,0); \
    GAPB(o[1]=__builtin_amdgcn_mfma_f32_32x32x16_bf16(PAF(0),VFR(4),o[1],0,0,0), C0,4); \
    KRD(GL,0); GAPB(o[0]=__builtin_amdgcn_mfma_f32_32x32x16_bf16(PAF(1),VFR(1),o[0],0,0,0), C0,8); \
    KRD(GL,1); GAPB(o[1]=__builtin_amdgcn_mfma_f32_32x32x16_bf16(PAF(1),VFR(5),o[1],0,0,0), C0,12); \
    KRD(GL,2); GAPB(o[0]=__builtin_amdgcn_mfma_f32_32x32x16_bf16(PAF(2),VFR(2),o[0],0,0,0), C1,0); \
    KRD(GL,3); GAPB(o[1]=__builtin_amdgcn_mfma_f32_32x32x16_bf16(PAF(2),VFR(6),o[1],0,0,0), C1,4); \
    GAPB(o[0]=__builtin_amdgcn_mfma_f32_32x32x16_bf16(PAF(3),VFR(3),o[0],0,0,0), C1,8); \
    GAPB(o[1]=__builtin_amdgcn_mfma_f32_32x32x16_bf16(PAF(3),VFR(7),o[1],0,0,0), C1,12); \
    }while(0)
  int t=1;
  #undef CMASK
  #define CMASK(P0,P1,t) do{}while(0)
  for(;t+5<NT;t+=2){
    STEP(pB0,pB1,pA0,pA1,t,true,true,true);     WAIT_BAR(2); RESC(); ROT();
    STEP(pA0,pA1,pB0,pB1,t+1,true,true,true);   WAIT_BAR(2); RESC(); ROT();
  }
  #undef CMASK
  #define CMASK(P0,P1,t) do{}while(0)
  #define ENDW(tt) do{ if((tt)+3<NT){WAIT_BAR(2);} else if((tt)+2<NT){WAIT_BAR(1);} else {WAIT_BAR(0);} }while(0)
  for(;t+1<NT;t+=2){
    STEP(pB0,pB1,pA0,pA1,t,(t+3<NT),(t+1<NT),(t+1<NT));       ENDW(t);   RESC(); ROT();
    STEP(pA0,pA1,pB0,pB1,t+1,(t+4<NT),(t+2<NT),(t+2<NT));     ENDW(t+1); RESC(); ROT();
  }
  STEP(pB0,pB1,pA0,pA1,NT-1,false,false,false); RESC();
  { float sacc=pB0[0]+pB0[1]; _Pragma("unroll") for(int r=2;r<16;++r)sacc+=pB0[r]; _Pragma("unroll") for(int r=0;r<16;++r)sacc+=pB1[r]; l_reg+=sacc;
    pw0=(u32x4){PKW(pB0,0),PKW(pB0,2),PKW(pB0,4),PKW(pB0,6)};pw1=(u32x4){PKW(pB0,8),PKW(pB0,10),PKW(pB0,12),PKW(pB0,14)};pw2=(u32x4){PKW(pB1,0),PKW(pB1,2),PKW(pB1,4),PKW(pB1,6)};pw3=(u32x4){PKW(pB1,8),PKW(pB1,10),PKW(pB1,12),PKW(pB1,14)};
    SBAR(); pv(o,vb0+sl_cur,PAF(0),PAF(1),PAF(2),PAF(3)); }
  #undef PKW
  #undef PAF
  #undef VFR
  #undef PIN
  #undef MX3
  #undef GAPA
  #undef GAPB
  #undef EX
  #undef VRD
  #undef KRD
  #undef STEP
  #undef ENDW
  {auto rr=__builtin_amdgcn_permlane32_swap(__float_as_uint(l_reg),__float_as_uint(l_reg),false,false);l_reg=__uint_as_float(rr[0])+__uint_as_float(rr[1]);}
  if(hi==0)wsf[32+r32]=l_reg;asm volatile("s_waitcnt lgkmcnt(0)":::"memory");
  float rli[16];
  #pragma unroll
  for(int r=0;r<16;++r)rli[r]=__builtin_amdgcn_rcpf(wsf[32+crow(r,hi)]);
  bf16*Ow=O+(rowbase+q0+wid*QBLK)*DM+h*D;
  { bf16*stg=(bf16*)(shm+LDS_OST)+wid*2048;
    #pragma unroll
    for(int r=0;r<16;++r){const int orow=crow(r,hi);
      #pragma unroll
      for(int d0=0;d0<2;++d0)stg[orow*64+d0*32+r32]=__float2bfloat16(o[d0][r]*rli[r]);}
    asm volatile("s_waitcnt lgkmcnt(0)":::"memory");
    #pragma unroll
    for(int i=0;i<4;++i){const int row=i*8+(lane>>3),ch=lane&7; const u32x4 v=*(const u32x4*)(stg+row*64+ch*8); ATTN_STORE16(Ow+(long)row*DM+ch*8,v);} }
  asm volatile("s_waitcnt lgkmcnt(0)\n\ts_barrier":::"memory");
  #undef DMA_K
  #undef DMA_V
  #undef CMASK
  #undef START
  #undef RESC
  #undef ROT
}
constexpr int ATTN_LDS_BYTES=LDS_BYTES;
#undef SBAR
#undef WAIT_BAR
}
namespace dil {
#define DLAS __attribute__((address_space(3)))
typedef unsigned short bf16_t;
typedef short bf16x8 __attribute__((ext_vector_type(8)));
typedef short s16x4 __attribute__((ext_vector_type(4)));
typedef float f32x16 __attribute__((ext_vector_type(16)));
typedef unsigned u32x4 __attribute__((ext_vector_type(4)));
constexpr int ROWB = 144;
constexpr int WAVE_LDS = 32 * ROWB + 256;
__device__ __forceinline__ int crow(int r, int hi) { return (r & 3) + 8 * (r >> 2) + 4 * hi; }
typedef float f32x2d __attribute__((ext_vector_type(2))); typedef __bf16 bf16x2d __attribute__((ext_vector_type(2)));
__device__ __forceinline__ unsigned cvtpk(float lo, float hi) { const f32x2d v = {lo, hi}; const bf16x2d b = __builtin_convertvector(v, bf16x2d); return __builtin_bit_cast(unsigned, b); }
__device__ __forceinline__ int clampi(int v) { return v < 0 ? 0 : (v > SEQ - 1 ? SEQ - 1 : v); }

__device__ __forceinline__ void load_tile(const bf16_t* Pb, int base, int dg, int m0, int kcol, int vcol, int lane, bf16x8 (&kf)[4], u32x4 (&vr)[4], bool doK, bool doV) {
    const int r32 = lane & 31, hi = lane >> 5;
    const int tk = clampi(base + dg * (m0 + r32));
    const bf16_t* kp = Pb + (size_t)tk * PP + kcol + 8 * hi;
    if (doK) {
#pragma unroll
    for (int d0 = 0; d0 < 4; ++d0) kf[d0] = *(const bf16x8*)(kp + 16 * d0); }
    if (doV)
#pragma unroll
    for (int c = 0; c < 4; ++c) { const int tv = clampi(base + dg * (m0 + 8 * c + (lane >> 3)));
        vr[c] = *(const u32x4*)(Pb + (size_t)tv * PP + vcol + 8 * (lane & 7)); }
}

__device__ __forceinline__ void dil_group(const bf16_t* Pb, int base, int qstride, int dg, int rho, int ntile, int qcol, DLAS unsigned char* wl, DLAS float* sc, int lane, int vaddr,
                                          float& m_run, float& l_run, f32x16& o0, f32x16& o1) {
    const int r32 = lane & 31, hi = lane >> 5; const int kcol = qcol + 256, vcol = qcol + 512;
    bf16x8 qf[4];
    { const bf16_t* qp = Pb + (size_t)(base + qstride * r32) * PP + qcol + 8 * hi;
#pragma unroll
      for (int d0 = 0; d0 < 4; ++d0) qf[d0] = *(const bf16x8*)(qp + 16 * d0); }
    bf16x8 kf[4], kn[4]; u32x4 vr[4];
    load_tile(Pb, base, dg, -64, kcol, vcol, lane, kf, vr, true, false);
    for (int T = 0; T < ntile; ++T) {
        const int m0 = -64 + 32 * T;
        load_tile(Pb, base, dg, m0, kcol, vcol, lane, kn, vr, false, true);
        if (T + 1 < ntile) load_tile(Pb, base, dg, m0 + 32, kcol, vcol, lane, kn, vr, true, false);
        f32x16 p = {};
#pragma unroll
        for (int d0 = 0; d0 < 4; ++d0) p = __builtin_amdgcn_mfma_f32_32x32x16_bf16(kf[d0], qf[d0], p, 0, 0, 0);
#pragma unroll
        for (int c = 0; c < 4; ++c) *(DLAS u32x4*)(wl + (8 * c + (lane >> 3)) * ROWB + (lane & 7) * 16) = vr[c];
        float mx = -1e30f;
        const int dmh = m0 + 64 - rho * r32 + 4 * hi;
        const int tokh = base + dg * (m0 + 4 * hi);
#pragma unroll
        for (int r = 0; r < 16; ++r) { const int cr = (r & 3) + 8 * (r >> 2);
            p[r] = (((unsigned)(dmh + cr) <= 128u) && ((unsigned)(tokh + dg * cr) < (unsigned)SEQ)) ? p[r] : -1e30f; mx = fmaxf(mx, p[r]); }
        mx = fmaxf(mx, __shfl_xor(mx, 32));
        const float m_new = fmaxf(m_run, mx), alpha = __builtin_amdgcn_exp2f(m_run - m_new); m_run = m_new;
        float psum = 0.f;
#pragma unroll
        for (int r = 0; r < 16; ++r) { const float e = (p[r] > -1e29f) ? __builtin_amdgcn_exp2f(p[r] - m_new) : 0.f; p[r] = e; psum += e; }
        l_run = l_run * alpha + psum;
        if (!__all(alpha == 1.0f)) {
            if (hi == 0) sc[r32] = alpha;
#pragma unroll
            for (int r = 0; r < 16; ++r) { const float a = sc[crow(r, hi)]; o0[r] *= a; o1[r] *= a; }
        }
        u32x4 pk0, pk1;
        pk0.x = cvtpk(p[0], p[1]); pk0.y = cvtpk(p[2], p[3]); pk0.z = cvtpk(p[4], p[5]); pk0.w = cvtpk(p[6], p[7]);
        pk1.x = cvtpk(p[8], p[9]); pk1.y = cvtpk(p[10], p[11]); pk1.z = cvtpk(p[12], p[13]); pk1.w = cvtpk(p[14], p[15]);
        const bf16x8 pa0 = __builtin_bit_cast(bf16x8, pk0), pa1 = __builtin_bit_cast(bf16x8, pk1);
#pragma unroll
        for (int s = 0; s < 2; ++s) {
#pragma unroll
            for (int d0 = 0; d0 < 2; ++d0) {
                DLAS unsigned char* va = wl + vaddr + (16 * s + 4 * hi) * ROWB + d0 * 64;
                const s16x4 lo = __builtin_bit_cast(s16x4, __builtin_amdgcn_ds_read_tr16_b64_v4i16((DLAS s16x4*)va));
                const s16x4 hh = __builtin_bit_cast(s16x4, __builtin_amdgcn_ds_read_tr16_b64_v4i16((DLAS s16x4*)(va + 8 * ROWB)));
                const bf16x8 vf = (bf16x8){lo[0], lo[1], lo[2], lo[3], hh[0], hh[1], hh[2], hh[3]};
                if (d0 == 0) o0 = __builtin_amdgcn_mfma_f32_32x32x16_bf16(s == 0 ? pa0 : pa1, vf, o0, 0, 0, 0);
                else         o1 = __builtin_amdgcn_mfma_f32_32x32x16_bf16(s == 0 ? pa0 : pa1, vf, o1, 0, 0, 0);
            }
        }
#pragma unroll
        for (int i = 0; i < 4; ++i) kf[i] = kn[i];
    }
}
__device__ __forceinline__ void dil_pass1(bf16_t* P, int grp, int j, DLAS unsigned char* wl, int lane, float* SO, float* SM, float* SL) {
    const int r32 = lane & 31, hi = lane >> 5; const int b = grp >> 5, h = (grp >> 3) & 3, blk = grp & 7; const int base = 512 * blk + 32 * j;
    const bf16_t* Pb = P + (size_t)b * SEQ * PP; DLAS float* sc = (DLAS float*)(wl + 32 * ROWB);
    const int vaddr = ((lane & 15) >> 2) * ROWB + (((lane >> 4) & 1) * 16 + (lane & 3) * 4) * 2;
    float m_run = -1e30f, l_run = 0.f; f32x16 o0 = {}, o1 = {};
    dil_group(Pb, base, 1, 1, 1, 5, C_B0 + 64 * h, wl, sc, lane, vaddr, m_run, l_run, o0, o1);
    l_run += __shfl_xor(l_run, 32);
    const size_t srow = (size_t)h * SEQ + base; SO += (size_t)b * 2097152; SM += (size_t)b * 2097152; SL += (size_t)b * 2097152;
    if (hi == 0) { SM[srow + r32] = m_run; SL[srow + r32] = l_run; }
#pragma unroll
    for (int r = 0; r < 16; ++r) { float* so = SO + (srow + crow(r, hi)) * 64 + r32; so[0] = o0[r]; so[32] = o1[r]; }
}
__device__ __forceinline__ void dil_pass2(bf16_t* P, int grp, int rr, DLAS unsigned char* wl, int lane, const float* SO, const float* SM, const float* SL) {
    const int r32 = lane & 31, hi = lane >> 5; const int b = grp >> 5, h = (grp >> 3) & 3, blk = grp & 7; const int base = 512 * blk + rr;
    bf16_t* Pb = P + (size_t)b * SEQ * PP; DLAS float* sc = (DLAS float*)(wl + 32 * ROWB);
    const int vaddr = ((lane & 15) >> 2) * ROWB + (((lane >> 4) & 1) * 16 + (lane & 3) * 4) * 2;
    const size_t srow = (size_t)h * SEQ + base; SO += (size_t)b * 2097152; SM += (size_t)b * 2097152; SL += (size_t)b * 2097152;
    float m_run = SM[srow + 16 * r32], l_run = (hi == 0) ? SL[srow + 16 * r32] : 0.f; f32x16 o0, o1;
#pragma unroll
    for (int r = 0; r < 16; ++r) { const float* so = SO + (srow + 16 * crow(r, hi)) * 64 + r32; o0[r] = so[0]; o1[r] = so[32]; }
#pragma unroll 1
    for (int g = 1; g <= 2; ++g) dil_group(Pb, base, 16, 1 << (2 * g), 16 >> (2 * g), g == 1 ? 8 : 5, C_B0 + 768 * g + 64 * h, wl, sc, lane, vaddr, m_run, l_run, o0, o1);
    l_run += __shfl_xor(l_run, 32);
    if (hi == 0) sc[32 + r32] = __builtin_amdgcn_rcpf(l_run);
    bf16_t* op = Pb + (size_t)base * PP + C_OB + 64 * h + r32;
#pragma unroll
    for (int r = 0; r < 16; ++r) { const int q = crow(r, hi); const float inv = sc[32 + q];
        const __hip_bfloat16 a = __float2bfloat16(o0[r] * inv), c = __float2bfloat16(o1[r] * inv);
        op[(size_t)(16 * q) * PP] = __builtin_bit_cast(unsigned short, a); op[(size_t)(16 * q) * PP + 32] = __builtin_bit_cast(unsigned short, c); }
}
}


namespace naive {
__device__ __forceinline__ float bf2f(unsigned short v) { return __uint_as_float((unsigned)v << 16); }
__device__ __forceinline__ float wmax(float v) {
#pragma unroll
    for (int o = 1; o < 64; o <<= 1) v = fmaxf(v, __shfl_xor(v, o));
    return v;
}
__device__ __forceinline__ float wsum(float v) {
#pragma unroll
    for (int o = 1; o < 64; o <<= 1) v += __shfl_xor(v, o);
    return v;
}
__device__ __forceinline__ void dense_task(unsigned short* P, int task, __attribute__((address_space(3))) float* qs, int lane) {
    const int m = task >> 3, hq = task & 7, b = m >> 12;
    unsigned short* prow = P + (size_t)m * PP + C_QA + 64 * hq;
    qs[lane] = bf2f(prow[lane]);
    const unsigned short* kb = P + (size_t)b * SEQ * PP + C_KA + 64 * (hq >> 2);
    const unsigned short* vb = P + (size_t)b * SEQ * PP + C_VA + 64 * (hq >> 2);
    float m_run = -1e30f, l = 0.f, o = 0.f;
    for (int kc = 0; kc < SEQ / 64; ++kc) {
        const unsigned short* kr = kb + (size_t)(kc * 64 + lane) * PP;
        float s = 0.f;
#pragma unroll 8
        for (int d = 0; d < 64; ++d) s += qs[d] * bf2f(kr[d]);
        const float m_new = fmaxf(m_run, wmax(s)), alpha = __builtin_amdgcn_exp2f(m_run - m_new), p = __builtin_amdgcn_exp2f(s - m_new);
        m_run = m_new; l = l * alpha + wsum(p); o *= alpha;
        for (int j = 0; j < 64; ++j) o += __shfl(p, j) * bf2f(vb[(size_t)(kc * 64 + j) * PP + lane]);
    }
    const __hip_bfloat16 r = __float2bfloat16(o / l);
    prow[lane] = __builtin_bit_cast(unsigned short, r);
}
__device__ __forceinline__ void dil_task(unsigned short* P, int task, __attribute__((address_space(3))) float* qs, int lane) {
    const int m = task >> 2, h = task & 3, b = m >> 12, t = m & (SEQ - 1);
    const unsigned short* Pb = P + (size_t)b * SEQ * PP;
    float m_run = -1e30f, l = 0.f, o = 0.f;
    for (int g = 0; g < 3; ++g) {
        const int dg = 1 << (2 * g); const int qcol = C_B0 + 768 * g + 64 * h, kcol = qcol + 256, vcol = qcol + 512;
        qs[lane] = bf2f(Pb[(size_t)t * PP + qcol + lane]);
        for (int c = 0; c < 3; ++c) {
            const int j = -64 + 64 * c + lane, tok = t + dg * j; const bool valid = (j <= 64) && (tok >= 0) && (tok < SEQ);
            const unsigned short* kr = Pb + (size_t)(valid ? tok : t) * PP + kcol;
            float s = 0.f;
#pragma unroll 8
            for (int d = 0; d < 64; ++d) s += qs[d] * bf2f(kr[d]);
            s = valid ? s : -1e30f;
            const float m_new = fmaxf(m_run, wmax(s)), alpha = __builtin_amdgcn_exp2f(m_run - m_new), p = valid ? __builtin_amdgcn_exp2f(s - m_new) : 0.f;
            m_run = m_new; l = l * alpha + wsum(p); o *= alpha;
            for (int jj = 0; jj < 64; ++jj) { int tk = t + dg * (-64 + 64 * c + jj); tk = tk < 0 ? 0 : (tk > SEQ - 1 ? SEQ - 1 : tk);
                o += __shfl(p, jj) * bf2f(Pb[(size_t)tk * PP + vcol + lane]); }
        }
    }
    const __hip_bfloat16 r = __float2bfloat16(o / l);
    P[(size_t)m * PP + C_OB + 64 * h + lane] = __builtin_bit_cast(unsigned short, r);
}
}


namespace naive {
__device__ __forceinline__ float blo(unsigned w) { return __uint_as_float(w << 16); }
__device__ __forceinline__ float bhi(unsigned w) { return __uint_as_float(w & 0xffff0000u); }
__device__ __forceinline__ unsigned short f2b(float v) { const __hip_bfloat16 r = __float2bfloat16(v); return __builtin_bit_cast(unsigned short, r); }
__device__ __forceinline__ float dotcol(const unsigned short* arow, const float* W, int K, int N, int c) {
    float s = 0.f;
    for (int k = 0; k < K; k += 2) { const unsigned w2 = *(const unsigned*)(arow + k); s += blo(w2) * W[(size_t)k * N + c]; s += bhi(w2) * W[(size_t)(k + 1) * N + c]; }
    return s;
}
__device__ __forceinline__ void gin_task(int w, int lane, const unsigned short* XN, unsigned short* P, const float* win, const float* qna, const float* kna, const float* qnb, const float* knb) {
    const int m = w / 80, cg = w % 80, c = 64 * cg + lane, t = m & (SEQ - 1);
    if (!NAIVE_GIN && !((DBG_SKIP >> (cg >> 2)) & 1u)) return;
    const float z = dotcol(XN + (size_t)m * DM, win, DM, NIN, c);
    float o;
    if (cg >= 48) o = 1.0f / (1.0f + expf(-z));
    else {
        int mode; const float* gn = qna; float scale = 1.f;
        if (cg < 8) { mode = 0; gn = qna; scale = QK_C2; }
        else if (cg < 10) { mode = 0; gn = kna; }
        else if (cg < 12) mode = 2;
        else { const int g = (cg - 12) / 12, rem = (cg - 12) % 12; if (rem < 4) { mode = 1; gn = qnb + 64 * g; scale = QK_C2; } else if (rem < 8) { mode = 1; gn = knb + 64 * g; } else mode = 2; }
        if (mode == 2) o = z;
        else {
            const float ss = wsum(z * z), y = z * (1.0f / sqrtf(ss * (1.0f / 64.0f) + EPS)) * gn[lane];
            float ang; bool first; float partner;
            if (mode == 0) { const int dd = lane & 31, i = dd & 15, pos = (lane >> 5) ? (t & 63) : (t >> 6); ang = (float)pos * powf(10000.0f, -(float)i / 16.0f); first = dd < 16; partner = __shfl_xor(y, 16); }
            else { const int i = lane & 31; ang = (float)t * powf(10000.0f, -(float)i / 32.0f); first = lane < 32; partner = __shfl_xor(y, 32); }
            const double a = (double)ang; const float cs = (float)cos(a), sn = (float)sin(a);
            o = (first ? (y * cs - partner * sn) : (y * cs + partner * sn)) * scale;
        }
    }
    P[(size_t)m * PP + c] = f2b(o);
}
}

#define LAS __attribute__((address_space(3)))
typedef unsigned short bf16;
typedef unsigned v4u __attribute__((ext_vector_type(4)));
typedef float f32x4 __attribute__((ext_vector_type(4)));
constexpr int NWAVES = 8;
constexpr size_t MiB = 1u << 20;
constexpr size_t WS_ADA = 1 * MiB, WS_TABB = 2 * MiB, WS_TABA = 3 * MiB;
constexpr size_t WS_WIN = 4 * MiB, WS_WA = 44 * MiB, WS_WB = 48 * MiB, WS_WO = 50 * MiB, WS_W1 = 58 * MiB, WS_W2 = 90 * MiB;
constexpr size_t WS_XN = 122 * MiB, WS_P = 186 * MiB, WS_XSB = 442 * MiB, WS_RSS = 506 * MiB, WS_END = 508 * MiB;
constexpr size_t WS_BIASA = 64 * 1024, WS_GS = 704 * 1024, WS_BIASF = 3 * MiB + 64 * 1024;
constexpr int RING_BYTES = 131072, LDS_BYTES = 147456;
constexpr int NPHASE = 2 + 6 * DEPTH;

__device__ __forceinline__ unsigned f2bf(float f) { unsigned u = __builtin_bit_cast(unsigned, f); return (u + 0x7fffu + ((u >> 16) & 1u)) >> 16; }
__device__ __forceinline__ unsigned pk2(float lo, float hi) { return f2bf(lo) | (f2bf(hi) << 16); }
#define LDS_WAIT() asm volatile("s_waitcnt lgkmcnt(0)" ::: "memory")
__device__ __forceinline__ float wave_sum(float v) {
#pragma unroll
    for (int o = 1; o < 64; o <<= 1) v += __shfl_xor(v, o);
    return v;
}
__device__ __forceinline__ int win_dst_row(int n) {
    const int pn = n >> 8, u = n & 255, wc = u >> 6, d = u & 63, e = d & 7;
    if (pn >= 12) return n;
    int bj, fq;
    if (pn <= 1 || (pn == 2 && wc < 2)) { bj = (d >> 4) & 1; fq = 2 * (d >> 5) + ((d >> 3) & 1); }
    else { bj = d >> 5; fq = (d >> 3) & 3; }
    return (pn << 8) + 128 * bj + 32 * wc + 8 * fq + e;
}
__device__ __forceinline__ void p0_transpose_item(const float* W, int K, int N, bf16* WT, bool perm, LAS float* scr, int item, int lane) {
    const int nblk = N / 32, kb = item / nblk, nb = item % nblk, k0 = 64 * kb, n0 = 32 * nb;
#pragma unroll
    for (int i = 0; i < 8; ++i) { const int kk = 8 * i + (lane >> 3), ch = lane & 7;
        const f32x4 v = *(const f32x4*)(W + (size_t)(k0 + kk) * N + n0 + 4 * ch);
        LAS float* d = scr + kk * 33 + 4 * ch; d[0] = v[0]; d[1] = v[1]; d[2] = v[2]; d[3] = v[3]; }
    LDS_WAIT(); asm volatile("" ::: "memory");
    const int c = lane & 7;
#pragma unroll
    for (int j = 0; j < 4; ++j) { const int n = (lane >> 3) + 8 * j; const LAS float* s = scr + (8 * c) * 33 + n;
        v4u o; o.x = pk2(s[0 * 33], s[1 * 33]); o.y = pk2(s[2 * 33], s[3 * 33]); o.z = pk2(s[4 * 33], s[5 * 33]); o.w = pk2(s[6 * 33], s[7 * 33]);
        const int row = perm ? win_dst_row(n0 + n) : (n0 + n);
        *(v4u*)(WT + (size_t)row * K + k0 + 8 * c) = o; }
    LDS_WAIT(); asm volatile("" ::: "memory");
}

__device__ __forceinline__ void gemv8_block(const float* W, int N, int n0, const LAS float* vec, LAS float* red, float* dst, int dstride, const float* addv, int wave, int lane) {
    const int cg = lane & 15, rg = lane >> 4;
    f32x4 a[8];
#pragma unroll
    for (int b = 0; b < 8; ++b) a[b] = (f32x4){0.f, 0.f, 0.f, 0.f};
    const float* wp = W + (size_t)(wave * 128 + rg) * N + n0 + 4 * cg;
#pragma unroll 8
    for (int i = 0; i < 32; ++i) { const f32x4 wv = *(const f32x4*)(wp + (size_t)(4 * i) * N); const int kk = wave * 128 + 4 * i + rg;
#pragma unroll
        for (int b = 0; b < 8; ++b) a[b] += wv * vec[b * DM + kk]; }
#pragma unroll
    for (int b = 0; b < 8; ++b)
#pragma unroll
        for (int j = 0; j < 4; ++j) { float v = a[b][j]; v += __shfl_xor(v, 16); v += __shfl_xor(v, 32); a[b][j] = v; }
    if (rg == 0) {
#pragma unroll
        for (int b = 0; b < 8; ++b) *(LAS f32x4*)(red + (wave * 8 + b) * 64 + 4 * cg) = a[b];
    }
    __syncthreads();
    { float s = addv ? addv[n0 + lane] : 0.f;
#pragma unroll
      for (int w2 = 0; w2 < 8; ++w2) s += red[(w2 * 8 + wave) * 64 + lane];
      dst[(size_t)wave * dstride + n0 + lane] = s; }
    __syncthreads();
}

#define XB_TMO      128
#define XB_XCNT(j)  (256  + 64 * (j))
#define XB_XSUB(j)  (1280 + 64 * (j))
#define XB_XGEN(j)  (2304 + 64 * (j))
#define XB_TOP      3328
#define XB_TOPGEN   3392
#define XCD_BAR_WORDS 3456
#define XB_SPIN_CAP (1u << 18)

__device__ __forceinline__ unsigned xb_ld(unsigned* p)              { return __hip_atomic_load(p, __ATOMIC_RELAXED, __HIP_MEMORY_SCOPE_AGENT); }
__device__ __forceinline__ unsigned xb_add(unsigned* p, unsigned v) { return __hip_atomic_fetch_add(p, v, __ATOMIC_RELAXED, __HIP_MEMORY_SCOPE_AGENT); }
__device__ __forceinline__ unsigned xb_xcc_id() { return (unsigned)__builtin_amdgcn_s_getreg((3 << 11) | 20) & 0xFu; }
#define XB_SPIN(cond, bar) do { unsigned _sp = 0; while (cond) { __builtin_amdgcn_s_sleep(1); \
    if ((++_sp & 255u) == 0u) { if (xb_ld(&(bar)[XB_TMO])) break; if (_sp > XB_SPIN_CAP) { atomicAdd(&(bar)[XB_TMO], 1u); break; } } } } while (0)

struct XcdBarrier {
    unsigned* bar; unsigned x;
    volatile LAS unsigned* st;
};

__device__ __forceinline__ XcdBarrier xcd_barrier_post(unsigned* bar, volatile LAS unsigned* st, bool leader) {
    XcdBarrier b; b.bar = bar; b.x = xb_xcc_id(); b.st = st;
    if (leader) (void)xb_add(&bar[XB_XCNT(b.x)], 1u);
    return b;
}
__device__ __forceinline__ void xcd_barrier_complete(unsigned* bar, unsigned x, unsigned& nloc, unsigned& nx) {
    const unsigned G = gridDim.x * gridDim.y * gridDim.z;
    unsigned sum, cnt, mine, sp = 0u;
    for (;;) {
        sum = 0u; cnt = 0u; mine = 0u;
#pragma unroll
        for (unsigned j = 0; j < 16; ++j) { const unsigned c = xb_ld(&bar[XB_XCNT(j)]); sum += c; cnt += (c > 0u) ? 1u : 0u; mine = (j == x) ? c : mine; }
        if (sum == G) break;
        __builtin_amdgcn_s_sleep(1);
        if ((++sp & 255u) == 0u) { if (xb_ld(&bar[XB_TMO])) break; if (sp > XB_SPIN_CAP) { atomicAdd(&bar[XB_TMO], 1u); break; } }
    }
    nloc = mine > 0u ? mine : 1u; nx = cnt > 0u ? cnt : 1u;
}

__device__ __forceinline__ void xcd_barrier(const XcdBarrier& b, bool leader) {
    asm volatile("s_waitcnt vmcnt(0)" ::: "memory");
    __syncthreads();
    if (leader) {
        unsigned* bar = b.bar;
        __builtin_amdgcn_s_waitcnt(0);
        unsigned nloc = b.st[0], nx = b.st[1];
        if (nloc == 0u) { xcd_barrier_complete(bar, b.x, nloc, nx); b.st[0] = nloc; b.st[1] = nx; }
        const unsigned old = xb_add(&bar[XB_XSUB(b.x)], 1u);
        const unsigned gen = old / nloc;
        if (old + 1u == (gen + 1u) * nloc) {
            __builtin_amdgcn_fence(__ATOMIC_RELEASE, "agent");
            asm volatile("s_waitcnt vmcnt(0)" ::: "memory");
            const unsigned og = xb_add(&bar[XB_TOP], 1u);
            const unsigned tg = og / nx;
            if (og + 1u == (tg + 1u) * nx) xb_add(&bar[XB_TOPGEN], 1u);
            else XB_SPIN(xb_ld(&bar[XB_TOPGEN]) == tg, bar);
            __builtin_amdgcn_fence(__ATOMIC_ACQUIRE, "agent");
            xb_add(&bar[XB_XGEN(b.x)], 1u);
            asm volatile("s_waitcnt vmcnt(0)" ::: "memory");
        } else {
            XB_SPIN(xb_ld(&bar[XB_XGEN(b.x)]) == gen, bar);
            __builtin_amdgcn_fence(__ATOMIC_ACQUIRE, "agent");
            asm volatile("s_waitcnt vmcnt(0)" ::: "memory");
        }
    }
    __syncthreads();
}

#define LB_CNT(g)   (3584 + 64 * (g))
#define LB_XMAX(g)  (3456 + (g))
#define LB_XMIN(g)  (3464 + (g))
__device__ __forceinline__ void grp_barrier(unsigned* bar, int vg, unsigned nloc, bool leader) {
    asm volatile("s_waitcnt vmcnt(0)" ::: "memory");
    __syncthreads();
    if (leader) {
        __builtin_amdgcn_s_waitcnt(0);
        const unsigned old = xb_add(&bar[LB_CNT(vg)], 1u), want = (old / nloc + 1u) * nloc;
        XB_SPIN(xb_ld(&bar[LB_CNT(vg)]) < want, bar);
        __builtin_amdgcn_fence(__ATOMIC_ACQUIRE, "agent");
        asm volatile("s_waitcnt vmcnt(0)" ::: "memory");
    }
    __syncthreads();
}

struct Args { const float* in[16]; float* out; unsigned char* ws; int ph_lo, ph_hi; };

typedef const Args __attribute__((address_space(4))) CArgs;
template <int ph> __device__ __forceinline__ void run_phase(CArgs* ap0, const int wave0, unsigned char* lds) {
    LAS unsigned char* L = (LAS unsigned char*)lds;
        int zz = 0; asm volatile("" : "+v"(zz));
        const int lane = __builtin_amdgcn_mbcnt_hi(~0u, __builtin_amdgcn_mbcnt_lo(~0u, zz)), wave = wave0;
        const int tid = wave * 64 + lane;
        int bx = blockIdx.x; asm volatile("" : "+s"(bx));
        const int G = gridDim.x; const int vcu = (G % 8 == 0) ? (bx % 8) * (G / 8) + bx / 8 : bx;
        const int gw = vcu * NWAVES + wave, NGW = G * NWAVES;
        CArgs* ap = ap0; asm volatile("" : "+s"(ap));
        unsigned char* ws = ap->ws;
        float* ADA = (float*)(ws + WS_ADA); float* TABB = (float*)(ws + WS_TABB); float* TABA = (float*)(ws + WS_TABA);
        bf16* XN = (bf16*)(ws + WS_XN); bf16* P = (bf16*)(ws + WS_P); bf16* HB = (bf16*)(ws + WS_P);
        const float* x_in = ap->in[0]; float* out = ap->out;
        if (ph == 0) {
            {
                LAS float* cact = (LAS float*)L;
                LAS float* red = (LAS float*)(L + 32768);
                for (int i = tid; i < BATCH * DM; i += NWAVES * 64) { const float v = ap->in[1][i]; cact[i] = v * __builtin_amdgcn_rcpf(1.0f + __expf(-v)); }
                __syncthreads();
                for (int it = bx; it < DEPTH * 96; it += G) {
                    const int l = it / 96, n0 = (it % 96) * 64;
                    gemv8_block(ap->in[2] + (size_t)l * DM * 6 * DM, 6 * DM, n0, cact, red, ADA + (size_t)l * BATCH * 6 * DM, 6 * DM, ap->in[3] + (size_t)l * 6 * DM, wave, lane);
                }
            }
            {
                for (int e = bx * NWAVES * 64 + tid; e < SEQ * 32 + 64 * 16; e += G * NWAVES * 64) {
                    int pos, i; float fr; float* dst;
                    if (e < SEQ * 32) { pos = e >> 5; i = e & 31; fr = (float)i * (1.0f / 32.0f); dst = TABB + 2 * (size_t)e; }
                    else { const int e2 = e - SEQ * 32; pos = e2 >> 4; i = e2 & 15; fr = (float)i * (1.0f / 16.0f); dst = TABA + 2 * (size_t)e2; }
                    const float inv = exp2f(-fr * 13.287712379549449f);
                    const float ang = (float)pos * inv;
                    const double turns = (double)ang * 0.15915494309189535;
                    const float fpart = (float)(turns - rint(turns));
#if TAB_DOUBLE
                    dst[0] = (float)cos((double)ang); dst[1] = (float)sin((double)ang);
#else
                    dst[0] = __builtin_amdgcn_cosf(fpart); dst[1] = __builtin_amdgcn_sinf(fpart);
#endif
                }
            }
            {
                LAS float* scr = (LAS float*)(L + wave * 16384);
                constexpr int I_IN = (DM / 64) * (NIN / 32), I_A = (512 / 64) * (DM / 32), I_B = (256 / 64) * (DM / 32), I_O = (DM / 64) * (DM / 32), I_1 = (DM / 64) * (FF / 32), I_2 = (FF / 64) * (DM / 32);
                constexpr int I_L = I_IN + I_A + I_B + I_O + I_1 + I_2;
                __syncthreads();
                for (int it = gw; it < DEPTH * I_L; it += NGW) {
                    const int l = it / I_L; int r = it - l * I_L;
                    if (r < I_IN) { p0_transpose_item(ap->in[6] + (size_t)l * DM * NIN, DM, NIN, (bf16*)(ws + WS_WIN) + (size_t)l * NIN * DM, true, scr, r, lane); continue; } r -= I_IN;
                    if (r < I_A) { p0_transpose_item(ap->in[11] + (size_t)l * 512 * DM, 512, DM, (bf16*)(ws + WS_WA) + (size_t)l * DM * 512, false, scr, r, lane); continue; } r -= I_A;
                    if (r < I_B) { p0_transpose_item(ap->in[12] + (size_t)l * 256 * DM, 256, DM, (bf16*)(ws + WS_WB) + (size_t)l * DM * 256, false, scr, r, lane); continue; } r -= I_B;
                    if (r < I_O) { p0_transpose_item(ap->in[13] + (size_t)l * DM * DM, DM, DM, (bf16*)(ws + WS_WO) + (size_t)l * DM * DM, false, scr, r, lane); continue; } r -= I_O;
                    if (r < I_1) { p0_transpose_item(ap->in[14] + (size_t)l * DM * FF, DM, FF, (bf16*)(ws + WS_W1) + (size_t)l * FF * DM, false, scr, r, lane); continue; } r -= I_1;
                    p0_transpose_item(ap->in[15] + (size_t)l * FF * DM, FF, DM, (bf16*)(ws + WS_W2) + (size_t)l * DM * FF, false, scr, r, lane);
                }
                __syncthreads();
            }
        } else {
            const int l = (ph - 2) / 6, sub6 = (ph - 2) % 6;
            const int sub = (ph == 1) ? 0 : (sub6 == 0 ? 1 : sub6 == 1 ? 2 : sub6 == 2 ? 3 : sub6 == 3 ? 4 : sub6 == 4 ? 6 : 7);
            const float* ada_l = ADA + (size_t)l * BATCH * 6 * DM;
            float* RSS = (float*)(ws + WS_RSS); float* GSV = (float*)(ws + WS_GS); float* BIASA = (float*)(ws + WS_BIASA); float* BIASF = (float*)(ws + WS_BIASF); bf16* XSB = P + C_GB;
            if (sub == 0) {
                { LAS float* shv = (LAS float*)L;
                  LAS float* red = (LAS float*)(L + 32768);
                  for (int it = bx; it < DEPTH * 144; it += G) {
                      const int ll = it / 144, r = it % 144; const bool isA = r < 80; const int n0 = (isA ? r : r - 80) * 64, N = isA ? NIN : FF;
                      const float* W = (isA ? ap->in[6] + (size_t)ll * DM * NIN : ap->in[14] + (size_t)ll * DM * FF);
                      const float* adl = ADA + (size_t)ll * BATCH * 6 * DM + (isA ? 0 : 3 * DM);
                      for (int i = tid; i < BATCH * DM; i += NWAVES * 64) shv[i] = adl[(size_t)(i >> 10) * 6 * DM + (i & 1023)];
                      __syncthreads();
                      gemv8_block(W, N, n0, shv, red, isA ? BIASA + (size_t)ll * BATCH * NIN : BIASF + (size_t)ll * BATCH * FF, N, nullptr, wave, lane);
                  } }
                for (int e = bx * NWAVES * 64 + tid; e < 2 * DEPTH * BATCH * DM; e += G * NWAVES * 64) {
                    const int which = e >> 15, ll = (e >> 13) & 3, b = (e >> 10) & 7, c = e & 1023;
                    GSV[e] = (which ? ap->in[5] : ap->in[4])[ll * DM + c] * (1.0f + ADA[((size_t)ll * BATCH + b) * 6 * DM + (which ? 4 : 1) * DM + c]);
                }
                { f32x4 gg[4];
#pragma unroll
                  for (int j = 0; j < 4; ++j) gg[j] = *(const f32x4*)(ap->in[4] + 256 * j + 4 * lane);
                  for (int m = gw; m < MTOK; m += NGW) {
                    const int b = m >> 12; const f32x4* xr = (const f32x4*)(x_in + (size_t)m * DM) + lane;
                    f32x4 v[4]; float s = 0.f;
#pragma unroll
                    for (int j = 0; j < 4; ++j) { v[j] = xr[64 * j]; s += (v[j][0] * v[j][0] + v[j][1] * v[j][1]) + (v[j][2] * v[j][2] + v[j][3] * v[j][3]); }
                    s = wave_sum(s);
                    if (lane < 16) RSS[(size_t)m * 16 + lane] = (lane == 0) ? s : 0.f;
                    const float* ab = ADA + (size_t)b * 6 * DM + DM;
                    unsigned long long* o8 = (unsigned long long*)(XN + (size_t)m * DM) + lane;
#pragma unroll
                    for (int j = 0; j < 4; ++j) { const f32x4 sc = *(const f32x4*)(ab + 256 * j + 4 * lane);
                        const f32x4 y = v[j] * gg[j] * (sc + 1.0f);
                        o8[64 * j] = (unsigned long long)pk2(y[0], y[1]) | ((unsigned long long)pk2(y[2], y[3]) << 32); }
                  } }
            } else if (sub == 1) {
                pg8::Gemm g{XN, (const bf16*)(ws + WS_WIN) + (size_t)l * NIN * DM, MTOK, NIN, DM, DM}; pg8::StaticOrder S; S.init(MTOK, NIN, G, bx);
                pg8::EpiIn E{P, ap->in[7] + l * 64, ap->in[8] + l * 64, ap->in[9] + l * 192, ap->in[10] + l * 192, TABA, TABB, RSS, BIASA + (size_t)l * BATCH * NIN};
#if NAIVE_GIN
                for (int w = gw; w < MTOK * 80; w += NGW) naive::gin_task(w, lane, XN, P, ap->in[6] + (size_t)l * DM * NIN, ap->in[7] + l * 64, ap->in[8] + l * 64, ap->in[9] + l * 192, ap->in[10] + l * 192);
#else
#ifndef NO_GIN
                pg8::gemm_phase<pg8::EpiIn, pg8::StaticOrder, true, true, DM, DM>(tid, L, g, S, E);
#if DBG_GEMM2 & 1
                pg8::gemm_phase<pg8::EpiIn, pg8::StaticOrder, true, true, DM, DM>(tid, L, g, S, E);
#endif
#endif
#if DBG_SKIP
                for (int w = gw; w < MTOK * 80; w += NGW) naive::gin_task(w, lane, XN, P, ap->in[6] + (size_t)l * DM * NIN, ap->in[7] + l * 64, ap->in[8] + l * 64, ap->in[9] + l * 192, ap->in[10] + l * 192);
#endif
#endif
            } else if (sub == 2) {
                for (int u = vcu; u < BATCH * 8 * 16; u += G) {
                    const int i = u / G, gsz = G >> 3, loc = (vcu % gsz) + gsz * i;
                    const int b = vcu / gsz, h = (loc >> 4) & 7, qb = loc & 15;
                    if (loc >= 128) continue;
#if !defined(NO_ATT) && !NAIVE_ATT
                    attn_body::attn_unit<8>(b, h, qb, (const attn_body::bf16*)P + C_QA, (const attn_body::bf16*)P + C_KA, (const attn_body::bf16*)P + C_VA, (attn_body::bf16*)P + C_QA, (char*)lds, tid);
#endif
                }
                __syncthreads();
#if NAIVE_ATT
                for (int w = gw; w < MTOK * 8; w += NGW) naive::dense_task(P, w, (LAS float*)(L + wave * 256), lane);
                __syncthreads();
#endif
#if NAIVE_DIL
                for (int w = gw; w < MTOK * 4; w += NGW) naive::dil_task(P, w, (LAS float*)(L + wave * 256), lane);
#elif !defined(NO_DIL)
                { float* SO = (float*)(ws + WS_XN); float* SM = (float*)(ws + WS_XN + 4 * MiB); float* SL = (float*)(ws + WS_XN + 4 * MiB + 65536);
                  for (int grp = vcu; grp < BATCH * 4 * 8; grp += G) {
#pragma unroll 1
                    for (int k2 = 0; k2 < 2; ++k2) dil::dil_pass1(P, grp, wave + 8 * k2, L + wave * dil::WAVE_LDS, lane, SO, SM, SL);
                    asm volatile("s_waitcnt vmcnt(0)" ::: "memory"); __syncthreads();
#pragma unroll 1
                    for (int k2 = 0; k2 < 2; ++k2) dil::dil_pass2(P, grp, wave + 8 * k2, L + wave * dil::WAVE_LDS, lane, SO, SM, SL);
                    __syncthreads();
                  } }
#endif
                __syncthreads();
            } else if (sub == 3) {
                { pg8::Gemm g{P + C_QA, (const bf16*)(ws + WS_WA) + (size_t)l * DM * 512, MTOK, DM, 512, PP}; pg8::StaticOrder S; S.init(MTOK, DM, G, bx);

#if NAIVE_BR
                for (int w = gw; w < MTOK * 16; w += NGW) { const int m = w >> 4, c = 64 * (w & 15) + lane;
                    const float za = naive::dotcol(P + (size_t)m * PP + C_QA, ap->in[11] + (size_t)l * 512 * DM, 512, DM, c), zb = naive::dotcol(P + (size_t)m * PP + C_OB, ap->in[12] + (size_t)l * 256 * DM, 256, DM, c);
                    const float ga = naive::bf2f(P[(size_t)m * PP + C_GA + c]), gb = naive::bf2f(P[(size_t)m * PP + C_GB + c]);
                    XN[(size_t)m * DM + c] = naive::f2b(ga * za + gb * zb); }
#else
#ifndef NO_BR0
pg8::EpiBr<0> E{XN, P, C_GA}; pg8::gemm_phase<pg8::EpiBr<0>, pg8::StaticOrder, true, true, 512, PP>(tid, L, g, S, E);
#endif
#endif
 }
                { pg8::Gemm g{P + C_OB, (const bf16*)(ws + WS_WB) + (size_t)l * DM * 256, MTOK, DM, 256, PP}; pg8::StaticOrder S; S.init(MTOK, DM, G, bx);

#if NAIVE_BR

#else
#ifndef NO_BR1
pg8::EpiBr<1> E{XN, P, C_GB}; pg8::gemm_phase<pg8::EpiBr<1>, pg8::StaticOrder, true, true, 256, PP>(tid, L, g, S, E);
#endif
#endif
 }
            } else if (sub == 4) {
                pg8::Gemm g{XN, (const bf16*)(ws + WS_WO) + (size_t)l * DM * DM, MTOK, DM, DM, DM}; pg8::StaticOrder S; S.init(MTOK, DM, G, bx);
                pg8::EpiRes E{l == 0 ? x_in : out, out, ada_l + 2 * DM, XSB, GSV + (size_t)(DEPTH + l) * BATCH * DM, RSS, PP};
#if NAIVE_OUT
                for (int w = gw; w < MTOK * 16; w += NGW) { const int m = w >> 4, c = 64 * (w & 15) + lane;
                    const float z = naive::dotcol(XN + (size_t)m * DM, ap->in[13] + (size_t)l * DM * DM, DM, DM, c);
                    out[(size_t)m * DM + c] = (l == 0 ? x_in : out)[(size_t)m * DM + c] + ada_l[(size_t)(m >> 12) * 6 * DM + 2 * DM + c] * z; }
#else
#ifndef NO_RES
pg8::gemm_phase<pg8::EpiRes, pg8::StaticOrder, true, true, DM, DM>(tid, L, g, S, E);
#endif
#endif

            } else if (sub == 6) {
                pg8::Gemm g{XSB, (const bf16*)(ws + WS_W1) + (size_t)l * FF * DM, MTOK, FF, DM, PP}; pg8::StaticOrder S; S.init(MTOK, FF, G, bx);
                pg8::EpiRelu2 E{HB, RSS, BIASF + (size_t)l * BATCH * FF};
#if NAIVE_F1
                for (int w = gw; w < MTOK * 64; w += NGW) { const int m = w >> 6, c = 64 * (w & 63) + lane;
                    const float z = fmaxf(naive::dotcol(XN + (size_t)m * DM, ap->in[14] + (size_t)l * DM * FF, DM, FF, c), 0.f);
                    HB[(size_t)m * FF + c] = naive::f2b(z * z); }
#else
#ifndef NO_F1
pg8::gemm_phase<pg8::EpiRelu2, pg8::StaticOrder, true, true, DM, PP>(tid, L, g, S, E);
#if DBG_GEMM2 & 4
pg8::gemm_phase<pg8::EpiRelu2, pg8::StaticOrder, true, true, DM, PP>(tid, L, g, S, E);
#endif
#endif
#endif

            } else {
                pg8::Gemm g{HB, (const bf16*)(ws + WS_W2) + (size_t)l * DM * FF, MTOK, DM, FF, PP}; pg8::StaticOrder S; S.init(MTOK, DM, G, bx);
                pg8::EpiRes E{out, out, ada_l + 5 * DM, (l + 1 < DEPTH) ? XN : (bf16*)nullptr, GSV + (size_t)((l + 1 < DEPTH) ? (l + 1) : 0) * BATCH * DM, RSS, DM};
#if NAIVE_F2
                for (int w = gw; w < MTOK * 16; w += NGW) { const int m = w >> 4, c = 64 * (w & 15) + lane;
                    const float z = naive::dotcol(HB + (size_t)m * FF, ap->in[15] + (size_t)l * FF * DM, FF, DM, c);
                    out[(size_t)m * DM + c] = out[(size_t)m * DM + c] + ada_l[(size_t)(m >> 12) * 6 * DM + 5 * DM + c] * z; }
#else
#ifndef NO_RES
pg8::gemm_phase<pg8::EpiRes, pg8::StaticOrder, true, true, FF, PP>(tid, L, g, S, E);
#endif
#endif

            }
        }
}

__global__ void __launch_bounds__(NWAVES * 64, 2) mk_fwd(Args args) {
    extern __shared__ __attribute__((aligned(16))) unsigned char lds[];
    CArgs* ap0 = (CArgs*)__builtin_amdgcn_kernarg_segment_ptr();
    const int ph_lo = ap0->ph_lo, ph_hi = ap0->ph_hi;
    const int wave0 = __builtin_amdgcn_readfirstlane(threadIdx.x >> 6);
    volatile LAS unsigned* bst = (volatile LAS unsigned*)((LAS unsigned char*)lds + RING_BYTES + 64);
    if (threadIdx.x == 0) { bst[0] = 0u; bst[1] = 0u; }
    __syncthreads();
    unsigned* barw = (unsigned*)ap0->ws;
    const unsigned xbx = xcd_barrier_post(barw, bst, threadIdx.x == 0).x;
    if (threadIdx.x == 0) { const int vg0 = blockIdx.x & 7; atomicMax(&barw[LB_XMAX(vg0)], xbx + 1u); atomicMax(&barw[LB_XMIN(vg0)], 16u - xbx); bst[2] = 0u; }
#define RUN(PH) if (ph_lo <= (PH) && (PH) < ph_hi) { const bool spin_ = (DBG_SPIN_SUB >= 0) && (PH) >= 2 && (((PH) - 2) % 6 == DBG_SPIN_SUB); unsigned long long t0_ = 0; if (spin_) t0_ = __builtin_amdgcn_s_memrealtime(); run_phase<(PH)>(ap0, wave0, lds); if (spin_) { __syncthreads(); const unsigned long long t1_ = __builtin_amdgcn_s_memrealtime(); while (__builtin_amdgcn_s_memrealtime() - t1_ < t1_ - t0_) __builtin_amdgcn_s_sleep(8); } if (DBG_P02 && (PH) <= 1) { __syncthreads(); run_phase<((PH) <= 1 ? (PH) : 0)>(ap0, wave0, lds); } if ((PH) + 1 < ph_hi) { if ((PH) == 0) cg::this_grid().sync(); else { int z_ = 0; asm volatile("" : "+v"(z_)); const bool ld_ = (wave0 == 0) && (__builtin_amdgcn_mbcnt_hi(~0u, __builtin_amdgcn_mbcnt_lo(~0u, z_)) == 0); XcdBarrier xb_; xb_.bar = barw; xb_.x = xbx; xb_.st = bst; if ((PH) == 1) { xcd_barrier(xb_, ld_); if (ld_) { unsigned ok_ = (gridDim.x == 256u) ? 1u : 0u;     for (int g_ = 0; g_ < 8; ++g_) ok_ &= (xb_ld(&barw[LB_XMAX(g_)]) + xb_ld(&barw[LB_XMIN(g_)]) == 17u) ? 1u : 0u; bst[2] = (LOCAL_SEAMS ? ok_ : 0u); } __syncthreads(); if (DBG_CENSUS && !bst[2]) { const unsigned long long tc_ = __builtin_amdgcn_s_memrealtime(); while (__builtin_amdgcn_s_memrealtime() - tc_ < 200000ull) __builtin_amdgcn_s_sleep(8); } } else { unsigned long long tb0_ = 0; if (DBG_SPIN_BAR) tb0_ = __builtin_amdgcn_s_memrealtime(); if (bst[2]) grp_barrier(barw, (int)(blockIdx.x & 7), gridDim.x / 8u, ld_); else for (int xs_ = 0; xs_ <= DBG_SYNCX; ++xs_) xcd_barrier(xb_, ld_); if (DBG_SPIN_BAR) { const unsigned long long tb1_ = __builtin_amdgcn_s_memrealtime(); while (__builtin_amdgcn_s_memrealtime() - tb1_ < tb1_ - tb0_) __builtin_amdgcn_s_sleep(8); } } } } }
#define RUN8(B) RUN(B) RUN(B + 1) RUN(B + 2) RUN(B + 3) RUN(B + 4) RUN(B + 5) RUN(B + 6) RUN(B + 7)
    RUN(0) RUN(1) RUN8(2) RUN8(10) RUN8(18)
#undef RUN8
#undef RUN
}

extern "C" void kernel_launch(void* const* d_in, const int* in_sizes, int n_in, void* d_out, int out_size, void* d_ws, size_t ws_size, hipStream_t stream) {
    static int grid = 0;
    if (grid == 0) {
        if (n_in != 16 || out_size != MTOK * DM || ws_size < WS_END) { fprintf(stderr, "kernel_launch: unexpected shapes (n_in %d out %d ws %zu)\n", n_in, out_size, ws_size); grid = -1; return; }
        int dev = 0, cus = 0, per_cu = 0;
        if (hipGetDevice(&dev) != hipSuccess || hipDeviceGetAttribute(&cus, hipDeviceAttributeMultiprocessorCount, dev) != hipSuccess) { grid = -1; return; }
        if (hipFuncSetAttribute((const void*)mk_fwd, hipFuncAttributeMaxDynamicSharedMemorySize, LDS_BYTES) != hipSuccess) { fprintf(stderr, "kernel_launch: hipFuncSetAttribute failed\n"); grid = -1; return; }
        if (hipOccupancyMaxActiveBlocksPerMultiprocessor(&per_cu, (const void*)mk_fwd, NWAVES * 64, LDS_BYTES) != hipSuccess || per_cu < 1) per_cu = 1;
        (void)hipGetLastError();
        grid = cus * 1;
        fprintf(stderr, "kernel_launch: grid %d (occupancy query %d per CU)\n", grid, per_cu);
    }
    if (grid < 0) return;
    if (hipMemsetAsync(d_ws, 0, 16384, stream) != hipSuccess) { fprintf(stderr, "kernel_launch: memset failed\n"); return; }
    Args a{};
    for (int i = 0; i < 16; ++i) a.in[i] = (const float*)d_in[i];
    a.out = (float*)d_out; a.ws = (unsigned char*)d_ws;
#if MK_PER_PHASE
    for (int ph = 0; ph < NPHASE; ++ph) { a.ph_lo = ph; a.ph_hi = ph + 1; hipLaunchKernelGGL(mk_fwd, dim3(grid), dim3(NWAVES * 64), LDS_BYTES, stream, a); }
#else
    a.ph_lo = 0; a.ph_hi = NPHASE;
    void* kargs[] = {&a};
    hipError_t e = hipLaunchCooperativeKernel((void*)mk_fwd, dim3(grid), dim3(NWAVES * 64), kargs, LDS_BYTES, stream);
    if (e != hipSuccess) fprintf(stderr, "cooperative launch failed: %s (grid %d)\n", hipGetErrorString(e), grid);
#endif
}
```
